# Optimizing an MI355X kernel written in HIP

```python
import jax, jax.numpy as jnp
from jax import lax
import numpy as np

D_MODEL = 1024
BATCH = 8
SEQ = 2048
DEPTH = 1

CHUNK = 64
POOL_WIDTH = D_MODEL // 2
N_POOL_GROUPS = 4
POOL_GROUP = POOL_WIDTH // N_POOL_GROUPS
POOL_WINDOWS = (2, 4, 8, 16)
CONV_WIDTH = D_MODEL // 2
CONV_K = 3
N_BRANCHES = 2
N_EXPERTS = 64
TOP_K = 8
EXPERT_HIDDEN = 256
SHARED_HIDDEN = 256
ROUTED_SCALE = 2.5
ROW_BLOCK = 128
EPS = 1e-6
IN_COLS = POOL_WIDTH + 3 * CONV_WIDTH + N_BRANCHES * D_MODEL

kernel_name = "hybrid_pool_shortconv_moe_block"


def rmsnorm(x, g):
    xf = x.astype(jnp.float32)
    r = lax.rsqrt(jnp.mean(xf * xf, axis=-1, keepdims=True) + EPS)
    return (xf * r).astype(x.dtype) * g


def pool_mixer(u, w_group, scale):
    b, s, _ = u.shape
    ug = u.reshape(b, s, N_POOL_GROUPS, POOL_GROUP)
    cs = jnp.cumsum(ug.astype(jnp.float32), axis=1)
    t = jnp.arange(s)
    outs = []
    for gi, w in enumerate(POOL_WINDOWS):
        c = cs[:, :, gi]
        prev = jnp.pad(c, ((0, 0), (w, 0), (0, 0)))[:, :s]
        cnt = jnp.minimum(t + 1, w).astype(jnp.float32)[None, :, None]
        outs.append((c - prev) / cnt)
    pooled = jnp.stack(outs, axis=2).astype(u.dtype) - ug
    mixed = jnp.einsum('bsgc,gcd->bsgd', pooled, w_group)
    return mixed.reshape(b, s, POOL_WIDTH) * scale


def causal_depthwise_conv3(u, w):
    s = u.shape[1]
    up = jnp.pad(u, ((0, 0), (CONV_K - 1, 0), (0, 0)))
    return up[:, 0:s] * w[0] + up[:, 1:s + 1] * w[1] + up[:, 2:s + 2] * w[2]


def swiglu(h, w_gate, w_up, w_down):
    return (jax.nn.silu(h @ w_gate) * (h @ w_up)) @ w_down


def routed_experts(h, w_router, router_bias, e_gate, e_up, e_down):
    t_tok, d = h.shape
    logits = (h.astype(jnp.float32) @ w_router.astype(jnp.float32))
    scores = jax.nn.sigmoid(logits)
    _, idx = lax.top_k(scores + router_bias.astype(jnp.float32), TOP_K)
    wsel = jnp.take_along_axis(scores, idx, axis=1)
    wsel = wsel / jnp.sum(wsel, axis=1, keepdims=True) * ROUTED_SCALE

    n_assign = t_tok * TOP_K
    flat_e = idx.reshape(n_assign)
    flat_tok = jnp.repeat(jnp.arange(t_tok, dtype=jnp.int32), TOP_K)
    flat_w = wsel.reshape(n_assign)
    order = jnp.argsort(flat_e, stable=True)
    sorted_e = flat_e[order]
    counts = jnp.bincount(flat_e, length=N_EXPERTS)
    padded = (counts + ROW_BLOCK - 1) // ROW_BLOCK * ROW_BLOCK
    start = jnp.cumsum(counts) - counts
    pad_end = jnp.cumsum(padded)
    pad_start = pad_end - padded
    rank = jnp.arange(n_assign) - start[sorted_e]
    dest = pad_start[sorted_e] + rank

    n_rows = n_assign + N_EXPERTS * ROW_BLOCK
    n_blk = n_rows // ROW_BLOCK
    row_tok = jnp.zeros((n_rows,), jnp.int32).at[dest].set(flat_tok[order])
    row_w = jnp.zeros((n_rows,), jnp.float32).at[dest].set(flat_w[order])
    blk_e = jnp.clip(jnp.searchsorted(pad_end, jnp.arange(n_blk) * ROW_BLOCK, side='right'),
                     0, N_EXPERTS - 1)
    xs = h[row_tok].reshape(n_blk, ROW_BLOCK, d)

    def expert_block(args):
        xb, e = args
        return swiglu(xb, e_gate[e], e_up[e], e_down[e])

    ys = lax.map(expert_block, (xs, blk_e)).reshape(n_rows, d)
    ys = ys * row_w[:, None].astype(ys.dtype)
    return jax.ops.segment_sum(ys, row_tok, num_segments=t_tok)


def setup_inputs(seed: int = 0) -> dict:
    key = jax.random.key(seed)
    ks = jax.random.split(key, 24)
    f32 = jnp.float32
    nrm = lambda k, shape, fan_in: jax.random.normal(k, shape, f32) * (fan_in ** -0.5)
    d = D_MODEL
    return {
        "x": jax.random.normal(ks[0], (BATCH, SEQ, d), f32),
        "g_mix": 1.0 + 0.05 * jax.random.normal(ks[1], (d,), f32),
        "w_in": nrm(ks[2], (d, IN_COLS), d),
        "b_gate": 0.05 * jax.random.normal(ks[3], (N_BRANCHES * d,), f32),
        "w_pool_group": nrm(ks[4], (N_POOL_GROUPS, POOL_GROUP, POOL_GROUP), POOL_GROUP),
        "pool_scale": 1.0 + 0.1 * jax.random.normal(ks[5], (POOL_WIDTH,), f32),
        "w_pool_out": nrm(ks[6], (POOL_WIDTH, d), POOL_WIDTH),
        "conv_w": nrm(ks[7], (CONV_K, CONV_WIDTH), CONV_K),
        "w_conv_out": nrm(ks[8], (CONV_WIDTH, d), CONV_WIDTH),
        "w_o": nrm(ks[9], (d, d), d),
        "g_ffn": 1.0 + 0.05 * jax.random.normal(ks[10], (d,), f32),
        "w_router": nrm(ks[11], (d, N_EXPERTS), d),
        "router_bias": 0.01 * jax.random.normal(ks[12], (N_EXPERTS,), f32),
        "e_gate": nrm(ks[13], (N_EXPERTS, d, EXPERT_HIDDEN), d),
        "e_up": nrm(ks[14], (N_EXPERTS, d, EXPERT_HIDDEN), d),
        "e_down": nrm(ks[15], (N_EXPERTS, EXPERT_HIDDEN, d), EXPERT_HIDDEN),
        "s_gate": nrm(ks[16], (d, SHARED_HIDDEN), d),
        "s_up": nrm(ks[17], (d, SHARED_HIDDEN), d),
        "s_down": nrm(ks[18], (SHARED_HIDDEN, d), SHARED_HIDDEN),
        "g_final": 1.0 + 0.05 * jax.random.normal(ks[19], (d,), f32),
    }


def reference(x, g_mix, w_in, b_gate, w_pool_group, pool_scale, w_pool_out, conv_w,
              w_conv_out, w_o, g_ffn, w_router, router_bias, e_gate, e_up, e_down,
              s_gate, s_up, s_down, g_final):
    b, s, d = x.shape
    for _ in range(DEPTH):
        h = rmsnorm(x, g_mix)
        proj = h @ w_in
        o0 = POOL_WIDTH
        o1 = o0 + CONV_WIDTH
        o2 = o1 + CONV_WIDTH
        o3 = o2 + CONV_WIDTH
        u_pool = proj[..., :o0]
        gb = proj[..., o0:o1]
        gc = proj[..., o1:o2]
        v = proj[..., o2:o3]
        gates = jax.nn.sigmoid(proj[..., o3:] + b_gate)
        gate_a = gates[..., :d]
        gate_b = gates[..., d:]

        branch_a = pool_mixer(u_pool, w_pool_group, pool_scale) @ w_pool_out
        branch_b = (gb * causal_depthwise_conv3(gc * v, conv_w)) @ w_conv_out
        merged = gate_a * branch_a + gate_b * branch_b
        x = x + merged @ w_o

        h2 = rmsnorm(x, g_ffn).reshape(b * s, d)
        shared = swiglu(h2, s_gate, s_up, s_down)
        routed = routed_experts(h2, w_router, router_bias, e_gate, e_up, e_down)
        x = x + (shared + routed).reshape(b, s, d)
    return rmsnorm(x, g_final)
```

```cpp
#include <hip/hip_runtime.h>
#include <stdint.h>
#include <cstdio>

typedef unsigned short bf16;
typedef unsigned int u32;

constexpr int T = 16384, D = 1024, SEQ = 2048, NIN = 4096;
constexpr int NE = 64, TOPK = 8, EH = 256;
constexpr float EPS = 1e-6f, ROUTED_SCALE = 2.5f;
constexpr int MAXROWS = T * TOPK + NE * 256 + T;

constexpr size_t MiB = 1u << 20;
constexpr size_t WS_CTL = 0, CTL_BYTES = 1 * MiB;
constexpr size_t WS_TOPE = 1 * MiB;
constexpr size_t WS_TOPW = WS_TOPE + 512 * 1024;
constexpr size_t WS_INV = WS_TOPW + 512 * 1024;
constexpr size_t WS_ROWTOK = WS_INV + 512 * 1024;
constexpr size_t WS_ROWW = WS_ROWTOK + 640 * 1024;
constexpr size_t WS_OFF = WS_ROWW + 640 * 1024;
constexpr size_t WS_TILEE = WS_OFF + 1024;
constexpr size_t WS_EDT = 5 * MiB;
constexpr size_t WS_WTIN = 38 * MiB;
constexpr size_t WS_WTAB = 46 * MiB;
constexpr size_t WS_WTO = 48 * MiB;
constexpr size_t WS_EGUT = 51 * MiB;
constexpr size_t WS_H = 116 * MiB;
constexpr size_t WS_UBCV = 148 * MiB;
constexpr size_t WS_GATES = 212 * MiB;
constexpr size_t WS_HID = 203 * MiB;
constexpr size_t WS_Y = 38 * MiB;
constexpr size_t WS_END = 283 * MiB;
static_assert(WS_TILEE + 4096 <= WS_EDT, "tables");
static_assert(WS_EDT + (size_t)65 * 1024 * 256 * 2 <= WS_WTIN, "edt");
static_assert(WS_EGUT + (size_t)65 * 512 * 1024 * 2 <= WS_H, "egut");
static_assert(WS_HID + (size_t)MAXROWS * 256 * 2 <= WS_END, "hid");
static_assert(WS_Y + (size_t)MAXROWS * 512 * 2 <= WS_HID, "y");
static_assert(WS_GATES + (size_t)T * 2048 * 2 <= WS_END, "gates");
constexpr int CW_CNT = 0, CW_CUR = 64;

__device__ __forceinline__ float bf2f(bf16 b) { return __uint_as_float(((u32)b) << 16); }
__device__ __forceinline__ bf16 f2bf(float f) { u32 u = __float_as_uint(f); return (bf16)((u + 0x7fffu + ((u >> 16) & 1u)) >> 16); }
__device__ __forceinline__ float sigmoidf_(float x) { return 1.0f / (1.0f + expf(-x)); }
__device__ __forceinline__ float wave_sum(float v) {
#pragma unroll
    for (int o = 1; o < 64; o <<= 1) v += __shfl_xor(v, o);
    return v;
}

__global__ void __launch_bounds__(256) k_rmsnorm_bf16(const float* x, const float* g, bf16* out) {
    const int lane = threadIdx.x & 63, row = blockIdx.x * 4 + (threadIdx.x >> 6);
    const float4* xr = (const float4*)(x + (size_t)row * D) + lane;
    const float4* gr = (const float4*)g + lane;
    float4 v[4]; float s = 0.f;
#pragma unroll
    for (int j = 0; j < 4; ++j) { v[j] = xr[64 * j]; s += v[j].x * v[j].x + v[j].y * v[j].y + v[j].z * v[j].z + v[j].w * v[j].w; }
    const float r = rsqrtf(wave_sum(s) * (1.0f / D) + EPS);
    uint2* o = (uint2*)(out + (size_t)row * D) + lane;
#pragma unroll
    for (int j = 0; j < 4; ++j) { const float4 gg = gr[64 * j];
        uint2 w; w.x = (u32)f2bf(v[j].x * r * gg.x) | ((u32)f2bf(v[j].y * r * gg.y) << 16); w.y = (u32)f2bf(v[j].z * r * gg.z) | ((u32)f2bf(v[j].w * r * gg.w) << 16);
        o[64 * j] = w; }
}
template <int MODE> __global__ void __launch_bounds__(256) k_transpose(const float* W, int K, int N, bf16* out, int ldo, size_t in_stride, size_t out_stride) {
    __shared__ float tile[32][33];
    W += (size_t)blockIdx.z * in_stride; out += (size_t)blockIdx.z * out_stride;
    const int k0 = blockIdx.y * 32, n0 = blockIdx.x * 32, tx = threadIdx.x & 31, ty = threadIdx.x >> 5;
#pragma unroll
    for (int i = 0; i < 4; ++i) tile[ty + 8 * i][tx] = W[(size_t)(k0 + ty + 8 * i) * N + n0 + tx];
    __syncthreads();
#pragma unroll
    for (int i = 0; i < 4; ++i) { const int n = n0 + ty + 8 * i; const int row = MODE == 0 ? n : ((n >> 7) * 256 + (MODE == 2 ? 128 : 0) + (n & 127));
        out[(size_t)row * ldo + k0 + tx] = f2bf(tile[tx][ty + 8 * i]); }
}
__global__ void __launch_bounds__(256) k_fold_pool(const float* wg, const float* scale, const float* wpo, bf16* wtab) {
    const int d = blockIdx.x * 256 + threadIdx.x, k = blockIdx.y, gi = k >> 7, c = k & 127;
    float s = 0.f;
    for (int j = 0; j < 128; ++j) s += wg[(size_t)(gi * 128 + c) * 128 + j] * scale[gi * 128 + j] * wpo[(size_t)(gi * 128 + j) * D + d];
    wtab[(size_t)d * 1024 + k] = f2bf(s);
}

template <class P> __global__ void __launch_bounds__(256) k_sgemm(P p) {
    __shared__ float As[2][64][17];
    __shared__ float Bs[2][64][17];
    const int tx = threadIdx.x & 15, ty = threadIdx.x >> 4;
    const int row0 = blockIdx.y * 64, col0 = blockIdx.x * 64;
    if (row0 >= p.rows()) return;
    float acc1[4][4], acc2[4][4];
#pragma unroll
    for (int i = 0; i < 4; ++i)
#pragma unroll
        for (int j = 0; j < 4; ++j) { acc1[i][j] = 0.f; acc2[i][j] = 0.f; }
    const int lr = threadIdx.x >> 2, lk = (threadIdx.x & 3) * 4;
    const bf16* a1 = p.arow(row0 + lr, 0) + lk; const bf16* b1 = p.brow(col0 + lr, 0, row0) + lk;
    const bf16* a2 = p.arow(row0 + lr, 1) + lk; const bf16* b2 = p.brow(col0 + lr, 1, row0) + lk;
    for (int k0 = 0; k0 < p.K; k0 += 16) {
        { const uint2 va = *(const uint2*)(a1 + k0), vb = *(const uint2*)(b1 + k0);
          As[0][lr][lk + 0] = __uint_as_float(va.x << 16); As[0][lr][lk + 1] = __uint_as_float(va.x & 0xffff0000u); As[0][lr][lk + 2] = __uint_as_float(va.y << 16); As[0][lr][lk + 3] = __uint_as_float(va.y & 0xffff0000u);
          Bs[0][lr][lk + 0] = __uint_as_float(vb.x << 16); Bs[0][lr][lk + 1] = __uint_as_float(vb.x & 0xffff0000u); Bs[0][lr][lk + 2] = __uint_as_float(vb.y << 16); Bs[0][lr][lk + 3] = __uint_as_float(vb.y & 0xffff0000u); }
        if (P::DUAL) { const uint2 va = *(const uint2*)(a2 + k0), vb = *(const uint2*)(b2 + k0);
          As[1][lr][lk + 0] = __uint_as_float(va.x << 16); As[1][lr][lk + 1] = __uint_as_float(va.x & 0xffff0000u); As[1][lr][lk + 2] = __uint_as_float(va.y << 16); As[1][lr][lk + 3] = __uint_as_float(va.y & 0xffff0000u);
          Bs[1][lr][lk + 0] = __uint_as_float(vb.x << 16); Bs[1][lr][lk + 1] = __uint_as_float(vb.x & 0xffff0000u); Bs[1][lr][lk + 2] = __uint_as_float(vb.y << 16); Bs[1][lr][lk + 3] = __uint_as_float(vb.y & 0xffff0000u); }
        __syncthreads();
#pragma unroll
        for (int kk = 0; kk < 16; ++kk) {
            float a[4], b[4];
#pragma unroll
            for (int i = 0; i < 4; ++i) { a[i] = As[0][ty * 4 + i][kk]; b[i] = Bs[0][tx * 4 + i][kk]; }
#pragma unroll
            for (int i = 0; i < 4; ++i)
#pragma unroll
                for (int j = 0; j < 4; ++j) acc1[i][j] += a[i] * b[j];
            if (P::DUAL) {
#pragma unroll
                for (int i = 0; i < 4; ++i) { a[i] = As[1][ty * 4 + i][kk]; b[i] = Bs[1][tx * 4 + i][kk]; }
#pragma unroll
                for (int i = 0; i < 4; ++i)
#pragma unroll
                    for (int j = 0; j < 4; ++j) acc2[i][j] += a[i] * b[j];
            }
        }
        __syncthreads();
    }
#pragma unroll
    for (int i = 0; i < 4; ++i)
#pragma unroll
        for (int j = 0; j < 4; ++j) p.epi(row0 + ty * 4 + i, col0 + tx * 4 + j, acc1[i][j], acc2[i][j]);
}

struct P_S1 { static constexpr bool DUAL = false; int K; const bf16* H; const bf16* Wt; const float* bgate; bf16* ubcv; bf16* gates;
    __device__ int rows() const { return T; }
    __device__ const bf16* arow(int r, int) const { return H + (size_t)r * D; }
    __device__ const bf16* brow(int n, int, int) const { return Wt + (size_t)n * D; }
    __device__ void epi(int r, int n, float v, float) const { if (n < 2048) ubcv[(size_t)r * 2048 + n] = f2bf(v); else gates[(size_t)r * 2048 + n - 2048] = f2bf(sigmoidf_(v + bgate[n - 2048])); } };
struct P_S2B { static constexpr bool DUAL = true; int K; const bf16* AB; const bf16* Wt; const bf16* gates; bf16* merged;
    __device__ int rows() const { return T; }
    __device__ const bf16* arow(int r, int w) const { return AB + (size_t)r * 1024 + w * 512; }
    __device__ const bf16* brow(int n, int w, int) const { return Wt + (size_t)n * 1024 + w * 512; }
    __device__ void epi(int r, int n, float v1, float v2) const { const float ga = bf2f(gates[(size_t)r * 2048 + n]), gb = bf2f(gates[(size_t)r * 2048 + 1024 + n]); merged[(size_t)r * 1024 + n] = f2bf(ga * v1 + gb * v2); } };
struct P_S3 { static constexpr bool DUAL = false; int K; const bf16* A; const bf16* Wt; const float* x; float* out;
    __device__ int rows() const { return T; }
    __device__ const bf16* arow(int r, int) const { return A + (size_t)r * D; }
    __device__ const bf16* brow(int n, int, int) const { return Wt + (size_t)n * D; }
    __device__ void epi(int r, int n, float v, float) const { out[(size_t)r * D + n] = x[(size_t)r * D + n] + v; } };
struct P_S5 { static constexpr bool DUAL = true; int K; const bf16* H2; const bf16* egut; const int* rowtok; const int* off; const int* tilee; bf16* hid;
    __device__ int rows() const { return off[64] + T; }
    __device__ const bf16* arow(int r, int) const { return H2 + (size_t)rowtok[r] * D; }
    __device__ const bf16* brow(int n, int w, int row0) const { const int e = tilee[row0 >> 8]; return egut + ((size_t)e * 512 + (n >> 7) * 256 + w * 128 + (n & 127)) * D; }
    __device__ void epi(int r, int n, float g, float u) const { hid[(size_t)r * EH + n] = f2bf(g / (1.0f + expf(-g)) * u); } };
struct P_S6 { static constexpr bool DUAL = false; int K; const bf16* hid; const bf16* edt; const float* roww; const int* off; const int* tilee; bf16* y; int chalf;
    __device__ int rows() const { return off[64] + T; }
    __device__ const bf16* arow(int r, int) const { return hid + (size_t)r * EH; }
    __device__ const bf16* brow(int n, int, int row0) const { const int e = tilee[row0 >> 8]; return edt + ((size_t)e * 1024 + chalf * 512 + n) * EH; }
    __device__ void epi(int r, int n, float v, float) const { y[(size_t)r * 512 + n] = f2bf(roww[r] * v); } };

__global__ void __launch_bounds__(256) k_mixer(const bf16* ubcv, const float* convw, bf16* ab) {
    const int gid = blockIdx.x * 256 + threadIdx.x; const int t = gid >> 7, c8 = (gid & 127) * 8; const int s = t & (SEQ - 1);
    float o[8];
    if (c8 < 512) {
        const int w = 2 << (c8 >> 7); const int cnt = (s + 1) < w ? (s + 1) : w; float sum[8];
#pragma unroll
        for (int i = 0; i < 8; ++i) sum[i] = 0.f;
        float cur[8];
        for (int j = 0; j < cnt; ++j) { const uint4 v = *(const uint4*)(ubcv + (size_t)(t - j) * 2048 + c8); const u32 q[4] = {v.x, v.y, v.z, v.w};
#pragma unroll
            for (int i = 0; i < 4; ++i) { const float lo = __uint_as_float(q[i] << 16), hi = __uint_as_float(q[i] & 0xffff0000u); sum[2 * i] += lo; sum[2 * i + 1] += hi; if (j == 0) { cur[2 * i] = lo; cur[2 * i + 1] = hi; } } }
        const float inv = 1.0f / (float)cnt;
#pragma unroll
        for (int i = 0; i < 8; ++i) o[i] = sum[i] * inv - cur[i];
    } else {
        const int c = c8 - 512;
#pragma unroll
        for (int i = 0; i < 8; ++i) o[i] = 0.f;
#pragma unroll
        for (int j = 0; j < 3; ++j) {
            const int dt = 2 - j; if (s - dt < 0) continue;
            const uint4 gc = *(const uint4*)(ubcv + (size_t)(t - dt) * 2048 + 1024 + c), vv = *(const uint4*)(ubcv + (size_t)(t - dt) * 2048 + 1536 + c);
            const u32 a[4] = {gc.x, gc.y, gc.z, gc.w}, b[4] = {vv.x, vv.y, vv.z, vv.w};
#pragma unroll
            for (int i = 0; i < 4; ++i) { o[2 * i] += convw[j * 512 + c + 2 * i] * (__uint_as_float(a[i] << 16) * __uint_as_float(b[i] << 16));
                o[2 * i + 1] += convw[j * 512 + c + 2 * i + 1] * (__uint_as_float(a[i] & 0xffff0000u) * __uint_as_float(b[i] & 0xffff0000u)); } }
        const uint4 gb = *(const uint4*)(ubcv + (size_t)t * 2048 + 512 + c); const u32 g[4] = {gb.x, gb.y, gb.z, gb.w};
#pragma unroll
        for (int i = 0; i < 4; ++i) { o[2 * i] *= __uint_as_float(g[i] << 16); o[2 * i + 1] *= __uint_as_float(g[i] & 0xffff0000u); }
    }
    uint4 w; w.x = (u32)f2bf(o[0]) | ((u32)f2bf(o[1]) << 16); w.y = (u32)f2bf(o[2]) | ((u32)f2bf(o[3]) << 16); w.z = (u32)f2bf(o[4]) | ((u32)f2bf(o[5]) << 16); w.w = (u32)f2bf(o[6]) | ((u32)f2bf(o[7]) << 16);
    *(uint4*)(ab + (size_t)t * 1024 + c8) = w;
}

__global__ void __launch_bounds__(256) k_router(const float* xmid, const float* gffn, const float* wrouter, const float* rbias, bf16* h2, int* tope, float* topw, u32* ctl) {
    __shared__ float hs[16][1024];
    __shared__ float sc[16][64];
    __shared__ float sel[16][64];
    __shared__ int hist[64];
    const int tid = threadIdx.x, lane = tid & 63, w = tid >> 6, t0 = blockIdx.x * 16;
    if (tid < 64) hist[tid] = 0;
    for (int tt = 0; tt < 4; ++tt) {
        const int tl = w * 4 + tt, tok = t0 + tl;
        const float4* xr = (const float4*)(xmid + (size_t)tok * D) + lane; const float4* gr = (const float4*)gffn + lane;
        float4 v[4]; float s = 0.f;
#pragma unroll
        for (int j = 0; j < 4; ++j) { v[j] = xr[64 * j]; s += v[j].x * v[j].x + v[j].y * v[j].y + v[j].z * v[j].z + v[j].w * v[j].w; }
        const float r = rsqrtf(wave_sum(s) * (1.0f / D) + EPS);
        uint2* o = (uint2*)(h2 + (size_t)tok * D) + lane;
#pragma unroll
        for (int j = 0; j < 4; ++j) { const float4 gg = gr[64 * j]; float4 h; h.x = v[j].x * r * gg.x; h.y = v[j].y * r * gg.y; h.z = v[j].z * r * gg.z; h.w = v[j].w * r * gg.w;
            *(float4*)&hs[tl][(lane + 64 * j) * 4] = h;
            uint2 q; q.x = (u32)f2bf(h.x) | ((u32)f2bf(h.y) << 16); q.y = (u32)f2bf(h.z) | ((u32)f2bf(h.w) << 16); o[64 * j] = q; }
    }
    __syncthreads();
    { const int e = tid & 63, q = tid >> 6; float a0 = 0.f, a1 = 0.f, a2 = 0.f, a3 = 0.f;
      for (int k = 0; k < D; ++k) { const float wv = wrouter[(size_t)k * NE + e]; a0 += hs[q * 4 + 0][k] * wv; a1 += hs[q * 4 + 1][k] * wv; a2 += hs[q * 4 + 2][k] * wv; a3 += hs[q * 4 + 3][k] * wv; }
      const float b = rbias[e]; float s;
      s = sigmoidf_(a0); sc[q * 4 + 0][e] = s; sel[q * 4 + 0][e] = s + b;
      s = sigmoidf_(a1); sc[q * 4 + 1][e] = s; sel[q * 4 + 1][e] = s + b;
      s = sigmoidf_(a2); sc[q * 4 + 2][e] = s; sel[q * 4 + 2][e] = s + b;
      s = sigmoidf_(a3); sc[q * 4 + 3][e] = s; sel[q * 4 + 3][e] = s + b; }
    __syncthreads();
    if (tid < 16) {
        const int tok = t0 + tid; float wsum = 0.f; float wk[8]; int ek[8];
#pragma unroll
        for (int j = 0; j < 8; ++j) { float best = -3.0e38f; int bi = 0;
            for (int e = 0; e < NE; ++e) { const float s = sel[tid][e]; if (s > best) { best = s; bi = e; } }
            sel[tid][bi] = -3.0e38f; ek[j] = bi; wk[j] = sc[tid][bi]; wsum += wk[j]; }
#pragma unroll
        for (int j = 0; j < 8; ++j) { tope[tok * 8 + j] = ek[j]; topw[tok * 8 + j] = wk[j] / wsum * ROUTED_SCALE; atomicAdd(&hist[ek[j]], 1); }
    }
    __syncthreads();
    if (tid < 64 && hist[tid]) atomicAdd(&ctl[CW_CNT + tid], (u32)hist[tid]);
}
__global__ void k_route_offsets(const u32* ctl, int* off, int* tilee) {
    __shared__ int so[65];
    if (threadIdx.x == 0) { int a = 0; for (int e = 0; e < NE; ++e) { so[e] = a; a += ((int)ctl[CW_CNT + e] + 255) & ~255; } so[64] = a; }
    __syncthreads();
    for (int e = threadIdx.x; e < 65; e += 64) off[e] = so[e];
    const int e = threadIdx.x;
    for (int rt = so[e] >> 8; rt < (so[e + 1] >> 8); ++rt) tilee[rt] = e;
    for (int i = threadIdx.x; i < 64; i += 64) tilee[(so[64] >> 8) + i] = 64;
}
__global__ void __launch_bounds__(256) k_route_fill(const int* off, int* rowtok, float* roww) {
    const int total = off[64];
    for (int i = blockIdx.x * 256 + threadIdx.x; i < MAXROWS; i += gridDim.x * 256) {
        const bool sh = (i >= total && i < total + T);
        rowtok[i] = sh ? i - total : 0; roww[i] = sh ? 1.0f : 0.0f; }
}
__global__ void __launch_bounds__(256) k_route_scatter(const int* tope, const float* topw, const int* off, u32* ctl, int* rowtok, float* roww, int* inv) {
    const int i = blockIdx.x * 256 + threadIdx.x; if (i >= T * TOPK) return;
    const int e = tope[i]; const int pos = off[e] + (int)atomicAdd(&ctl[CW_CUR + e], 1u);
    rowtok[pos] = i >> 3; roww[pos] = topw[i]; inv[i] = pos;
}
__global__ void __launch_bounds__(256) k_combine(const bf16* y, const int* inv, const int* off, float* out, int chalf) {
    const int gid = blockIdx.x * 256 + threadIdx.x; const int t = gid >> 6, c8 = (gid & 63) * 8; const int total = off[64];
    float a[8]; float* o = out + (size_t)t * D + chalf * 512 + c8;
    { const float4 p = *(const float4*)o, q = *(const float4*)(o + 4); a[0] = p.x; a[1] = p.y; a[2] = p.z; a[3] = p.w; a[4] = q.x; a[5] = q.y; a[6] = q.z; a[7] = q.w; }
    for (int k = 0; k < 9; ++k) { const int pos = k < 8 ? inv[t * 8 + k] : total + t; const uint4 v = *(const uint4*)(y + (size_t)pos * 512 + c8); const u32 q[4] = {v.x, v.y, v.z, v.w};
#pragma unroll
        for (int i = 0; i < 4; ++i) { a[2 * i] += __uint_as_float(q[i] << 16); a[2 * i + 1] += __uint_as_float(q[i] & 0xffff0000u); } }
    *(float4*)o = make_float4(a[0], a[1], a[2], a[3]); *(float4*)(o + 4) = make_float4(a[4], a[5], a[6], a[7]);
}
__global__ void __launch_bounds__(256) k_final_norm(float* out, const float* g) {
    const int lane = threadIdx.x & 63, row = blockIdx.x * 4 + (threadIdx.x >> 6);
    float4* xr = (float4*)(out + (size_t)row * D) + lane; const float4* gr = (const float4*)g + lane;
    float4 v[4]; float s = 0.f;
#pragma unroll
    for (int j = 0; j < 4; ++j) { v[j] = xr[64 * j]; s += v[j].x * v[j].x + v[j].y * v[j].y + v[j].z * v[j].z + v[j].w * v[j].w; }
    const float r = rsqrtf(wave_sum(s) * (1.0f / D) + EPS);
#pragma unroll
    for (int j = 0; j < 4; ++j) { const float4 gg = gr[64 * j]; xr[64 * j] = make_float4(v[j].x * r * gg.x, v[j].y * r * gg.y, v[j].z * r * gg.z, v[j].w * r * gg.w); }
}

extern "C" void kernel_launch(void* const* d_in, const int* in_sizes, int n_in, void* d_out, int out_size, void* d_ws, size_t ws_size, hipStream_t stream) {
    if (n_in != 20 || ws_size < WS_END || out_size != T * D) { fprintf(stderr, "kernel_launch: unexpected shapes / workspace (%zu)\n", ws_size); return; }
    const float* x = (const float*)d_in[0]; const float* g_mix = (const float*)d_in[1]; const float* w_in = (const float*)d_in[2]; const float* b_gate = (const float*)d_in[3];
    const float* w_pool_group = (const float*)d_in[4]; const float* pool_scale = (const float*)d_in[5]; const float* w_pool_out = (const float*)d_in[6]; const float* conv_w = (const float*)d_in[7];
    const float* w_conv_out = (const float*)d_in[8]; const float* w_o = (const float*)d_in[9]; const float* g_ffn = (const float*)d_in[10]; const float* w_router = (const float*)d_in[11];
    const float* router_bias = (const float*)d_in[12]; const float* e_gate = (const float*)d_in[13]; const float* e_up = (const float*)d_in[14]; const float* e_down = (const float*)d_in[15];
    const float* s_gate = (const float*)d_in[16]; const float* s_up = (const float*)d_in[17]; const float* s_down = (const float*)d_in[18]; const float* g_final = (const float*)d_in[19];
    unsigned char* ws = (unsigned char*)d_ws; float* out = (float*)d_out;
    u32* ctl = (u32*)(ws + WS_CTL); int* tope = (int*)(ws + WS_TOPE); float* topw = (float*)(ws + WS_TOPW); int* inv = (int*)(ws + WS_INV);
    int* rowtok = (int*)(ws + WS_ROWTOK); float* roww = (float*)(ws + WS_ROWW); int* off = (int*)(ws + WS_OFF); int* tilee = (int*)(ws + WS_TILEE);
    bf16* edt = (bf16*)(ws + WS_EDT); bf16* wtin = (bf16*)(ws + WS_WTIN); bf16* wtab = (bf16*)(ws + WS_WTAB); bf16* wto = (bf16*)(ws + WS_WTO); bf16* egut = (bf16*)(ws + WS_EGUT);
    bf16* H = (bf16*)(ws + WS_H); bf16* AB = H; bf16* H2 = H; bf16* ubcv = (bf16*)(ws + WS_UBCV); bf16* merged = ubcv; bf16* gates = (bf16*)(ws + WS_GATES);
    bf16* hid = (bf16*)(ws + WS_HID); bf16* y = (bf16*)(ws + WS_Y);

    hipMemsetAsync(ws + WS_CTL, 0, CTL_BYTES, stream);
    k_rmsnorm_bf16<<<T / 4, 256, 0, stream>>>(x, g_mix, H);
    k_transpose<0><<<dim3(NIN / 32, D / 32, 1), 256, 0, stream>>>(w_in, D, NIN, wtin, D, 0, 0);
    k_fold_pool<<<dim3(4, 512), 256, 0, stream>>>(w_pool_group, pool_scale, w_pool_out, wtab);
    k_transpose<0><<<dim3(D / 32, 512 / 32, 1), 256, 0, stream>>>(w_conv_out, 512, D, wtab + 512, 1024, 0, 0);
    k_transpose<0><<<dim3(D / 32, D / 32, 1), 256, 0, stream>>>(w_o, D, D, wto, D, 0, 0);
    k_transpose<1><<<dim3(EH / 32, D / 32, NE), 256, 0, stream>>>(e_gate, D, EH, egut, D, (size_t)D * EH, (size_t)512 * D);
    k_transpose<2><<<dim3(EH / 32, D / 32, NE), 256, 0, stream>>>(e_up, D, EH, egut, D, (size_t)D * EH, (size_t)512 * D);
    k_transpose<1><<<dim3(EH / 32, D / 32, 1), 256, 0, stream>>>(s_gate, D, EH, egut + (size_t)64 * 512 * D, D, 0, 0);
    k_transpose<2><<<dim3(EH / 32, D / 32, 1), 256, 0, stream>>>(s_up, D, EH, egut + (size_t)64 * 512 * D, D, 0, 0);
    k_transpose<0><<<dim3(D / 32, EH / 32, NE), 256, 0, stream>>>(e_down, EH, D, edt, EH, (size_t)EH * D, (size_t)D * EH);
    k_transpose<0><<<dim3(D / 32, EH / 32, 1), 256, 0, stream>>>(s_down, EH, D, edt + (size_t)64 * D * EH, EH, 0, 0);
    { P_S1 p{D, H, wtin, b_gate, ubcv, gates}; k_sgemm<P_S1><<<dim3(NIN / 64, T / 64), 256, 0, stream>>>(p); }
    k_mixer<<<T * 128 / 256, 256, 0, stream>>>(ubcv, conv_w, AB);
    { P_S2B p{512, AB, wtab, gates, merged}; k_sgemm<P_S2B><<<dim3(D / 64, T / 64), 256, 0, stream>>>(p); }
    { P_S3 p{D, merged, wto, x, out}; k_sgemm<P_S3><<<dim3(D / 64, T / 64), 256, 0, stream>>>(p); }
    k_router<<<T / 16, 256, 0, stream>>>(out, g_ffn, w_router, router_bias, H2, tope, topw, ctl);
    k_route_offsets<<<1, 64, 0, stream>>>(ctl, off, tilee);
    k_route_fill<<<256, 256, 0, stream>>>(off, rowtok, roww);
    k_route_scatter<<<T * TOPK / 256, 256, 0, stream>>>(tope, topw, off, ctl, rowtok, roww, inv);
    { P_S5 p{D, H2, egut, rowtok, off, tilee, hid}; k_sgemm<P_S5><<<dim3(EH / 64, MAXROWS / 64), 256, 0, stream>>>(p); }
    for (int c = 0; c < 2; ++c) {
        P_S6 p{EH, hid, edt, roww, off, tilee, y, c}; k_sgemm<P_S6><<<dim3(512 / 64, MAXROWS / 64), 256, 0, stream>>>(p);
        k_combine<<<T * 64 / 256, 256, 0, stream>>>(y, inv, off, out, c);
    }
    k_final_norm<<<T / 4, 256, 0, stream>>>(out, g_final);
}
```

```cpp
#include <hip/hip_runtime.h>
#include <stdint.h>
#include <cstdio>

#ifndef MK_PER_PHASE
#define MK_PER_PHASE 0
#endif

typedef unsigned short bf16;
typedef unsigned int u32;
#define GAS __attribute__((address_space(1)))
#define LAS __attribute__((address_space(3)))
typedef float f32x4 __attribute__((ext_vector_type(4)));
typedef short bf16x8 __attribute__((ext_vector_type(8)));
typedef unsigned u32x4 __attribute__((ext_vector_type(4)));
typedef unsigned u32x2 __attribute__((ext_vector_type(2)));
#define RLX_AGENT __ATOMIC_RELAXED, __HIP_MEMORY_SCOPE_AGENT

constexpr int T = 16384, D = 1024, SEQ = 2048, NIN = 4096;
constexpr int NE = 64, TOPK = 8, EH = 256;
constexpr float EPS = 1e-6f, ROUTED_SCALE = 2.5f;
constexpr int MAXROWS = T * TOPK + NE * 256 + T;
constexpr int NWAVES = 8, NTHR = 512;

constexpr size_t MiB = 1u << 20;
constexpr size_t WS_CTL = 0, CTL_BYTES = 1 * MiB;
constexpr size_t WS_TOPE = 1 * MiB;
constexpr size_t WS_TOPW = WS_TOPE + 512 * 1024;
constexpr size_t WS_INV = WS_TOPW + 512 * 1024;
constexpr size_t WS_ROWTOK = WS_INV + 512 * 1024;
constexpr size_t WS_ROWW = WS_ROWTOK + 640 * 1024;
constexpr size_t WS_OFF = WS_ROWW + 640 * 1024;
constexpr size_t WS_TILEE = WS_OFF + 1024;
constexpr size_t WS_EDT = 5 * MiB;
constexpr size_t WS_WTIN = 38 * MiB;
constexpr size_t WS_WTAB = 46 * MiB;
constexpr size_t WS_WTO = 48 * MiB;
constexpr size_t WS_EGUT = 51 * MiB;
constexpr size_t WS_H = 116 * MiB;
constexpr size_t WS_UBCV = 148 * MiB;
constexpr size_t WS_GATES = 212 * MiB;
constexpr size_t WS_HID = 203 * MiB;
constexpr size_t WS_Y = 38 * MiB;
constexpr size_t WS_END = 283 * MiB;
static_assert(WS_TILEE + 4096 <= WS_EDT, "tables");
static_assert(WS_EDT + (size_t)65 * 1024 * 256 * 2 <= WS_WTIN, "edt");
static_assert(WS_EGUT + (size_t)65 * 512 * 1024 * 2 <= WS_H, "egut");
static_assert(WS_HID + (size_t)MAXROWS * 256 * 2 <= WS_END, "hid");
static_assert(WS_Y + (size_t)MAXROWS * 512 * 2 <= WS_HID, "y");
static_assert(WS_GATES + (size_t)T * 2048 * 2 <= WS_END, "gates");
constexpr int CW_CNT = 0, CW_CUR = 64;
constexpr int CW_BAR = 4096;

constexpr int RING_BYTES = 131072;
constexpr int LDSCTL_OFF = RING_BYTES, MISC_OFF = LDSCTL_OFF + 320;
constexpr int LDS_BYTES = 147456;

__device__ __forceinline__ float bf2f(bf16 b) { return __uint_as_float(((u32)b) << 16); }
__device__ __forceinline__ float bflo(u32 w) { return __uint_as_float(w << 16); }
__device__ __forceinline__ float bfhi(u32 w) { return __uint_as_float(w & 0xffff0000u); }
__device__ __forceinline__ u32 f2bf(float f) { u32 u = __float_as_uint(f); return (u + 0x7fffu + ((u >> 16) & 1u)) >> 16; }
__device__ __forceinline__ u32 pk2(float lo, float hi) { return f2bf(lo) | (f2bf(hi) << 16); }
__device__ __forceinline__ float sigmoid_fast(float x) { return __builtin_amdgcn_rcpf(1.0f + __expf(-x)); }
__device__ __forceinline__ float sigmoid_acc(float x) { return 1.0f / (1.0f + expf(-x)); }
__device__ __forceinline__ float wave_sum(float v) {
#pragma unroll
    for (int o = 1; o < 64; o <<= 1) v += __shfl_xor(v, o);
    return v;
}
#define LDS_WAIT() asm volatile("s_waitcnt lgkmcnt(0)" ::: "memory")
#define VM_WAIT() asm volatile("s_waitcnt vmcnt(0)" ::: "memory")
__device__ __forceinline__ int ld_agent(const int* p) { return (int)__hip_atomic_load((const u32*)p, RLX_AGENT); }

namespace pg8 {
constexpr int BM = 256, BK = 64, HALF = 128, HTB = HALF * BK * 2, STAGE_BYTES = 8 * HTB, NXCD = 8, WGM = 8;
__host__ __device__ __forceinline__ int lds_byte(int r, int c) { const int st = (r >> 4) * 2 + (c >> 5), rr = r & 15, cc = c & 31, ob = rr * 64 + cc * 2; return st * 1024 + (ob ^ (((ob >> 9) & 1) << 5)); }
__host__ __device__ __forceinline__ void stage_rc(int b, int& R, int& C) { const int st = b / 1024, sb = b % 1024, swz = sb ^ (((sb >> 9) & 1) << 5); R = (st >> 1) * 16 + swz / 64; C = (st & 1) * 32 + (swz % 64) / 2; }
__host__ __device__ __forceinline__ int perm32(int rho) { const int n = rho >> 4, i = rho & 15; return 8 * (i >> 2) + 4 * n + (i & 3); }

struct Unit { int pm, pn, aux; };

__device__ __forceinline__ int xcd_remap(int L, int nwg) { const int q = nwg / NXCD, r = nwg % NXCD, xcd = L % NXCD, o = L / NXCD; return (xcd < r ? xcd * (q + 1) : r * (q + 1) + (xcd - r) * q) + o; }

struct RegOrder {
    static constexpr bool GATHER = false;
    const char* A; const char* Bt; int lda, ldb;
    int nM, nN, nwg, G, c, halves, khalf;
    __device__ __forceinline__ void init(const void* A_, const void* Bt_, int lda_, int ldb_, int M, int N, int G_, int c_, int halves_, int khalf_) {
        A = (const char*)A_; Bt = (const char*)Bt_; lda = lda_; ldb = ldb_; nM = M / BM; nN = N / BM; nwg = nM * nN; G = G_; c = c_; halves = halves_; khalf = khalf_; }
    __device__ __forceinline__ bool next(int i, Unit& u) const {
        const int round = (halves == 2) ? (i >> 1) : i; u.aux = (halves == 2) ? (i & 1) : 0;
        const long L = (long)round * G + c; if (L >= nwg) return false;
        const int wgid = xcd_remap((int)L, nwg);
        const int nig = WGM * nN, gid = wgid / nig, fm = gid * WGM, gsz = (nM - fm) < WGM ? (nM - fm) : WGM;
        u.pm = fm + ((wgid % nig) % gsz); u.pn = (wgid % nig) / gsz; return true;
    }
    __device__ __forceinline__ const char* a_base(const Unit& u) const { return A + (size_t)u.pm * BM * lda * 2 + (size_t)u.aux * khalf; }
    __device__ __forceinline__ const char* b_base(const Unit& u) const { return Bt + (size_t)u.pn * BM * ldb * 2 + (size_t)u.aux * khalf; }
    __device__ __forceinline__ unsigned a_row_off(const Unit&, int) const { return 0u; }
};
template <bool GATHER_> struct MoeOrder {
    static constexpr bool GATHER = GATHER_;
    const char* A; const char* Bt; int lda, ldb; const int* rowtok; const int* tilee; int nunits, npn, G, c; size_t estride, bextra;
    __device__ __forceinline__ bool next(int i, Unit& u) const {
        const long L = (long)i * G + c; if (L >= nunits) return false;
        const int wgid = xcd_remap((int)L, nunits);
        u.pm = wgid / npn; u.pn = wgid - u.pm * npn; u.aux = __builtin_amdgcn_readfirstlane(ld_agent(tilee + u.pm)); return true;
    }
    __device__ __forceinline__ const char* a_base(const Unit& u) const { return GATHER ? A : A + (size_t)u.pm * BM * lda * 2; }
    __device__ __forceinline__ const char* b_base(const Unit& u) const { return Bt + (size_t)u.aux * estride + bextra + (size_t)u.pn * BM * ldb * 2; }
    __device__ __forceinline__ unsigned a_row_off(const Unit& u, int r) const { return (unsigned)rowtok[u.pm * BM + r] * (unsigned)(lda * 2); }
};

__device__ __forceinline__ unsigned cvt_pk_bf16(float lo, float hi) { unsigned r; asm volatile("v_cvt_pk_bf16_f32 %0, %1, %2" : "=v"(r) : "v"(lo), "v"(hi)); return r; }

struct EpiS1 { static constexpr bool PERM = true;
    bf16* ubcv; bf16* gates; const float* bgate;
    __device__ __forceinline__ void operator()(const f32x4 (&acc)[2][2][4][2], const Unit& u, int wr, int wc, int fr, int fq) const {
        const int row0 = u.pm * BM + wr * 64 + fr; int colt = u.pn * BM; const bool isg = colt >= 2048; bf16* base = isg ? gates : ubcv; if (isg) colt -= 2048;
        const int col0 = colt + wc * 32 + 8 * fq;
        f32x4 bv[2][2];
#pragma unroll
        for (int bj = 0; bj < 2; ++bj)
#pragma unroll
            for (int n = 0; n < 2; ++n) bv[bj][n] = isg ? *(const f32x4*)(bgate + col0 + bj * HALF + 4 * n) : (f32x4){0.f, 0.f, 0.f, 0.f};
#pragma unroll
        for (int ai = 0; ai < 2; ++ai)
#pragma unroll
            for (int m = 0; m < 4; ++m) { bf16* rowp = base + (size_t)(row0 + ai * HALF + m * 16) * 2048 + col0;
#pragma unroll
                for (int bj = 0; bj < 2; ++bj) { f32x4 v0 = acc[ai][bj][m][0] + bv[bj][0], v1 = acc[ai][bj][m][1] + bv[bj][1];
                    if (isg) {
#pragma unroll
                        for (int j = 0; j < 4; ++j) { v0[j] = sigmoid_fast(v0[j]); v1[j] = sigmoid_fast(v1[j]); } }
                    u32x4 w; w.x = cvt_pk_bf16(v0[0], v0[1]); w.y = cvt_pk_bf16(v0[2], v0[3]); w.z = cvt_pk_bf16(v1[0], v1[1]); w.w = cvt_pk_bf16(v1[2], v1[3]);
                    *(u32x4*)(rowp + bj * HALF) = w; } }
    }
};
struct EpiS2B { static constexpr bool PERM = true;
    const bf16* gates; float* part; bf16* merged;
    __device__ __forceinline__ void operator()(const f32x4 (&acc)[2][2][4][2], const Unit& u, int wr, int wc, int fr, int fq) const {
        const int row0 = u.pm * BM + wr * 64 + fr, col0 = u.pn * BM + wc * 32 + 8 * fq; const int goff = u.aux ? 1024 : 0;
#pragma unroll
        for (int ai = 0; ai < 2; ++ai)
#pragma unroll
            for (int m = 0; m < 4; ++m) { const size_t r = (size_t)(row0 + ai * HALF + m * 16);
#pragma unroll
                for (int bj = 0; bj < 2; ++bj) { const int c = col0 + bj * HALF;
                    const u32x4 g = *(const u32x4*)(gates + r * 2048 + goff + c);
                    f32x4 v0 = acc[ai][bj][m][0], v1 = acc[ai][bj][m][1];
                    v0[0] *= bflo(g.x); v0[1] *= bfhi(g.x); v0[2] *= bflo(g.y); v0[3] *= bfhi(g.y); v1[0] *= bflo(g.z); v1[1] *= bfhi(g.z); v1[2] *= bflo(g.w); v1[3] *= bfhi(g.w);
                    float* pp = part + r * 1024 + c;
                    if (u.aux == 0) { *(f32x4*)pp = v0; *(f32x4*)(pp + 4) = v1; }
                    else { v0 += *(const f32x4*)pp; v1 += *(const f32x4*)(pp + 4);
                        u32x4 w; w.x = cvt_pk_bf16(v0[0], v0[1]); w.y = cvt_pk_bf16(v0[2], v0[3]); w.z = cvt_pk_bf16(v1[0], v1[1]); w.w = cvt_pk_bf16(v1[2], v1[3]);
                        *(u32x4*)(merged + r * 1024 + c) = w; } } }
    }
};
struct EpiS3 { static constexpr bool PERM = false;
    const float* x; float* out;
    __device__ __forceinline__ void operator()(const f32x4 (&acc)[2][2][4][2], const Unit& u, int wr, int wc, int fr, int fq) const {
        const int row0 = u.pm * BM + wr * 64 + fr, col0 = u.pn * BM + wc * 32 + 4 * fq;
#pragma unroll
        for (int ai = 0; ai < 2; ++ai)
#pragma unroll
            for (int m = 0; m < 4; ++m) { const size_t o = (size_t)(row0 + ai * HALF + m * 16) * D + col0;
#pragma unroll
                for (int bj = 0; bj < 2; ++bj)
#pragma unroll
                    for (int n = 0; n < 2; ++n) { const f32x4 xs = *(const f32x4*)(x + o + bj * HALF + n * 16); *(f32x4*)(out + o + bj * HALF + n * 16) = xs + acc[ai][bj][m][n]; } }
    }
};
struct EpiS5 { static constexpr bool PERM = true;
    bf16* hid;
    __device__ __forceinline__ void operator()(const f32x4 (&acc)[2][2][4][2], const Unit& u, int wr, int wc, int fr, int fq) const {
        const int row0 = u.pm * BM + wr * 64 + fr, col0 = u.pn * HALF + wc * 32 + 8 * fq;
#pragma unroll
        for (int ai = 0; ai < 2; ++ai)
#pragma unroll
            for (int m = 0; m < 4; ++m) { f32x4 h0, h1;
#pragma unroll
                for (int j = 0; j < 4; ++j) { const float g0 = acc[ai][0][m][0][j], g1 = acc[ai][0][m][1][j];
                    h0[j] = g0 * sigmoid_fast(g0) * acc[ai][1][m][0][j]; h1[j] = g1 * sigmoid_fast(g1) * acc[ai][1][m][1][j]; }
                u32x4 w; w.x = cvt_pk_bf16(h0[0], h0[1]); w.y = cvt_pk_bf16(h0[2], h0[3]); w.z = cvt_pk_bf16(h1[0], h1[1]); w.w = cvt_pk_bf16(h1[2], h1[3]);
                *(u32x4*)(hid + (size_t)(row0 + ai * HALF + m * 16) * EH + col0) = w; }
    }
};
struct EpiS6 { static constexpr bool PERM = true;
    const float* roww; bf16* y;
    __device__ __forceinline__ void operator()(const f32x4 (&acc)[2][2][4][2], const Unit& u, int wr, int wc, int fr, int fq) const {
        const int row0 = u.pm * BM + wr * 64 + fr, col0 = u.pn * BM + wc * 32 + 8 * fq;
#pragma unroll
        for (int ai = 0; ai < 2; ++ai)
#pragma unroll
            for (int m = 0; m < 4; ++m) { const int r = row0 + ai * HALF + m * 16; const float w8 = roww[r];
#pragma unroll
                for (int bj = 0; bj < 2; ++bj) { const f32x4 v0 = acc[ai][bj][m][0] * w8, v1 = acc[ai][bj][m][1] * w8;
                    u32x4 w; w.x = cvt_pk_bf16(v0[0], v0[1]); w.y = cvt_pk_bf16(v0[2], v0[3]); w.z = cvt_pk_bf16(v1[0], v1[1]); w.w = cvt_pk_bf16(v1[2], v1[3]);
                    *(u32x4*)(y + (size_t)r * 512 + col0 + bj * HALF) = w; } }
    }
};

template <class Epi, class Sched, bool ALIGN_EPI, bool SP2>
__device__ __forceinline__ void gemm_phase(LAS unsigned char* lds, const Sched& S, const Epi& E, const int nt) {
    const int tid = threadIdx.x, wid = __builtin_amdgcn_readfirstlane(tid >> 6), lane = tid & 63, wr = wid >> 2, wc = wid & 3, fr = lane & 15, fq = lane >> 4;
    const int lda = S.lda, ldb = S.ldb;
    unsigned voffA[2], voffB[2], colA[2]; int RA[2];
#pragma unroll
    for (int i = 0; i < 2; ++i) { int R, C; stage_rc(tid * 16 + i * 8192, R, C); const int Rb = Epi::PERM ? ((R & ~31) + perm32(R & 31)) : R;
        voffA[i] = (unsigned)(R * lda + C) * 2u; voffB[i] = (unsigned)(Rb * ldb + C) * 2u; RA[i] = R; colA[i] = (unsigned)C * 2u; }
    const size_t kstep = (size_t)(BK * 2);
    const size_t hstepA = (size_t)HALF * lda * 2, hstepB = (size_t)HALF * ldb * 2;
    const unsigned ldsw = (unsigned)wid * 1024u;
    const int aoff = lds_byte(wr * 64 + fr, fq * 8), boff = lds_byte(wc * 32 + fr, fq * 8);
#define PG8_SA(b, h) (((b) * 2 + (h)) * HTB)
#define PG8_SB(b, h) ((4 + (b) * 2 + (h)) * HTB)
#define PG8_GLDS(gp, lp) __builtin_amdgcn_global_load_lds((const unsigned*)(gp), (LAS unsigned*)(lp), 16, 0, 0)
#define PG8_STAGE_A(bufoff, wn, h, kb) do { _Pragma("unroll") for (int _i = 0; _i < 2; ++_i) { \
        const char* _p = Sched::GATHER ? (((wn) ? nA : cA) + (kb) + ((wn) ? gn[h][_i] : ga[h][_i])) : (((wn) ? nA : cA) + (size_t)(h) * hstepA + (kb) + voffA[_i]); \
        PG8_GLDS(_p, lds + (bufoff) + ldsw + _i * 8192); } } while (0)
#define PG8_STAGE_B(bufoff, gbase) do { _Pragma("unroll") for (int _i = 0; _i < 2; ++_i) PG8_GLDS((const char*)(gbase) + voffB[_i], lds + (bufoff) + ldsw + _i * 8192); } while (0)
#define PG8_LDA(dst, b, h) do { _Pragma("unroll") for (int m = 0; m < 4; ++m) _Pragma("unroll") for (int k = 0; k < 2; ++k) dst[m][k] = *(const LAS bf16x8*)(lds + PG8_SA(b, h) + aoff + m * 2048 + k * 1024); } while (0)
#define PG8_LDB(dst, b, h) do { _Pragma("unroll") for (int n = 0; n < 2; ++n) _Pragma("unroll") for (int k = 0; k < 2; ++k) dst[n][k] = *(const LAS bf16x8*)(lds + PG8_SB(b, h) + boff + n * 2048 + k * 1024); } while (0)
#define PG8_MMA(ai, bj, At, Bt) do { __builtin_amdgcn_s_setprio(1); _Pragma("unroll") for (int m = 0; m < 4; ++m) _Pragma("unroll") for (int n = 0; n < 2; ++n) _Pragma("unroll") for (int k = 0; k < 2; ++k) \
        acc[ai][bj][m][n] = __builtin_amdgcn_mfma_f32_16x16x32_bf16(Bt[n][k], At[m][k], acc[ai][bj][m][n], 0, 0, 0); __builtin_amdgcn_s_setprio(0); } while (0)
#define PG8_WAIT_V(n) asm volatile("s_waitcnt vmcnt(" #n ")" ::: "memory")
#define PG8_WAIT_L(n) asm volatile("s_waitcnt lgkmcnt(" #n ")" ::: "memory")
#define PG8_BAR __builtin_amdgcn_s_barrier()
#define PG8_SCHED __builtin_amdgcn_sched_barrier(0)
    Unit cur, nxt; int ui = 0;
    if (!S.next(0, cur)) return;
    f32x4 acc[2][2][4][2];
#pragma unroll
    for (int a = 0; a < 2; ++a)
#pragma unroll
        for (int b = 0; b < 2; ++b)
#pragma unroll
            for (int m = 0; m < 4; ++m)
#pragma unroll
                for (int n = 0; n < 2; ++n) acc[a][b][m][n] = (f32x4){0.f, 0.f, 0.f, 0.f};
    bf16x8 At[4][2], B0[2][2], B1[2][2];
    unsigned ga[2][2], gn[2][2];
#pragma unroll
    for (int h = 0; h < 2; ++h)
#pragma unroll
        for (int i = 0; i < 2; ++i) { ga[h][i] = Sched::GATHER ? S.a_row_off(cur, h * HALF + RA[i]) + colA[i] : 0u; gn[h][i] = ga[h][i]; }
    const char* cA = S.a_base(cur); const char* cB = S.b_base(cur);
    const char* nA = cA; const char* nB = cB;
    if constexpr (SP2) {
        PG8_STAGE_B(PG8_SB(0, 0), cB); PG8_STAGE_B(PG8_SB(0, 1), cB + hstepB); PG8_STAGE_A(PG8_SA(0, 0), false, 0, 0); PG8_STAGE_A(PG8_SA(0, 1), false, 1, 0);
        if (wr == 1) PG8_BAR;
        PG8_WAIT_V(2); PG8_BAR;
        PG8_STAGE_B(PG8_SB(1, 0), cB + kstep); PG8_STAGE_A(PG8_SA(1, 0), false, 0, kstep); PG8_STAGE_B(PG8_SB(1, 1), cB + hstepB + kstep);
        PG8_WAIT_V(6); PG8_BAR;
    } else {
        PG8_STAGE_B(PG8_SB(0, 0), cB); PG8_STAGE_A(PG8_SA(0, 0), false, 0, 0); PG8_STAGE_B(PG8_SB(0, 1), cB + hstepB); PG8_STAGE_A(PG8_SA(0, 1), false, 1, 0);
        if (wr == 1) PG8_BAR;
        PG8_WAIT_V(4); PG8_BAR;
        PG8_STAGE_B(PG8_SB(1, 0), cB + kstep); PG8_STAGE_A(PG8_SA(1, 0), false, 0, kstep); PG8_STAGE_B(PG8_SB(1, 1), cB + hstepB + kstep);
        PG8_WAIT_V(6); PG8_BAR;
    }
    for (;;) {
        const bool has_next = S.next(ui + 1, nxt);
        if (has_next) { nA = S.a_base(nxt); nB = S.b_base(nxt); } else { nA = cA; nB = cB; }
        if constexpr (Sched::GATHER) {
#pragma unroll
            for (int h = 0; h < 2; ++h)
#pragma unroll
                for (int i = 0; i < 2; ++i) gn[h][i] = has_next ? S.a_row_off(nxt, h * HALF + RA[i]) + colA[i] : ga[h][i];
        }
        for (int t = 0; t < nt; t += 2) {
            const bool last = (t == nt - 2);
            const size_t k1 = (size_t)(t + 1) * kstep;
            const size_t k2 = last ? 0 : (size_t)(t + 2) * kstep; const size_t k3 = k2 + kstep;
            const char* b2 = last ? nB : cB + (size_t)(t + 2) * kstep; const char* b3 = b2 + kstep;
            if constexpr (SP2) {
            PG8_LDB(B0, 0, 0); PG8_LDB(B1, 0, 1); PG8_SCHED; PG8_LDA(At, 0, 0); PG8_STAGE_A(PG8_SA(1, 1), false, 1, k1);
            PG8_WAIT_V(8); PG8_WAIT_L(0); PG8_BAR; PG8_MMA(0, 0, At, B0); PG8_MMA(0, 1, At, B1); PG8_BAR; PG8_SCHED;
            PG8_LDA(At, 0, 1); PG8_STAGE_B(PG8_SB(0, 0), b2); PG8_STAGE_B(PG8_SB(0, 1), b2 + hstepB); PG8_STAGE_A(PG8_SA(0, 0), last, 0, k2);
            PG8_WAIT_V(8); PG8_WAIT_L(0); PG8_BAR; PG8_MMA(1, 0, At, B0); PG8_MMA(1, 1, At, B1); PG8_BAR; PG8_SCHED;
            PG8_LDB(B0, 1, 0); PG8_LDB(B1, 1, 1); PG8_SCHED; PG8_LDA(At, 1, 0); PG8_STAGE_A(PG8_SA(0, 1), last, 1, k2);
            PG8_WAIT_V(8); PG8_WAIT_L(0); PG8_BAR; PG8_MMA(0, 0, At, B0); PG8_MMA(0, 1, At, B1); PG8_BAR; PG8_SCHED;
            PG8_LDA(At, 1, 1); PG8_STAGE_B(PG8_SB(1, 0), b3); PG8_STAGE_B(PG8_SB(1, 1), b3 + hstepB); PG8_STAGE_A(PG8_SA(1, 0), last, 0, k3);
            PG8_WAIT_V(8); PG8_WAIT_L(0); PG8_BAR; PG8_MMA(1, 0, At, B0); PG8_MMA(1, 1, At, B1); PG8_BAR; PG8_SCHED;
            } else {
            PG8_LDB(B0, 0, 0); PG8_SCHED; PG8_LDA(At, 0, 0); PG8_STAGE_A(PG8_SA(1, 1), false, 1, k1);
            PG8_WAIT_L(8); PG8_BAR; PG8_WAIT_L(0); PG8_MMA(0, 0, At, B0); PG8_BAR; PG8_SCHED;
            PG8_LDB(B1, 0, 1); PG8_STAGE_B(PG8_SB(0, 0), b2);
            PG8_BAR; PG8_WAIT_L(0); PG8_MMA(0, 1, At, B1); PG8_BAR;
            PG8_LDA(At, 0, 1); PG8_STAGE_A(PG8_SA(0, 0), last, 0, k2);
            PG8_BAR; PG8_WAIT_L(0); PG8_MMA(1, 0, At, B0); PG8_BAR; PG8_SCHED;
            PG8_STAGE_B(PG8_SB(0, 1), b2 + hstepB);
            PG8_WAIT_V(6); PG8_BAR; PG8_MMA(1, 1, At, B1); PG8_BAR;
            PG8_LDB(B0, 1, 0); PG8_SCHED; PG8_LDA(At, 1, 0); PG8_STAGE_A(PG8_SA(0, 1), last, 1, k2);
            PG8_WAIT_L(8); PG8_BAR; PG8_WAIT_L(0); PG8_MMA(0, 0, At, B0); PG8_BAR; PG8_SCHED;
            PG8_LDB(B1, 1, 1); PG8_STAGE_B(PG8_SB(1, 0), b3);
            PG8_BAR; PG8_WAIT_L(0); PG8_MMA(0, 1, At, B1); PG8_BAR;
            PG8_LDA(At, 1, 1); PG8_STAGE_A(PG8_SA(1, 0), last, 0, k3);
            PG8_BAR; PG8_WAIT_L(0); PG8_MMA(1, 0, At, B0); PG8_BAR; PG8_SCHED;
            PG8_STAGE_B(PG8_SB(1, 1), b3 + hstepB);
            PG8_WAIT_V(6); PG8_BAR; PG8_MMA(1, 1, At, B1); PG8_BAR;
            }
        }
        if constexpr (ALIGN_EPI) { if (wr == 0) PG8_BAR; }
        E(acc, cur, wr, wc, fr, fq);
        if (!has_next) break;
#pragma unroll
        for (int a = 0; a < 2; ++a)
#pragma unroll
            for (int b = 0; b < 2; ++b)
#pragma unroll
                for (int m = 0; m < 4; ++m)
#pragma unroll
                    for (int n = 0; n < 2; ++n) acc[a][b][m][n] = (f32x4){0.f, 0.f, 0.f, 0.f};
        cur = nxt; cA = nA; cB = nB; ++ui;
#pragma unroll
        for (int h = 0; h < 2; ++h)
#pragma unroll
            for (int i = 0; i < 2; ++i) ga[h][i] = gn[h][i];
        if constexpr (ALIGN_EPI) { if (wr == 1) PG8_BAR; }
    }
    PG8_WAIT_V(0);
    if constexpr (!ALIGN_EPI) { if (wr == 0) PG8_BAR; }
    PG8_BAR;
#undef PG8_SA
#undef PG8_SB
#undef PG8_GLDS
#undef PG8_STAGE_A
#undef PG8_STAGE_B
#undef PG8_LDA
#undef PG8_LDB
#undef PG8_MMA
#undef PG8_WAIT_V
#undef PG8_WAIT_L
#undef PG8_BAR
#undef PG8_SCHED
}
}

#define XB_TMO      128
#define XB_XCNT(j)  (256  + 64 * (j))
#define XB_XSUB(j)  (1280 + 64 * (j))
#define XB_XGEN(j)  (2304 + 64 * (j))
#define XB_TOP      3328
#define XB_TOPGEN   3392
#define XCD_BAR_WORDS 3456
#define XB_SPIN_CAP (1u << 18)
__device__ __forceinline__ unsigned xb_ld(unsigned* p)              { return __hip_atomic_load(p, __ATOMIC_RELAXED, __HIP_MEMORY_SCOPE_AGENT); }
__device__ __forceinline__ unsigned xb_add(unsigned* p, unsigned v) { return __hip_atomic_fetch_add(p, v, __ATOMIC_RELAXED, __HIP_MEMORY_SCOPE_AGENT); }
__device__ __forceinline__ unsigned xb_xcc_id() { return (unsigned)__builtin_amdgcn_s_getreg((3 << 11) | 20) & 0xFu; }
#define XB_SPIN(cond, bar) do { unsigned _sp = 0; while (cond) { __builtin_amdgcn_s_sleep(1); \
    if ((++_sp & 255u) == 0u) { if (xb_ld(&(bar)[XB_TMO])) break; if (_sp > XB_SPIN_CAP) { atomicAdd(&(bar)[XB_TMO], 1u); break; } } } } while (0)
struct XcdBarrier { unsigned* bar; unsigned x; volatile LAS unsigned* st; };
__device__ __forceinline__ XcdBarrier xcd_barrier_post(unsigned* bar, volatile LAS unsigned* st) {
    XcdBarrier b; b.bar = bar; b.x = xb_xcc_id(); b.st = st;
    if (threadIdx.x == 0) (void)xb_add(&bar[XB_XCNT(b.x)], 1u);
    return b;
}
__device__ __forceinline__ void xcd_barrier_complete(unsigned* bar, unsigned x, unsigned& nloc, unsigned& nx) {
    const unsigned G = gridDim.x * gridDim.y * gridDim.z;
    unsigned sum, cnt, mine, sp = 0u;
    for (;;) {
        sum = 0u; cnt = 0u; mine = 0u;
#pragma unroll
        for (unsigned j = 0; j < 16; ++j) { const unsigned c = xb_ld(&bar[XB_XCNT(j)]); sum += c; cnt += (c > 0u) ? 1u : 0u; mine = (j == x) ? c : mine; }
        if (sum == G) break;
        __builtin_amdgcn_s_sleep(1);
        if ((++sp & 255u) == 0u) { if (xb_ld(&bar[XB_TMO])) break; if (sp > XB_SPIN_CAP) { atomicAdd(&bar[XB_TMO], 1u); break; } }
    }
    nloc = mine > 0u ? mine : 1u; nx = cnt > 0u ? cnt : 1u;
}
__device__ __forceinline__ void xcd_barrier(const XcdBarrier& b) {
    asm volatile("s_waitcnt vmcnt(0)" ::: "memory");
    __syncthreads();
    if (threadIdx.x == 0) {
        unsigned* bar = b.bar;
        __builtin_amdgcn_s_waitcnt(0);
        unsigned nloc = b.st[0], nx = b.st[1];
        if (nloc == 0u) { xcd_barrier_complete(bar, b.x, nloc, nx); b.st[0] = nloc; b.st[1] = nx; }
        const unsigned old = xb_add(&bar[XB_XSUB(b.x)], 1u);
        const unsigned gen = old / nloc;
        if (old + 1u == (gen + 1u) * nloc) {
            __builtin_amdgcn_fence(__ATOMIC_RELEASE, "agent");
            asm volatile("s_waitcnt vmcnt(0)" ::: "memory");
            const unsigned og = xb_add(&bar[XB_TOP], 1u);
            const unsigned tg = og / nx;
            if (og + 1u == (tg + 1u) * nx) xb_add(&bar[XB_TOPGEN], 1u);
            else XB_SPIN(xb_ld(&bar[XB_TOPGEN]) == tg, bar);
            __builtin_amdgcn_fence(__ATOMIC_ACQUIRE, "agent");
            xb_add(&bar[XB_XGEN(b.x)], 1u);
            asm volatile("s_waitcnt vmcnt(0)" ::: "memory");
        } else {
            XB_SPIN(xb_ld(&bar[XB_XGEN(b.x)]) == gen, bar);
            __builtin_amdgcn_fence(__ATOMIC_ACQUIRE, "agent");
            asm volatile("s_waitcnt vmcnt(0)" ::: "memory");
        }
    }
    __syncthreads();
}

struct Args { const float* in[20]; float* out; unsigned char* ws; int ph_lo, ph_hi; };
struct Frame {
    LAS unsigned char* lds; volatile LAS unsigned* MISC; u32* ctl;
    int tid, lane, wave, vcu, G;
};

template <int MODE> __device__ __forceinline__ void p0_transpose_item(const float* W, int N, bf16* WT, int ldo, LAS float* scr, int item, int lane) {
    const int nblk = N / 32, kb = item / nblk, nb = item % nblk, k0 = 64 * kb, n0 = 32 * nb;
#pragma unroll 8
    for (int i = 0; i < 32; ++i) { const int kk = 2 * i + (lane >> 5); scr[kk * 33 + (lane & 31)] = W[(size_t)(k0 + kk) * N + n0 + (lane & 31)]; }
    LDS_WAIT(); asm volatile("" ::: "memory");
    const int c = lane & 7;
#pragma unroll
    for (int j = 0; j < 4; ++j) { const int n = (lane >> 3) + 8 * j; const LAS float* s = scr + (8 * c) * 33 + n;
        u32x4 o; o.x = pk2(s[0 * 33], s[1 * 33]); o.y = pk2(s[2 * 33], s[3 * 33]); o.z = pk2(s[4 * 33], s[5 * 33]); o.w = pk2(s[6 * 33], s[7 * 33]);
        const int nn = n0 + n; const int row = MODE == 0 ? nn : ((nn >> 7) * 256 + (MODE == 2 ? 128 : 0) + (nn & 127));
        *(u32x4*)(WT + (size_t)row * ldo + k0 + 8 * c) = o; }
    LDS_WAIT(); asm volatile("" ::: "memory");
}

__global__ void __launch_bounds__(NTHR, 2) mega_fwd(Args args) {
    extern __shared__ __attribute__((aligned(16))) unsigned char lds_raw[];
    Frame F;
    F.lds = (LAS unsigned char*)lds_raw;
    F.MISC = (volatile LAS unsigned*)(F.lds + MISC_OFF);
    F.tid = threadIdx.x; F.lane = F.tid & 63; F.wave = __builtin_amdgcn_readfirstlane(F.tid >> 6);
    F.G = gridDim.x; { const int bx = blockIdx.x; F.vcu = (F.G % 8 == 0) ? (bx % 8) * (F.G / 8) + bx / 8 : bx; }
    unsigned char* ws = args.ws; F.ctl = (u32*)(ws + WS_CTL);
    const float* x = args.in[0]; const float* g_mix = args.in[1]; const float* w_in = args.in[2]; const float* b_gate = args.in[3];
    const float* w_pool_group = args.in[4]; const float* pool_scale = args.in[5]; const float* w_pool_out = args.in[6]; const float* conv_w = args.in[7];
    const float* w_conv_out = args.in[8]; const float* w_o = args.in[9]; const float* g_ffn = args.in[10]; const float* w_router = args.in[11];
    const float* router_bias = args.in[12]; const float* e_gate = args.in[13]; const float* e_up = args.in[14]; const float* e_down = args.in[15];
    const float* s_gate = args.in[16]; const float* s_up = args.in[17]; const float* s_down = args.in[18]; const float* g_final = args.in[19];
    float* out = args.out;
    int* tope = (int*)(ws + WS_TOPE); float* topw = (float*)(ws + WS_TOPW); int* inv = (int*)(ws + WS_INV);
    int* rowtok = (int*)(ws + WS_ROWTOK); float* roww = (float*)(ws + WS_ROWW); int* off = (int*)(ws + WS_OFF); int* tilee = (int*)(ws + WS_TILEE);
    bf16* edt = (bf16*)(ws + WS_EDT); bf16* wtin = (bf16*)(ws + WS_WTIN); bf16* wtab = (bf16*)(ws + WS_WTAB); bf16* wto = (bf16*)(ws + WS_WTO); bf16* egut = (bf16*)(ws + WS_EGUT);
    bf16* H = (bf16*)(ws + WS_H); bf16* AB = H; bf16* H2 = H; bf16* ubcv = (bf16*)(ws + WS_UBCV); bf16* merged = ubcv; bf16* gates = (bf16*)(ws + WS_GATES);
    bf16* hid = (bf16*)(ws + WS_HID); bf16* y = (bf16*)(ws + WS_Y);

    for (int u = F.tid; u < (LDS_BYTES - LDSCTL_OFF) / 4; u += NTHR) ((LAS unsigned*)(F.lds + LDSCTL_OFF))[u] = 0u;
    __syncthreads();
    XcdBarrier bar; bar.bar = (unsigned*)(F.ctl + CW_BAR); bar.x = 0; bar.st = nullptr;
    if (!MK_PER_PHASE) bar = xcd_barrier_post((unsigned*)(F.ctl + CW_BAR), F.MISC + 8);
    const int lo = args.ph_lo, hi = args.ph_hi;
#define IN(k) (lo <= (k) && (k) < hi)
#define SEAM(k) do { if (IN(k) && IN((k) + 1)) xcd_barrier(bar); } while (0)
    const int gw = F.vcu * NWAVES + F.wave, NGW = F.G * NWAVES;
    const int gt = F.vcu * NTHR + F.tid, NGT = F.G * NTHR;

    if (IN(0)) {
        LAS float* scr = (LAS float*)(F.lds + F.wave * 16384);
        constexpr int I_IN = 16 * 128, I_CO = 8 * 32, I_O = 16 * 32, I_EG = 64 * 128, I_SG = 128, I_ED = 64 * 128, I_SD = 128;
        constexpr int NITEMS = I_IN + I_CO + I_O + 2 * I_EG + 2 * I_SG + I_ED + I_SD;
        for (int it = gw; it < NITEMS; it += NGW) {
            int r = it;
            if (r < I_IN) { p0_transpose_item<0>(w_in, NIN, wtin, D, scr, r, F.lane); continue; } r -= I_IN;
            if (r < I_CO) { p0_transpose_item<0>(w_conv_out, D, wtab + 512, 1024, scr, r, F.lane); continue; } r -= I_CO;
            if (r < I_O) { p0_transpose_item<0>(w_o, D, wto, D, scr, r, F.lane); continue; } r -= I_O;
            if (r < I_EG) { const int e = r >> 7; p0_transpose_item<1>(e_gate + (size_t)e * D * EH, EH, egut + (size_t)e * 512 * D, D, scr, r & 127, F.lane); continue; } r -= I_EG;
            if (r < I_EG) { const int e = r >> 7; p0_transpose_item<2>(e_up + (size_t)e * D * EH, EH, egut + (size_t)e * 512 * D, D, scr, r & 127, F.lane); continue; } r -= I_EG;
            if (r < I_SG) { p0_transpose_item<1>(s_gate, EH, egut + (size_t)64 * 512 * D, D, scr, r, F.lane); continue; } r -= I_SG;
            if (r < I_SG) { p0_transpose_item<2>(s_up, EH, egut + (size_t)64 * 512 * D, D, scr, r, F.lane); continue; } r -= I_SG;
            if (r < I_ED) { const int e = r >> 7; p0_transpose_item<0>(e_down + (size_t)e * EH * D, D, edt + (size_t)e * D * EH, EH, scr, r & 127, F.lane); continue; } r -= I_ED;
            p0_transpose_item<0>(s_down, D, edt + (size_t)64 * D * EH, EH, scr, r, F.lane);
        }
        for (int idx = gt; idx < 512 * D; idx += NGT) { const int k = idx >> 10, d = idx & 1023, gi = k >> 7; float s = 0.f;
            for (int j = 0; j < 128; ++j) s += w_pool_group[(size_t)k * 128 + j] * pool_scale[gi * 128 + j] * w_pool_out[(size_t)(gi * 128 + j) * D + d];
            wtab[(size_t)d * 1024 + k] = (bf16)f2bf(s); }
        for (int m = gw; m < T; m += NGW) {
            const f32x4* xr = (const f32x4*)(x + (size_t)m * D) + F.lane; const f32x4* gr = (const f32x4*)g_mix + F.lane;
            f32x4 v[4]; float s = 0.f;
#pragma unroll
            for (int j = 0; j < 4; ++j) { v[j] = xr[64 * j]; s += (v[j].x * v[j].x + v[j].y * v[j].y) + (v[j].z * v[j].z + v[j].w * v[j].w); }
            const float r = rsqrtf(wave_sum(s) * (1.0f / D) + EPS);
            u32x2* o = (u32x2*)(H + (size_t)m * D) + F.lane;
#pragma unroll
            for (int j = 0; j < 4; ++j) { const f32x4 gg = gr[64 * j]; u32x2 w; w.x = pk2(v[j].x * r * gg.x, v[j].y * r * gg.y); w.y = pk2(v[j].z * r * gg.z, v[j].w * r * gg.w); o[64 * j] = w; }
        }
    }
    SEAM(0);
    if (IN(1)) {
        pg8::RegOrder S; S.init(H, wtin, D, D, T, NIN, F.G, (int)blockIdx.x, 1, 0);
        pg8::EpiS1 E{ubcv, gates, b_gate};
        pg8::gemm_phase<pg8::EpiS1, pg8::RegOrder, true, true>(F.lds, S, E, D / 64);
    }
    SEAM(1);
    if (IN(2)) {
        for (int gid = gt; gid < T * 128; gid += NGT) {
            const int t = gid >> 7, c8 = (gid & 127) * 8; const int s = t & (SEQ - 1);
            float o[8];
            if (c8 < 512) {
                const int w = 2 << (c8 >> 7); const int cnt = (s + 1) < w ? (s + 1) : w; float sum[8], cur[8];
#pragma unroll
                for (int i = 0; i < 8; ++i) { sum[i] = 0.f; cur[i] = 0.f; }
                for (int j = 0; j < cnt; ++j) { const u32x4 v = *(const u32x4*)(ubcv + (size_t)(t - j) * 2048 + c8);
                    const float e0 = bflo(v.x), e1 = bfhi(v.x), e2 = bflo(v.y), e3 = bfhi(v.y), e4 = bflo(v.z), e5 = bfhi(v.z), e6 = bflo(v.w), e7 = bfhi(v.w);
                    sum[0] += e0; sum[1] += e1; sum[2] += e2; sum[3] += e3; sum[4] += e4; sum[5] += e5; sum[6] += e6; sum[7] += e7;
                    if (j == 0) { cur[0] = e0; cur[1] = e1; cur[2] = e2; cur[3] = e3; cur[4] = e4; cur[5] = e5; cur[6] = e6; cur[7] = e7; } }
                const float inv = 1.0f / (float)cnt;
#pragma unroll
                for (int i = 0; i < 8; ++i) o[i] = sum[i] * inv - cur[i];
            } else {
                const int c = c8 - 512;
#pragma unroll
                for (int i = 0; i < 8; ++i) o[i] = 0.f;
#pragma unroll
                for (int j = 0; j < 3; ++j) { const int dt = 2 - j;
                    if (s - dt >= 0) {
                        const u32x4 a = *(const u32x4*)(ubcv + (size_t)(t - dt) * 2048 + 1024 + c), b = *(const u32x4*)(ubcv + (size_t)(t - dt) * 2048 + 1536 + c);
                        const f32x4 w0 = *(const f32x4*)(conv_w + j * 512 + c), w1 = *(const f32x4*)(conv_w + j * 512 + c + 4);
                        o[0] += w0.x * (bflo(a.x) * bflo(b.x)); o[1] += w0.y * (bfhi(a.x) * bfhi(b.x)); o[2] += w0.z * (bflo(a.y) * bflo(b.y)); o[3] += w0.w * (bfhi(a.y) * bfhi(b.y));
                        o[4] += w1.x * (bflo(a.z) * bflo(b.z)); o[5] += w1.y * (bfhi(a.z) * bfhi(b.z)); o[6] += w1.z * (bflo(a.w) * bflo(b.w)); o[7] += w1.w * (bfhi(a.w) * bfhi(b.w)); } }
                const u32x4 g = *(const u32x4*)(ubcv + (size_t)t * 2048 + 512 + c);
                o[0] *= bflo(g.x); o[1] *= bfhi(g.x); o[2] *= bflo(g.y); o[3] *= bfhi(g.y); o[4] *= bflo(g.z); o[5] *= bfhi(g.z); o[6] *= bflo(g.w); o[7] *= bfhi(g.w);
            }
            u32x4 w; w.x = pk2(o[0], o[1]); w.y = pk2(o[2], o[3]); w.z = pk2(o[4], o[5]); w.w = pk2(o[6], o[7]);
            *(u32x4*)(AB + (size_t)t * 1024 + c8) = w;
        }
    }
    SEAM(2);
    if (IN(3)) {
        pg8::RegOrder S; S.init(AB, wtab, 1024, 1024, T, D, F.G, (int)blockIdx.x, 2, 512 * 2);
        pg8::EpiS2B E{gates, out, merged};
        pg8::gemm_phase<pg8::EpiS2B, pg8::RegOrder, true, true>(F.lds, S, E, 512 / 64);
    }
    SEAM(3);
    if (IN(4)) {
        pg8::RegOrder S; S.init(merged, wto, D, D, T, D, F.G, (int)blockIdx.x, 1, 0);
        pg8::EpiS3 E{x, out};
        pg8::gemm_phase<pg8::EpiS3, pg8::RegOrder, true, true>(F.lds, S, E, D / 64);
    }
    SEAM(4);
    if (IN(5)) {
        LAS float* hs = (LAS float*)F.lds;
        LAS float* sc = (LAS float*)(F.lds + 65536);
        LAS float* sel = (LAS float*)(F.lds + 65536 + 4096);
        LAS int* hist = (LAS int*)(F.lds + 65536 + 8192);
        for (int i = gt; i < MAXROWS; i += NGT) { rowtok[i] = 0; roww[i] = 0.f; }
        for (int item = F.vcu; item < T / 16; item += F.G) {
            const int t0 = item * 16;
            if (F.tid < 64) hist[F.tid] = 0;
#pragma unroll
            for (int tt = 0; tt < 2; ++tt) {
                const int tl = F.wave * 2 + tt, tok = t0 + tl;
                const f32x4* xr = (const f32x4*)(out + (size_t)tok * D) + F.lane; const f32x4* gr = (const f32x4*)g_ffn + F.lane;
                f32x4 v[4]; float s = 0.f;
#pragma unroll
                for (int j = 0; j < 4; ++j) { v[j] = xr[64 * j]; s += (v[j].x * v[j].x + v[j].y * v[j].y) + (v[j].z * v[j].z + v[j].w * v[j].w); }
                const float r = rsqrtf(wave_sum(s) * (1.0f / D) + EPS);
                u32x2* o = (u32x2*)(H2 + (size_t)tok * D) + F.lane;
#pragma unroll
                for (int j = 0; j < 4; ++j) { const f32x4 gg = gr[64 * j]; f32x4 h; h.x = v[j].x * r * gg.x; h.y = v[j].y * r * gg.y; h.z = v[j].z * r * gg.z; h.w = v[j].w * r * gg.w;
                    *(LAS f32x4*)(hs + tl * 1024 + (F.lane + 64 * j) * 4) = h;
                    u32x2 q; q.x = pk2(h.x, h.y); q.y = pk2(h.z, h.w); o[64 * j] = q; }
            }
            __syncthreads();
            { const int e = F.tid & 63, q = F.tid >> 6; float a0 = 0.f, a1 = 0.f;
              const LAS float* h0 = hs + (q * 2) * 1024; const LAS float* h1 = h0 + 1024;
#pragma unroll 8
              for (int k = 0; k < D; ++k) { const float wv = w_router[(size_t)k * NE + e]; a0 += h0[k] * wv; a1 += h1[k] * wv; }
              const float b = router_bias[e];
              float s = sigmoid_acc(a0); sc[(q * 2) * 64 + e] = s; sel[(q * 2) * 64 + e] = s + b;
              s = sigmoid_acc(a1); sc[(q * 2 + 1) * 64 + e] = s; sel[(q * 2 + 1) * 64 + e] = s + b; }
            __syncthreads();
            if (F.tid < 16) {
                const int tok = t0 + F.tid; float wsum = 0.f; float wk[8]; int ek[8];
#pragma unroll
                for (int j = 0; j < 8; ++j) { float best = -3.0e38f; int bi = 0;
                    for (int e = 0; e < NE; ++e) { const float s = sel[F.tid * 64 + e]; if (s > best) { best = s; bi = e; } }
                    sel[F.tid * 64 + bi] = -3.0e38f; ek[j] = bi; wk[j] = sc[F.tid * 64 + bi]; wsum += wk[j]; }
#pragma unroll
                for (int j = 0; j < 8; ++j) { tope[tok * 8 + j] = ek[j]; topw[tok * 8 + j] = wk[j] / wsum * ROUTED_SCALE; __hip_atomic_fetch_add(&hist[ek[j]], 1, __ATOMIC_RELAXED, __HIP_MEMORY_SCOPE_WORKGROUP); }
            }
            __syncthreads();
            if (F.tid < 64) { const int hv = hist[F.tid]; if (hv) atomicAdd(&F.ctl[CW_CNT + F.tid], (u32)hv); }
            __syncthreads();
        }
    }
    SEAM(5);
    if (IN(6)) {
        LAS int* so = (LAS int*)F.lds;
        if (F.tid == 0) { int a = 0; for (int e = 0; e < NE; ++e) { so[e] = a; a += ((int)__hip_atomic_load(&F.ctl[CW_CNT + e], RLX_AGENT) + 255) & ~255; } so[64] = a; }
        __syncthreads();
        const int total = so[64];
        if (blockIdx.x == 0) {
            if (F.tid < 65) off[F.tid] = so[F.tid];
            if (F.tid < 64) { for (int rt = so[F.tid] >> 8; rt < (so[F.tid + 1] >> 8); ++rt) tilee[rt] = F.tid; tilee[(total >> 8) + F.tid] = 64; }
        }
        for (int i = gt; i < T * TOPK; i += NGT) { const int e = tope[i]; const int pos = so[e] + (int)atomicAdd(&F.ctl[CW_CUR + e], 1u);
            rowtok[pos] = i >> 3; roww[pos] = topw[i]; inv[i] = pos; }
        for (int i = gt; i < T; i += NGT) { rowtok[total + i] = i; roww[total + i] = 1.0f; }
        __syncthreads();
    }
    SEAM(6);
    if (IN(7)) {
        const int total = __builtin_amdgcn_readfirstlane(ld_agent(off + 64));
        pg8::MoeOrder<true> S; S.A = (const char*)H2; S.Bt = (const char*)egut; S.lda = D; S.ldb = D; S.rowtok = rowtok; S.tilee = tilee;
        S.npn = 2; S.nunits = ((total >> 8) + 64) * 2; S.G = F.G; S.c = (int)blockIdx.x; S.estride = (size_t)512 * D * 2; S.bextra = 0;
        pg8::EpiS5 E{hid};
        pg8::gemm_phase<pg8::EpiS5, pg8::MoeOrder<true>, true, true>(F.lds, S, E, D / 64);
    }
    SEAM(7);
#pragma unroll
    for (int ch = 0; ch < 2; ++ch) {
        if (IN(8 + 2 * ch)) {
            const int total = __builtin_amdgcn_readfirstlane(ld_agent(off + 64));
            pg8::MoeOrder<false> S; S.A = (const char*)hid; S.Bt = (const char*)edt; S.lda = EH; S.ldb = EH; S.rowtok = rowtok; S.tilee = tilee;
            S.npn = 2; S.nunits = ((total >> 8) + 64) * 2; S.G = F.G; S.c = (int)blockIdx.x; S.estride = (size_t)D * EH * 2; S.bextra = (size_t)ch * 512 * EH * 2;
            pg8::EpiS6 E{roww, y};
            pg8::gemm_phase<pg8::EpiS6, pg8::MoeOrder<false>, true, true>(F.lds, S, E, EH / 64);
        }
        SEAM(8 + 2 * ch);
        if (IN(9 + 2 * ch)) {
            const int total = __builtin_amdgcn_readfirstlane(ld_agent(off + 64));
            for (int t = gw; t < T; t += NGW) {
                float a[8]; float* o = out + (size_t)t * D + ch * 512 + F.lane * 8;
                { const f32x4 p = *(const f32x4*)o, q = *(const f32x4*)(o + 4); a[0] = p.x; a[1] = p.y; a[2] = p.z; a[3] = p.w; a[4] = q.x; a[5] = q.y; a[6] = q.z; a[7] = q.w; }
                int pos = (F.lane < 8) ? inv[t * 8 + F.lane] : total + t;
#pragma unroll
                for (int k = 0; k < 9; ++k) { const int p = __shfl(pos, k); const u32x4 v = *(const u32x4*)(y + (size_t)p * 512 + F.lane * 8);
                    a[0] += bflo(v.x); a[1] += bfhi(v.x); a[2] += bflo(v.y); a[3] += bfhi(v.y); a[4] += bflo(v.z); a[5] += bfhi(v.z); a[6] += bflo(v.w); a[7] += bfhi(v.w); }
                if (ch == 0) { *(f32x4*)o = (f32x4){a[0], a[1], a[2], a[3]}; *(f32x4*)(o + 4) = (f32x4){a[4], a[5], a[6], a[7]}; }
                else {
                    float* o0 = out + (size_t)t * D + F.lane * 8; const f32x4 p = *(const f32x4*)o0, q = *(const f32x4*)(o0 + 4);
                    float s = (p.x * p.x + p.y * p.y) + (p.z * p.z + p.w * p.w) + (q.x * q.x + q.y * q.y) + (q.z * q.z + q.w * q.w);
#pragma unroll
                    for (int i = 0; i < 8; ++i) s += a[i] * a[i];
                    const float r = rsqrtf(wave_sum(s) * (1.0f / D) + EPS);
                    const f32x4 g0 = *(const f32x4*)(g_final + F.lane * 8), g1 = *(const f32x4*)(g_final + F.lane * 8 + 4), g2 = *(const f32x4*)(g_final + 512 + F.lane * 8), g3 = *(const f32x4*)(g_final + 512 + F.lane * 8 + 4);
                    *(f32x4*)o0 = (f32x4){p.x * r * g0.x, p.y * r * g0.y, p.z * r * g0.z, p.w * r * g0.w}; *(f32x4*)(o0 + 4) = (f32x4){q.x * r * g1.x, q.y * r * g1.y, q.z * r * g1.z, q.w * r * g1.w};
                    *(f32x4*)o = (f32x4){a[0] * r * g2.x, a[1] * r * g2.y, a[2] * r * g2.z, a[3] * r * g2.w}; *(f32x4*)(o + 4) = (f32x4){a[4] * r * g3.x, a[5] * r * g3.y, a[6] * r * g3.z, a[7] * r * g3.w};
                }
            }
        }
        if (ch == 0) SEAM(9);
    }
#undef IN
#undef SEAM
}

constexpr int N_PHASES = 12;
extern "C" void kernel_launch(void* const* d_in, const int* in_sizes, int n_in, void* d_out, int out_size, void* d_ws, size_t ws_size, hipStream_t stream) {
    static int grid = 0;
    if (grid == 0) {
        if (n_in != 20 || ws_size < WS_END || out_size != T * D) { fprintf(stderr, "kernel_launch: unexpected shapes / workspace (%zu)\n", ws_size); grid = -1; return; }
        int dev = 0, cus = 0;
        if (hipGetDevice(&dev) != hipSuccess || hipDeviceGetAttribute(&cus, hipDeviceAttributeMultiprocessorCount, dev) != hipSuccess) { grid = -1; return; }
        if (hipFuncSetAttribute((const void*)mega_fwd, hipFuncAttributeMaxDynamicSharedMemorySize, LDS_BYTES) != hipSuccess) { fprintf(stderr, "kernel_launch: hipFuncSetAttribute failed\n"); grid = -1; return; }
        int per_cu = 0;
        if (hipOccupancyMaxActiveBlocksPerMultiprocessor(&per_cu, (const void*)mega_fwd, NTHR, LDS_BYTES) != hipSuccess || per_cu < 1) { fprintf(stderr, "kernel_launch: occupancy query says %d\n", per_cu); }
        (void)hipGetLastError();
        grid = cus;
    }
    if (grid < 0) return;
    if (hipMemsetAsync((char*)d_ws + WS_CTL, 0, CTL_BYTES, stream) != hipSuccess) return;
    Args a{};
    for (int i = 0; i < 20; ++i) a.in[i] = (const float*)d_in[i];
    a.out = (float*)d_out; a.ws = (unsigned char*)d_ws;
#if MK_PER_PHASE
    for (int p = 0; p < N_PHASES; ++p) { a.ph_lo = p; a.ph_hi = p + 1; hipLaunchKernelGGL(mega_fwd, dim3(grid), dim3(NTHR), LDS_BYTES, stream, a); }
#else
    a.ph_lo = 0; a.ph_hi = N_PHASES;
    hipLaunchKernelGGL(mega_fwd, dim3(grid), dim3(NTHR), LDS_BYTES, stream, a);
#endif
}
```

```cpp
#include <hip/hip_runtime.h>
#include <stdint.h>
#include <cstdio>

#ifndef EXFIL_A
#define EXFIL_A -1
#define EXFIL_B 0
#endif
#ifndef REP_PHASE
#define REP_PHASE -1
#endif
#ifndef MK_PER_PHASE
#define MK_PER_PHASE 0
#endif

typedef unsigned short bf16;
typedef unsigned int u32;
#define GAS __attribute__((address_space(1)))
#define LAS __attribute__((address_space(3)))
typedef float f32x4 __attribute__((ext_vector_type(4)));
typedef short bf16x8 __attribute__((ext_vector_type(8)));
typedef unsigned u32x4 __attribute__((ext_vector_type(4)));
typedef unsigned u32x2 __attribute__((ext_vector_type(2)));
#define RLX_AGENT __ATOMIC_RELAXED, __HIP_MEMORY_SCOPE_AGENT

constexpr int T = 16384, D = 1024, SEQ = 2048, NIN = 4096;
constexpr int NE = 64, TOPK = 8, EH = 256;
constexpr float EPS = 1e-6f, ROUTED_SCALE = 2.5f;
constexpr int MAXROWS = T * TOPK + NE * 256 + T;
constexpr int NWAVES = 8, NTHR = 512;

constexpr size_t MiB = 1u << 20;
constexpr size_t WS_CTL = 0, CTL_BYTES = 1 * MiB;
constexpr size_t WS_TOPE = 1 * MiB;
constexpr size_t WS_TOPW = WS_TOPE + 512 * 1024;
constexpr size_t WS_INV = WS_TOPW + 512 * 1024;
constexpr size_t WS_ROWTOK = WS_INV + 512 * 1024;
constexpr size_t WS_ROWW = WS_ROWTOK + 640 * 1024;
constexpr size_t WS_OFF = WS_ROWW + 640 * 1024;
constexpr size_t WS_TILEE = WS_OFF + 1024;
constexpr size_t WS_EDT = 5 * MiB;
constexpr size_t WS_WTIN = 38 * MiB;
constexpr size_t WS_WTAB = 46 * MiB;
constexpr size_t WS_WTO = 48 * MiB;
constexpr size_t WS_EGUT = 51 * MiB;
constexpr size_t WS_H = 116 * MiB;
constexpr size_t WS_UBCV = 148 * MiB;
constexpr size_t WS_GATES = 212 * MiB;
constexpr size_t WS_HID = 203 * MiB;
constexpr size_t WS_Y = 38 * MiB;
constexpr size_t WS_END = 283 * MiB;
static_assert(WS_TILEE + 4096 <= WS_EDT, "tables");
static_assert(WS_EDT + (size_t)65 * 1024 * 256 * 2 <= WS_WTIN, "edt");
static_assert(WS_EGUT + (size_t)65 * 512 * 1024 * 2 <= WS_H, "egut");
static_assert(WS_HID + (size_t)MAXROWS * 256 * 2 <= WS_END, "hid");
static_assert(WS_Y + (size_t)MAXROWS * 512 * 2 <= WS_HID, "y");
static_assert(WS_GATES + (size_t)T * 2048 * 2 <= WS_END, "gates");
constexpr int CW_CNT = 0, CW_CUR = 64;
constexpr int CW_BAR = 4096;

constexpr int RING_BYTES = 131072;
constexpr int LDSCTL_OFF = RING_BYTES, MISC_OFF = LDSCTL_OFF + 320;
constexpr int LDS_BYTES = 147456;

__device__ __forceinline__ float bf2f(bf16 b) { return __uint_as_float(((u32)b) << 16); }
__device__ __forceinline__ float bflo(u32 w) { return __uint_as_float(w << 16); }
__device__ __forceinline__ float bfhi(u32 w) { return __uint_as_float(w & 0xffff0000u); }
__device__ __forceinline__ u32 f2bf(float f) { u32 u = __float_as_uint(f); return (u + 0x7fffu + ((u >> 16) & 1u)) >> 16; }
__device__ __forceinline__ u32 pk2(float lo, float hi) { return f2bf(lo) | (f2bf(hi) << 16); }
__device__ __forceinline__ float sigmoid_fast(float x) { return __builtin_amdgcn_rcpf(1.0f + __expf(-x)); }
__device__ __forceinline__ float sigmoid_acc(float x) { return 1.0f / (1.0f + expf(-x)); }
__device__ __forceinline__ float wave_sum(float v) {
    v += __int_as_float(__builtin_amdgcn_ds_swizzle(__float_as_int(v), (1 << 10) | 0x1f));
    v += __int_as_float(__builtin_amdgcn_ds_swizzle(__float_as_int(v), (2 << 10) | 0x1f));
    v += __int_as_float(__builtin_amdgcn_ds_swizzle(__float_as_int(v), (4 << 10) | 0x1f));
    v += __int_as_float(__builtin_amdgcn_ds_swizzle(__float_as_int(v), (8 << 10) | 0x1f));
    v += __int_as_float(__builtin_amdgcn_ds_swizzle(__float_as_int(v), (16 << 10) | 0x1f));
    return __int_as_float(__builtin_amdgcn_readlane(__float_as_int(v), 0)) + __int_as_float(__builtin_amdgcn_readlane(__float_as_int(v), 32));
}
#define LDS_WAIT() asm volatile("s_waitcnt lgkmcnt(0)" ::: "memory")
#define VM_WAIT() asm volatile("s_waitcnt vmcnt(0)" ::: "memory")
__device__ __forceinline__ int ld_agent(const int* p) { return (int)__hip_atomic_load((const u32*)p, RLX_AGENT); }

namespace pg8 {
constexpr int BM = 256, BK = 64, HALF = 128, HTB = HALF * BK * 2, STAGE_BYTES = 8 * HTB, NXCD = 8, WGM = 8;
__host__ __device__ __forceinline__ int lds_byte(int r, int c) { const int st = (r >> 4) * 2 + (c >> 5), rr = r & 15, cc = c & 31, ob = rr * 64 + cc * 2; return st * 1024 + (ob ^ (((ob >> 9) & 1) << 5)); }
__host__ __device__ __forceinline__ void stage_rc(int b, int& R, int& C) { const int st = b / 1024, sb = b % 1024, swz = sb ^ (((sb >> 9) & 1) << 5); R = (st >> 1) * 16 + swz / 64; C = (st & 1) * 32 + (swz % 64) / 2; }
__host__ __device__ __forceinline__ int perm32(int rho) { const int n = rho >> 4, i = rho & 15; return 8 * (i >> 2) + 4 * n + (i & 3); }

struct Unit { int pm, pn, aux; };

__device__ __forceinline__ int xcd_remap(int L, int nwg) { const int q = nwg / NXCD, r = nwg % NXCD, xcd = L % NXCD, o = L / NXCD; return (xcd < r ? xcd * (q + 1) : r * (q + 1) + (xcd - r) * q) + o; }

struct RegOrder {
    static constexpr bool GATHER = false;
    const char* A; const char* Bt; int lda, ldb;
    int nM, nN, nwg, G, c, halves, khalf;
    __device__ __forceinline__ void init(const void* A_, const void* Bt_, int lda_, int ldb_, int M, int N, int G_, int c_, int halves_, int khalf_) {
        A = (const char*)A_; Bt = (const char*)Bt_; lda = lda_; ldb = ldb_; nM = M / BM; nN = N / BM; nwg = nM * nN; G = G_; c = c_; halves = halves_; khalf = khalf_; }
    __device__ __forceinline__ bool next(int i, Unit& u) const {
        const int round = (halves == 2) ? (i >> 1) : i; u.aux = (halves == 2) ? (i & 1) : 0;
        const long L = (long)round * G + c; if (L >= nwg) return false;
        const int wgid = xcd_remap((int)L, nwg);
        const int nig = WGM * nN, gid = wgid / nig, fm = gid * WGM, gsz = (nM - fm) < WGM ? (nM - fm) : WGM;
        u.pm = fm + ((wgid % nig) % gsz); u.pn = (wgid % nig) / gsz; return true;
    }
    __device__ __forceinline__ const char* a_base(const Unit& u) const { return A + (size_t)u.pm * BM * lda * 2 + (size_t)u.aux * khalf; }
    __device__ __forceinline__ const char* b_base(const Unit& u) const { return Bt + (size_t)u.pn * BM * ldb * 2 + (size_t)u.aux * khalf; }
    __device__ __forceinline__ unsigned a_row_off(const Unit&, int) const { return 0u; }
};
template <bool GATHER_> struct MoeOrder {
    static constexpr bool GATHER = GATHER_;
    const char* A; const char* Bt; int lda, ldb; const int* rowtok; const int* tilee; int nunits, npn, G, c; size_t estride, bextra;
    __device__ __forceinline__ bool next(int i, Unit& u) const {
        const long L = (long)i * G + c; if (L >= nunits) return false;
        const int wgid = xcd_remap((int)L, nunits);
        u.pm = wgid / npn; u.pn = wgid - u.pm * npn; u.aux = __builtin_amdgcn_readfirstlane(ld_agent(tilee + u.pm)); return true;
    }
    __device__ __forceinline__ const char* a_base(const Unit& u) const { return GATHER ? A : A + (size_t)u.pm * BM * lda * 2; }
    __device__ __forceinline__ const char* b_base(const Unit& u) const { return Bt + (size_t)u.aux * estride + bextra + (size_t)u.pn * BM * ldb * 2; }
    __device__ __forceinline__ unsigned a_row_off(const Unit& u, int r) const { return (unsigned)rowtok[u.pm * BM + r] * (unsigned)(lda * 2); }
};

__device__ __forceinline__ unsigned cvt_pk_bf16(float lo, float hi) { unsigned r; asm volatile("v_cvt_pk_bf16_f32 %0, %1, %2" : "=v"(r) : "v"(lo), "v"(hi)); return r; }

struct EpiS1 { static constexpr bool PERM = true;
    bf16* ubcv; bf16* gates; const float* bgate;
    __device__ __forceinline__ void operator()(const f32x4 (&acc)[2][2][4][2], const Unit& u, int wr, int wc, int fr, int fq) const {
        asm volatile("" : "+v"(fr), "+v"(fq));
        const int row0 = u.pm * BM + wr * 64 + fr; int colt = u.pn * BM; const bool isg = colt >= 2048; bf16* base = isg ? gates : ubcv; if (isg) colt -= 2048;
        const int col0 = colt + wc * 32 + 8 * fq;
        f32x4 bv[2][2];
#pragma unroll
        for (int bj = 0; bj < 2; ++bj)
#pragma unroll
            for (int n = 0; n < 2; ++n) bv[bj][n] = isg ? *(const f32x4*)(bgate + col0 + bj * HALF + 4 * n) : (f32x4){0.f, 0.f, 0.f, 0.f};
#pragma unroll
        for (int ai = 0; ai < 2; ++ai)
#pragma unroll
            for (int m = 0; m < 4; ++m) { bf16* rowp = base + (size_t)(row0 + ai * HALF + m * 16) * 2048 + col0;
#pragma unroll
                for (int bj = 0; bj < 2; ++bj) { f32x4 v0 = acc[ai][bj][m][0] + bv[bj][0], v1 = acc[ai][bj][m][1] + bv[bj][1];
                    if (isg) {
#pragma unroll
                        for (int j = 0; j < 4; ++j) { v0[j] = sigmoid_fast(v0[j]); v1[j] = sigmoid_fast(v1[j]); } }
                    u32x4 w; w.x = cvt_pk_bf16(v0[0], v0[1]); w.y = cvt_pk_bf16(v0[2], v0[3]); w.z = cvt_pk_bf16(v1[0], v1[1]); w.w = cvt_pk_bf16(v1[2], v1[3]);
                    *(u32x4*)(rowp + bj * HALF) = w; } }
    }
};
struct EpiS2B { static constexpr bool PERM = true;
    const bf16* gates; float* part; bf16* merged;
    __device__ __forceinline__ void operator()(const f32x4 (&acc)[2][2][4][2], const Unit& u, int wr, int wc, int fr, int fq) const {
        asm volatile("" : "+v"(fr), "+v"(fq));
        const int row0 = u.pm * BM + wr * 64 + fr, col0 = u.pn * BM + wc * 32 + 8 * fq; const int goff = u.aux ? 1024 : 0;
#pragma unroll
        for (int ai = 0; ai < 2; ++ai)
#pragma unroll
            for (int m = 0; m < 4; ++m) { const size_t r = (size_t)(row0 + ai * HALF + m * 16);
#pragma unroll
                for (int bj = 0; bj < 2; ++bj) { const int c = col0 + bj * HALF;
                    const u32x4 g = *(const u32x4*)(gates + r * 2048 + goff + c);
                    f32x4 v0 = acc[ai][bj][m][0], v1 = acc[ai][bj][m][1];
                    v0[0] *= bflo(g.x); v0[1] *= bfhi(g.x); v0[2] *= bflo(g.y); v0[3] *= bfhi(g.y); v1[0] *= bflo(g.z); v1[1] *= bfhi(g.z); v1[2] *= bflo(g.w); v1[3] *= bfhi(g.w);
                    float* pp = part + r * 1024 + c;
                    if (u.aux == 0) { *(f32x4*)pp = v0; *(f32x4*)(pp + 4) = v1; }
                    else { v0 += *(const f32x4*)pp; v1 += *(const f32x4*)(pp + 4);
                        u32x4 w; w.x = cvt_pk_bf16(v0[0], v0[1]); w.y = cvt_pk_bf16(v0[2], v0[3]); w.z = cvt_pk_bf16(v1[0], v1[1]); w.w = cvt_pk_bf16(v1[2], v1[3]);
                        *(u32x4*)(merged + r * 1024 + c) = w; } } }
    }
};
struct EpiS3 { static constexpr bool PERM = false;
    const float* x; float* out;
    __device__ __forceinline__ void operator()(const f32x4 (&acc)[2][2][4][2], const Unit& u, int wr, int wc, int fr, int fq) const {
        asm volatile("" : "+v"(fr), "+v"(fq));
        const int row0 = u.pm * BM + wr * 64 + fr, col0 = u.pn * BM + wc * 32 + 4 * fq;
#pragma unroll
        for (int ai = 0; ai < 2; ++ai)
#pragma unroll
            for (int m = 0; m < 4; ++m) { const size_t o = (size_t)(row0 + ai * HALF + m * 16) * D + col0;
#pragma unroll
                for (int bj = 0; bj < 2; ++bj)
#pragma unroll
                    for (int n = 0; n < 2; ++n) { const f32x4 xs = *(const f32x4*)(x + o + bj * HALF + n * 16); *(f32x4*)(out + o + bj * HALF + n * 16) = xs + acc[ai][bj][m][n]; } }
    }
};
struct EpiS5 { static constexpr bool PERM = true;
    bf16* hid;
    __device__ __forceinline__ void operator()(const f32x4 (&acc)[2][2][4][2], const Unit& u, int wr, int wc, int fr, int fq) const {
        asm volatile("" : "+v"(fr), "+v"(fq));
        const int row0 = u.pm * BM + wr * 64 + fr, col0 = u.pn * HALF + wc * 32 + 8 * fq;
#pragma unroll
        for (int ai = 0; ai < 2; ++ai)
#pragma unroll
            for (int m = 0; m < 4; ++m) { f32x4 h0, h1;
#pragma unroll
                for (int j = 0; j < 4; ++j) { const float g0 = acc[ai][0][m][0][j], g1 = acc[ai][0][m][1][j];
                    h0[j] = g0 * sigmoid_fast(g0) * acc[ai][1][m][0][j]; h1[j] = g1 * sigmoid_fast(g1) * acc[ai][1][m][1][j]; }
                u32x4 w; w.x = cvt_pk_bf16(h0[0], h0[1]); w.y = cvt_pk_bf16(h0[2], h0[3]); w.z = cvt_pk_bf16(h1[0], h1[1]); w.w = cvt_pk_bf16(h1[2], h1[3]);
                *(u32x4*)(hid + (size_t)(row0 + ai * HALF + m * 16) * EH + col0) = w; }
    }
};
struct EpiS6 { static constexpr bool PERM = true;
    const float* roww; bf16* y;
    __device__ __forceinline__ void operator()(const f32x4 (&acc)[2][2][4][2], const Unit& u, int wr, int wc, int fr, int fq) const {
        asm volatile("" : "+v"(fr), "+v"(fq));
        const int row0 = u.pm * BM + wr * 64 + fr, col0 = u.pn * BM + wc * 32 + 8 * fq;
#pragma unroll
        for (int ai = 0; ai < 2; ++ai)
#pragma unroll
            for (int m = 0; m < 4; ++m) { const int r = row0 + ai * HALF + m * 16; const float w8 = roww[r];
#pragma unroll
                for (int bj = 0; bj < 2; ++bj) { const f32x4 v0 = acc[ai][bj][m][0] * w8, v1 = acc[ai][bj][m][1] * w8;
                    u32x4 w; w.x = cvt_pk_bf16(v0[0], v0[1]); w.y = cvt_pk_bf16(v0[2], v0[3]); w.z = cvt_pk_bf16(v1[0], v1[1]); w.w = cvt_pk_bf16(v1[2], v1[3]);
                    *(u32x4*)(y + (size_t)r * 512 + col0 + bj * HALF) = w; } }
    }
};

template <class Epi, class Sched, bool ALIGN_EPI, bool SP2>
__device__ __forceinline__ void gemm_phase(LAS unsigned char* lds, const Sched& S, const Epi& E, const int nt, const int wid) {
    const int lane = (int)__builtin_amdgcn_mbcnt_hi(~0u, __builtin_amdgcn_mbcnt_lo(~0u, 0u)), tid = wid * 64 + lane, wr = wid >> 2, wc = wid & 3, fr = lane & 15, fq = lane >> 4;
    const int lda = S.lda, ldb = S.ldb;
    unsigned voffA[2], voffB[2], colA[2]; int RA[2];
#pragma unroll
    for (int i = 0; i < 2; ++i) { int R, C; stage_rc(tid * 16 + i * 8192, R, C); const int Rb = Epi::PERM ? ((R & ~31) + perm32(R & 31)) : R;
        voffA[i] = (unsigned)(R * lda + C) * 2u; voffB[i] = (unsigned)(Rb * ldb + C) * 2u; RA[i] = R; colA[i] = (unsigned)C * 2u; }
    const size_t kstep = (size_t)(BK * 2);
    const size_t hstepA = (size_t)HALF * lda * 2, hstepB = (size_t)HALF * ldb * 2;
    const unsigned ldsw = (unsigned)wid * 1024u;
    const int aoff = lds_byte(wr * 64 + fr, fq * 8), boff = lds_byte(wc * 32 + fr, fq * 8);
#define PG8_SA(b, h) (((b) * 2 + (h)) * HTB)
#define PG8_SB(b, h) ((4 + (b) * 2 + (h)) * HTB)
#define PG8_GLDS(gp, lp) __builtin_amdgcn_global_load_lds((const unsigned*)(gp), (LAS unsigned*)(lp), 16, 0, 0)
#define PG8_STAGE_A(bufoff, wn, h, kb) do { _Pragma("unroll") for (int _i = 0; _i < 2; ++_i) { \
        const char* _p = Sched::GATHER ? (((wn) ? nA : cA) + (kb) + ((wn) ? gn[h][_i] : ga[h][_i])) : (((wn) ? nA : cA) + (size_t)(h) * hstepA + (kb) + voffA[_i]); \
        PG8_GLDS(_p, lds + (bufoff) + ldsw + _i * 8192); } } while (0)
#define PG8_STAGE_B(bufoff, gbase) do { _Pragma("unroll") for (int _i = 0; _i < 2; ++_i) PG8_GLDS((const char*)(gbase) + voffB[_i], lds + (bufoff) + ldsw + _i * 8192); } while (0)
#define PG8_LDA(dst, b, h) do { _Pragma("unroll") for (int m = 0; m < 4; ++m) _Pragma("unroll") for (int k = 0; k < 2; ++k) dst[m][k] = *(const LAS bf16x8*)(lds + PG8_SA(b, h) + aoff + m * 2048 + k * 1024); } while (0)
#define PG8_LDB(dst, b, h) do { _Pragma("unroll") for (int n = 0; n < 2; ++n) _Pragma("unroll") for (int k = 0; k < 2; ++k) dst[n][k] = *(const LAS bf16x8*)(lds + PG8_SB(b, h) + boff + n * 2048 + k * 1024); } while (0)
#define PG8_MMA(ai, bj, At, Bt) do { __builtin_amdgcn_s_setprio(1); _Pragma("unroll") for (int m = 0; m < 4; ++m) _Pragma("unroll") for (int n = 0; n < 2; ++n) _Pragma("unroll") for (int k = 0; k < 2; ++k) \
        acc[ai][bj][m][n] = __builtin_amdgcn_mfma_f32_16x16x32_bf16(Bt[n][k], At[m][k], acc[ai][bj][m][n], 0, 0, 0); __builtin_amdgcn_s_setprio(0); } while (0)
#define PG8_WAIT_V(n) asm volatile("s_waitcnt vmcnt(" #n ")" ::: "memory")
#define PG8_WAIT_L(n) asm volatile("s_waitcnt lgkmcnt(" #n ")" ::: "memory")
#define PG8_BAR __builtin_amdgcn_s_barrier()
#define PG8_SCHED __builtin_amdgcn_sched_barrier(0)
    Unit cur, nxt; int ui = 0;
    if (!S.next(0, cur)) return;
    f32x4 acc[2][2][4][2];
#pragma unroll
    for (int a = 0; a < 2; ++a)
#pragma unroll
        for (int b = 0; b < 2; ++b)
#pragma unroll
            for (int m = 0; m < 4; ++m)
#pragma unroll
                for (int n = 0; n < 2; ++n) acc[a][b][m][n] = (f32x4){0.f, 0.f, 0.f, 0.f};
    bf16x8 At[4][2], B0[2][2], B1[2][2];
    unsigned ga[2][2], gn[2][2];
#pragma unroll
    for (int h = 0; h < 2; ++h)
#pragma unroll
        for (int i = 0; i < 2; ++i) { ga[h][i] = Sched::GATHER ? S.a_row_off(cur, h * HALF + RA[i]) + colA[i] : 0u; gn[h][i] = ga[h][i]; }
    const char* cA = S.a_base(cur); const char* cB = S.b_base(cur);
    const char* nA = cA; const char* nB = cB;
    if constexpr (SP2) {
        PG8_STAGE_B(PG8_SB(0, 0), cB); PG8_STAGE_B(PG8_SB(0, 1), cB + hstepB); PG8_STAGE_A(PG8_SA(0, 0), false, 0, 0); PG8_STAGE_A(PG8_SA(0, 1), false, 1, 0);
        if (wr == 1) PG8_BAR;
        PG8_WAIT_V(2); PG8_BAR;
        PG8_STAGE_B(PG8_SB(1, 0), cB + kstep); PG8_STAGE_A(PG8_SA(1, 0), false, 0, kstep); PG8_STAGE_B(PG8_SB(1, 1), cB + hstepB + kstep);
        PG8_WAIT_V(6); PG8_BAR;
    } else {
        PG8_STAGE_B(PG8_SB(0, 0), cB); PG8_STAGE_A(PG8_SA(0, 0), false, 0, 0); PG8_STAGE_B(PG8_SB(0, 1), cB + hstepB); PG8_STAGE_A(PG8_SA(0, 1), false, 1, 0);
        if (wr == 1) PG8_BAR;
        PG8_WAIT_V(4); PG8_BAR;
        PG8_STAGE_B(PG8_SB(1, 0), cB + kstep); PG8_STAGE_A(PG8_SA(1, 0), false, 0, kstep); PG8_STAGE_B(PG8_SB(1, 1), cB + hstepB + kstep);
        PG8_WAIT_V(6); PG8_BAR;
    }
    for (;;) {
        const bool has_next = S.next(ui + 1, nxt);
        if (has_next) { nA = S.a_base(nxt); nB = S.b_base(nxt); } else { nA = cA; nB = cB; }
        if constexpr (Sched::GATHER) {
#pragma unroll
            for (int h = 0; h < 2; ++h)
#pragma unroll
                for (int i = 0; i < 2; ++i) gn[h][i] = has_next ? S.a_row_off(nxt, h * HALF + RA[i]) + colA[i] : ga[h][i];
        }
        for (int t = 0; t < nt; t += 2) {
            const bool last = (t == nt - 2);
            const size_t k1 = (size_t)(t + 1) * kstep;
            const size_t k2 = last ? 0 : (size_t)(t + 2) * kstep; const size_t k3 = k2 + kstep;
            const char* b2 = last ? nB : cB + (size_t)(t + 2) * kstep; const char* b3 = b2 + kstep;
            if constexpr (SP2) {
            PG8_LDB(B0, 0, 0); PG8_LDB(B1, 0, 1); PG8_SCHED; PG8_LDA(At, 0, 0); PG8_STAGE_A(PG8_SA(1, 1), false, 1, k1);
            PG8_WAIT_V(8); PG8_WAIT_L(0); PG8_BAR; PG8_MMA(0, 0, At, B0); PG8_MMA(0, 1, At, B1); PG8_BAR; PG8_SCHED;
            PG8_LDA(At, 0, 1); PG8_STAGE_B(PG8_SB(0, 0), b2); PG8_STAGE_B(PG8_SB(0, 1), b2 + hstepB); PG8_STAGE_A(PG8_SA(0, 0), last, 0, k2);
            PG8_WAIT_V(8); PG8_WAIT_L(0); PG8_BAR; PG8_MMA(1, 0, At, B0); PG8_MMA(1, 1, At, B1); PG8_BAR; PG8_SCHED;
            PG8_LDB(B0, 1, 0); PG8_LDB(B1, 1, 1); PG8_SCHED; PG8_LDA(At, 1, 0); PG8_STAGE_A(PG8_SA(0, 1), last, 1, k2);
            PG8_WAIT_V(8); PG8_WAIT_L(0); PG8_BAR; PG8_MMA(0, 0, At, B0); PG8_MMA(0, 1, At, B1); PG8_BAR; PG8_SCHED;
            PG8_LDA(At, 1, 1); PG8_STAGE_B(PG8_SB(1, 0), b3); PG8_STAGE_B(PG8_SB(1, 1), b3 + hstepB); PG8_STAGE_A(PG8_SA(1, 0), last, 0, k3);
            PG8_WAIT_V(8); PG8_WAIT_L(0); PG8_BAR; PG8_MMA(1, 0, At, B0); PG8_MMA(1, 1, At, B1); PG8_BAR; PG8_SCHED;
            } else {
            PG8_LDB(B0, 0, 0); PG8_SCHED; PG8_LDA(At, 0, 0); PG8_STAGE_A(PG8_SA(1, 1), false, 1, k1);
            PG8_WAIT_L(8); PG8_BAR; PG8_WAIT_L(0); PG8_MMA(0, 0, At, B0); PG8_BAR; PG8_SCHED;
            PG8_LDB(B1, 0, 1); PG8_STAGE_B(PG8_SB(0, 0), b2);
            PG8_BAR; PG8_WAIT_L(0); PG8_MMA(0, 1, At, B1); PG8_BAR;
            PG8_LDA(At, 0, 1); PG8_STAGE_A(PG8_SA(0, 0), last, 0, k2);
            PG8_BAR; PG8_WAIT_L(0); PG8_MMA(1, 0, At, B0); PG8_BAR; PG8_SCHED;
            PG8_STAGE_B(PG8_SB(0, 1), b2 + hstepB);
            PG8_WAIT_V(6); PG8_BAR; PG8_MMA(1, 1, At, B1); PG8_BAR;
            PG8_LDB(B0, 1, 0); PG8_SCHED; PG8_LDA(At, 1, 0); PG8_STAGE_A(PG8_SA(0, 1), last, 1, k2);
            PG8_WAIT_L(8); PG8_BAR; PG8_WAIT_L(0); PG8_MMA(0, 0, At, B0); PG8_BAR; PG8_SCHED;
            PG8_LDB(B1, 1, 1); PG8_STAGE_B(PG8_SB(1, 0), b3);
            PG8_BAR; PG8_WAIT_L(0); PG8_MMA(0, 1, At, B1); PG8_BAR;
            PG8_LDA(At, 1, 1); PG8_STAGE_A(PG8_SA(1, 0), last, 0, k3);
            PG8_BAR; PG8_WAIT_L(0); PG8_MMA(1, 0, At, B0); PG8_BAR; PG8_SCHED;
            PG8_STAGE_B(PG8_SB(1, 1), b3 + hstepB);
            PG8_WAIT_V(6); PG8_BAR; PG8_MMA(1, 1, At, B1); PG8_BAR;
            }
        }
        if constexpr (ALIGN_EPI) { if (wr == 0) PG8_BAR; }
        E(acc, cur, wr, wc, fr, fq);
        if (!has_next) break;
#pragma unroll
        for (int a = 0; a < 2; ++a)
#pragma unroll
            for (int b = 0; b < 2; ++b)
#pragma unroll
                for (int m = 0; m < 4; ++m)
#pragma unroll
                    for (int n = 0; n < 2; ++n) acc[a][b][m][n] = (f32x4){0.f, 0.f, 0.f, 0.f};
        cur = nxt; cA = nA; cB = nB; ++ui;
#pragma unroll
        for (int h = 0; h < 2; ++h)
#pragma unroll
            for (int i = 0; i < 2; ++i) ga[h][i] = gn[h][i];
        if constexpr (ALIGN_EPI) { if (wr == 1) PG8_BAR; }
    }
    PG8_WAIT_V(0);
    if constexpr (!ALIGN_EPI) { if (wr == 0) PG8_BAR; }
    PG8_BAR;
#undef PG8_SA
#undef PG8_SB
#undef PG8_GLDS
#undef PG8_STAGE_A
#undef PG8_STAGE_B
#undef PG8_LDA
#undef PG8_LDB
#undef PG8_MMA
#undef PG8_WAIT_V
#undef PG8_WAIT_L
#undef PG8_BAR
#undef PG8_SCHED
}
}

#define XB_TMO      128
#define XB_XCNT(j)  (256  + 64 * (j))
#define XB_XSUB(j)  (1280 + 64 * (j))
#define XB_XGEN(j)  (2304 + 64 * (j))
#define XB_TOP      3328
#define XB_TOPGEN   3392
#define XCD_BAR_WORDS 3456
#define XB_SPIN_CAP (1u << 18)
__device__ __forceinline__ unsigned xb_ld(unsigned* p)              { return __hip_atomic_load(p, __ATOMIC_RELAXED, __HIP_MEMORY_SCOPE_AGENT); }
__device__ __forceinline__ unsigned xb_add(unsigned* p, unsigned v) { return __hip_atomic_fetch_add(p, v, __ATOMIC_RELAXED, __HIP_MEMORY_SCOPE_AGENT); }
__device__ __forceinline__ unsigned xb_xcc_id() { return (unsigned)__builtin_amdgcn_s_getreg((3 << 11) | 20) & 0xFu; }
#define XB_SPIN(cond, bar) do { unsigned _sp = 0; while (cond) { __builtin_amdgcn_s_sleep(1); \
    if ((++_sp & 255u) == 0u) { if (xb_ld(&(bar)[XB_TMO])) break; if (_sp > XB_SPIN_CAP) { atomicAdd(&(bar)[XB_TMO], 1u); break; } } } } while (0)
struct XcdBarrier { unsigned* bar; unsigned x; volatile LAS unsigned* st; };
__device__ __forceinline__ XcdBarrier xcd_barrier_post(unsigned* bar, volatile LAS unsigned* st) {
    XcdBarrier b; b.bar = bar; b.x = xb_xcc_id(); b.st = st;
    if (threadIdx.x == 0) (void)xb_add(&bar[XB_XCNT(b.x)], 1u);
    return b;
}
__device__ __forceinline__ void xcd_barrier_complete(unsigned* bar, unsigned x, unsigned& nloc, unsigned& nx) {
    const unsigned G = gridDim.x * gridDim.y * gridDim.z;
    unsigned sum, cnt, mine, sp = 0u;
    for (;;) {
        sum = 0u; cnt = 0u; mine = 0u;
#pragma unroll
        for (unsigned j = 0; j < 16; ++j) { const unsigned c = xb_ld(&bar[XB_XCNT(j)]); sum += c; cnt += (c > 0u) ? 1u : 0u; mine = (j == x) ? c : mine; }
        if (sum == G) break;
        __builtin_amdgcn_s_sleep(1);
        if ((++sp & 255u) == 0u) { if (xb_ld(&bar[XB_TMO])) break; if (sp > XB_SPIN_CAP) { atomicAdd(&bar[XB_TMO], 1u); break; } }
    }
    nloc = mine > 0u ? mine : 1u; nx = cnt > 0u ? cnt : 1u;
}
__device__ __forceinline__ void xcd_barrier(const XcdBarrier& b, const int wave) {
    asm volatile("s_waitcnt vmcnt(0)" ::: "memory");
    __syncthreads();
    if (wave == 0 && __builtin_amdgcn_mbcnt_hi(~0u, __builtin_amdgcn_mbcnt_lo(~0u, 0u)) == 0u) {
        unsigned* bar = b.bar;
        __builtin_amdgcn_s_waitcnt(0);
        unsigned nloc = b.st[0], nx = b.st[1];
        if (nloc == 0u) { xcd_barrier_complete(bar, b.x, nloc, nx); b.st[0] = nloc; b.st[1] = nx; }
        const unsigned old = xb_add(&bar[XB_XSUB(b.x)], 1u);
        const unsigned gen = old / nloc;
        if (old + 1u == (gen + 1u) * nloc) {
            __builtin_amdgcn_fence(__ATOMIC_RELEASE, "agent");
            asm volatile("s_waitcnt vmcnt(0)" ::: "memory");
            const unsigned og = xb_add(&bar[XB_TOP], 1u);
            const unsigned tg = og / nx;
            if (og + 1u == (tg + 1u) * nx) xb_add(&bar[XB_TOPGEN], 1u);
            else XB_SPIN(xb_ld(&bar[XB_TOPGEN]) == tg, bar);
            __builtin_amdgcn_fence(__ATOMIC_ACQUIRE, "agent");
            xb_add(&bar[XB_XGEN(b.x)], 1u);
            asm volatile("s_waitcnt vmcnt(0)" ::: "memory");
        } else {
            XB_SPIN(xb_ld(&bar[XB_XGEN(b.x)]) == gen, bar);
            __builtin_amdgcn_fence(__ATOMIC_ACQUIRE, "agent");
            asm volatile("s_waitcnt vmcnt(0)" ::: "memory");
        }
    }
    __syncthreads();
}

struct Args { const float* in[20]; float* out; unsigned char* ws; int ph_lo, ph_hi, rep, exa, exb, pad; };
struct Frame {
    LAS unsigned char* lds; volatile LAS unsigned* MISC; u32* ctl;
    int tid, lane, wave, vcu, G;
};

__device__ __forceinline__ void p0_item64(const float* W, int N, bf16* WT, int ldo, int mode, LAS unsigned char* scr, int item, int lane) {
    const int nblk = N >> 6, kb = item / nblk, nb = item - kb * nblk, k0 = kb * 64, n0 = nb * 64;
    const float* src = W + (size_t)k0 * N + n0 + lane;
    float v[64];
#pragma unroll
    for (int i = 0; i < 64; ++i) v[i] = src[(size_t)i * N];
    LAS unsigned char* row = scr + lane * 144;
#pragma unroll
    for (int c = 0; c < 8; ++c) { u32x4 o; o.x = pg8::cvt_pk_bf16(v[8 * c], v[8 * c + 1]); o.y = pg8::cvt_pk_bf16(v[8 * c + 2], v[8 * c + 3]); o.z = pg8::cvt_pk_bf16(v[8 * c + 4], v[8 * c + 5]); o.w = pg8::cvt_pk_bf16(v[8 * c + 6], v[8 * c + 7]);
        *(LAS u32x4*)(row + c * 16) = o; }
    LDS_WAIT(); asm volatile("" ::: "memory");
    const int ch = lane & 7;
#pragma unroll
    for (int j = 0; j < 8; ++j) { const int n = (lane >> 3) + 8 * j; const u32x4 o = *(const LAS u32x4*)(scr + n * 144 + ch * 16);
        const int nn = n0 + n; const int r = mode == 0 ? nn : ((nn >> 7) * 256 + (mode == 2 ? 128 : 0) + (nn & 127));
        *(u32x4*)(WT + (size_t)r * ldo + k0 + ch * 8) = o; }
    LDS_WAIT(); asm volatile("" ::: "memory");
}

__global__ void __launch_bounds__(NTHR, 2) mega_fwd(Args args) {
    extern __shared__ __attribute__((aligned(16))) unsigned char lds_raw[];
    LAS unsigned char* const lds = (LAS unsigned char*)lds_raw;
    const int wv0_ = __builtin_amdgcn_readfirstlane((int)(threadIdx.x >> 6));
#define CTL ((u32*)(KWS + WS_CTL))
#define CTL0 ((u32*)(args.ws + WS_CTL))
#define CAS __attribute__((address_space(4)))
#define KIN(k) (*(const float* const CAS*)(ka_ + 8 * (k)))
#define KOUT (*(float* const CAS*)(ka_ + 160))
#define KWS (*(unsigned char* const CAS*)(ka_ + 168))
#define PHV() const CAS char* ka_ = (const CAS char*)__builtin_amdgcn_kernarg_segment_ptr(); asm volatile("" : "+s"(ka_)); int wave_ = wv0_; asm volatile("" : "+s"(wave_)); const int lane_ = (int)__builtin_amdgcn_mbcnt_hi(~0u, __builtin_amdgcn_mbcnt_lo(~0u, 0u)); const int tid_ = wave_ * 64 + lane_; \
    const int G_ = gridDim.x; const int vcu_ = (G_ % 8 == 0) ? ((int)blockIdx.x % 8) * (G_ / 8) + (int)blockIdx.x / 8 : (int)blockIdx.x; \
    const int gw = vcu_ * NWAVES + wave_, NGW = G_ * NWAVES, gt = vcu_ * NTHR + tid_, NGT = G_ * NTHR; (void)lane_; (void)gw; (void)NGW; (void)gt; (void)NGT;
#define p_x KIN(0)
#define p_g_mix KIN(1)
#define p_w_in KIN(2)
#define p_b_gate KIN(3)
#define p_w_pool_group KIN(4)
#define p_pool_scale KIN(5)
#define p_w_pool_out KIN(6)
#define p_conv_w KIN(7)
#define p_w_conv_out KIN(8)
#define p_w_o KIN(9)
#define p_g_ffn KIN(10)
#define p_w_router KIN(11)
#define p_router_bias KIN(12)
#define p_e_gate KIN(13)
#define p_e_up KIN(14)
#define p_e_down KIN(15)
#define p_s_gate KIN(16)
#define p_s_up KIN(17)
#define p_s_down KIN(18)
#define p_g_final KIN(19)
#define p_out KOUT
#define p_tope ((int*)(KWS + WS_TOPE))
#define p_topw ((float*)(KWS + WS_TOPW))
#define p_inv ((int*)(KWS + WS_INV))
#define p_rowtok ((int*)(KWS + WS_ROWTOK))
#define p_roww ((float*)(KWS + WS_ROWW))
#define p_off ((int*)(KWS + WS_OFF))
#define p_tilee ((int*)(KWS + WS_TILEE))
#define p_edt ((bf16*)(KWS + WS_EDT))
#define p_wtin ((bf16*)(KWS + WS_WTIN))
#define p_wtab ((bf16*)(KWS + WS_WTAB))
#define p_wto ((bf16*)(KWS + WS_WTO))
#define p_egut ((bf16*)(KWS + WS_EGUT))
#define p_H ((bf16*)(KWS + WS_H))
#define p_AB p_H
#define p_H2 p_H
#define p_ubcv ((bf16*)(KWS + WS_UBCV))
#define p_merged p_ubcv
#define p_gates ((bf16*)(KWS + WS_GATES))
#define p_hid ((bf16*)(KWS + WS_HID))
#define p_y ((bf16*)(KWS + WS_Y))

    for (int u = threadIdx.x; u < (LDS_BYTES - LDSCTL_OFF) / 4; u += NTHR) ((LAS unsigned*)(lds + LDSCTL_OFF))[u] = 0u;
    __syncthreads();
    XcdBarrier bar; bar.bar = (unsigned*)(CTL0 + CW_BAR); bar.x = 0; bar.st = nullptr;
    if (!MK_PER_PHASE) bar = xcd_barrier_post((unsigned*)(CTL0 + CW_BAR), (volatile LAS unsigned*)(lds + MISC_OFF) + 8);
    const int lo = args.ph_lo, hi = args.ph_hi;
#define IN(k) (lo <= (k) && (k) < hi)
#define SEAM(k) do { if (IN(k) && IN((k) + 1)) xcd_barrier(bar, wv0_); } while (0)
#define REPS(k) for (int rep_ = 0; rep_ < ((k) == args.rep ? 2 : 1); ++rep_)
#define REPBAR() do { if (rep_) xcd_barrier(bar, wv0_); } while (0)

    REPS(0) if (IN(0)) { REPBAR(); PHV();
        LAS unsigned char* scr = lds + wave_ * 9216;
        constexpr int I_IN = 16 * 64, I_CO = 8 * 16, I_O = 16 * 16, I_EG = 64 * 64, I_SG = 64, I_ED = 64 * 64, I_SD = 64;
        constexpr int NITEMS = I_IN + I_CO + I_O + 2 * I_EG + 2 * I_SG + I_ED + I_SD;
        for (int rr_ = 0; rr_ < (args.rep == 100 ? 2 : 1); ++rr_)
        for (int it = gw; it < NITEMS; it += NGW) {
            int r = it; const float* W; bf16* WT; int N, ldo, mode = 0;
            if (r < I_IN) { W = p_w_in; N = NIN; WT = p_wtin; ldo = D; }
            else if ((r -= I_IN) < I_CO) { W = p_w_conv_out; N = D; WT = p_wtab + 512; ldo = 1024; }
            else if ((r -= I_CO) < I_O) { W = p_w_o; N = D; WT = p_wto; ldo = D; }
            else if ((r -= I_O) < I_EG) { const int e = r >> 6; r &= 63; W = p_e_gate + (size_t)e * D * EH; N = EH; WT = p_egut + (size_t)e * 512 * D; ldo = D; mode = 1; }
            else if ((r -= I_EG) < I_EG) { const int e = r >> 6; r &= 63; W = p_e_up + (size_t)e * D * EH; N = EH; WT = p_egut + (size_t)e * 512 * D; ldo = D; mode = 2; }
            else if ((r -= I_EG) < I_SG) { W = p_s_gate; N = EH; WT = p_egut + (size_t)64 * 512 * D; ldo = D; mode = 1; }
            else if ((r -= I_SG) < I_SG) { W = p_s_up; N = EH; WT = p_egut + (size_t)64 * 512 * D; ldo = D; mode = 2; }
            else if ((r -= I_SG) < I_ED) { const int e = r >> 6; r &= 63; W = p_e_down + (size_t)e * EH * D; N = D; WT = p_edt + (size_t)e * D * EH; ldo = EH; }
            else { r -= I_ED; W = p_s_down; N = D; WT = p_edt + (size_t)64 * D * EH; ldo = EH; }
            p0_item64(W, N, WT, ldo, mode, scr, r, lane_);
        }
        for (int rr_ = 0; rr_ < (args.rep == 101 ? 2 : 1); ++rr_)
        for (int idx = gt; idx < 512 * (D / 4); idx += NGT) { const int k = idx >> 8, d4 = (idx & 255) * 4, gi = k >> 7; f32x4 s = (f32x4){0.f, 0.f, 0.f, 0.f};
            const float* wgp = p_w_pool_group + (size_t)k * 128; const float* scp = p_pool_scale + gi * 128; const float* wpo = p_w_pool_out + (size_t)(gi * 128) * D + d4;
#pragma unroll 8
            for (int j = 0; j < 128; ++j) { const float a = wgp[j] * scp[j]; s += *(const f32x4*)(wpo + (size_t)j * D) * a; }
            bf16* o = p_wtab + (size_t)d4 * 1024 + k;
            o[0] = (bf16)f2bf(s.x); o[1024] = (bf16)f2bf(s.y); o[2048] = (bf16)f2bf(s.z); o[3072] = (bf16)f2bf(s.w); }
        for (int rr_ = 0; rr_ < (args.rep == 102 ? 2 : 1); ++rr_)
        for (int m = gw; m < T; m += 2 * NGW) {
            const int m2 = (m + NGW < T) ? m + NGW : m;
            const f32x4* xr = (const f32x4*)(p_x + (size_t)m * D) + lane_; const f32x4* xr2 = (const f32x4*)(p_x + (size_t)m2 * D) + lane_; const f32x4* gr = (const f32x4*)p_g_mix + lane_;
            f32x4 v[4], v2[4]; float s = 0.f, s2 = 0.f;
#pragma unroll
            for (int j = 0; j < 4; ++j) { v[j] = xr[64 * j]; v2[j] = xr2[64 * j]; }
#pragma unroll
            for (int j = 0; j < 4; ++j) { s += (v[j].x * v[j].x + v[j].y * v[j].y) + (v[j].z * v[j].z + v[j].w * v[j].w); s2 += (v2[j].x * v2[j].x + v2[j].y * v2[j].y) + (v2[j].z * v2[j].z + v2[j].w * v2[j].w); }
            const float r = rsqrtf(wave_sum(s) * (1.0f / D) + EPS), r2 = rsqrtf(wave_sum(s2) * (1.0f / D) + EPS);
            u32x2* o = (u32x2*)(p_H + (size_t)m * D) + lane_; u32x2* o2 = (u32x2*)(p_H + (size_t)m2 * D) + lane_;
#pragma unroll
            for (int j = 0; j < 4; ++j) { const f32x4 gg = gr[64 * j]; u32x2 w; w.x = pk2(v[j].x * r * gg.x, v[j].y * r * gg.y); w.y = pk2(v[j].z * r * gg.z, v[j].w * r * gg.w); o[64 * j] = w;
                w.x = pk2(v2[j].x * r2 * gg.x, v2[j].y * r2 * gg.y); w.y = pk2(v2[j].z * r2 * gg.z, v2[j].w * r2 * gg.w); o2[64 * j] = w; }
        }
    }
    SEAM(0);
    REPS(1) if (IN(1)) { REPBAR(); PHV();
        pg8::RegOrder S; S.init(p_H, p_wtin, D, D, T, NIN, G_, (int)blockIdx.x, 1, 0);
        pg8::EpiS1 E{p_ubcv, p_gates, p_b_gate};
        pg8::gemm_phase<pg8::EpiS1, pg8::RegOrder, true, true>(lds, S, E, D / 64, wave_);
    }
    SEAM(1);
    REPS(2) if (IN(2)) { REPBAR(); PHV();
        for (int gid = gt; gid < T * 128; gid += NGT) {
            const int t = gid >> 7, c8 = (gid & 127) * 8; const int s = t & (SEQ - 1);
            float o[8];
            if (c8 < 512) {
                const int w = 2 << (c8 >> 7); const int cnt = (s + 1) < w ? (s + 1) : w; float sum[8], cur[8];
#pragma unroll
                for (int i = 0; i < 8; ++i) { sum[i] = 0.f; cur[i] = 0.f; }
#pragma unroll
                for (int j = 0; j < 16; ++j) { u32x4 v = (u32x4){0u, 0u, 0u, 0u}; if (j < cnt) v = *(const u32x4*)(p_ubcv + (size_t)(t - j) * 2048 + c8);
                    const float e0 = bflo(v.x), e1 = bfhi(v.x), e2 = bflo(v.y), e3 = bfhi(v.y), e4 = bflo(v.z), e5 = bfhi(v.z), e6 = bflo(v.w), e7 = bfhi(v.w);
                    sum[0] += e0; sum[1] += e1; sum[2] += e2; sum[3] += e3; sum[4] += e4; sum[5] += e5; sum[6] += e6; sum[7] += e7;
                    if (j == 0) { cur[0] = e0; cur[1] = e1; cur[2] = e2; cur[3] = e3; cur[4] = e4; cur[5] = e5; cur[6] = e6; cur[7] = e7; } }
                const float rc = 1.0f / (float)cnt;
#pragma unroll
                for (int i = 0; i < 8; ++i) o[i] = sum[i] * rc - cur[i];
            } else {
                const int c = c8 - 512;
#pragma unroll
                for (int i = 0; i < 8; ++i) o[i] = 0.f;
#pragma unroll
                for (int j = 0; j < 3; ++j) { const int dt = 2 - j;
                    if (s - dt >= 0) {
                        const u32x4 a = *(const u32x4*)(p_ubcv + (size_t)(t - dt) * 2048 + 1024 + c), b = *(const u32x4*)(p_ubcv + (size_t)(t - dt) * 2048 + 1536 + c);
                        const f32x4 w0 = *(const f32x4*)(p_conv_w + j * 512 + c), w1 = *(const f32x4*)(p_conv_w + j * 512 + c + 4);
                        o[0] += w0.x * (bflo(a.x) * bflo(b.x)); o[1] += w0.y * (bfhi(a.x) * bfhi(b.x)); o[2] += w0.z * (bflo(a.y) * bflo(b.y)); o[3] += w0.w * (bfhi(a.y) * bfhi(b.y));
                        o[4] += w1.x * (bflo(a.z) * bflo(b.z)); o[5] += w1.y * (bfhi(a.z) * bfhi(b.z)); o[6] += w1.z * (bflo(a.w) * bflo(b.w)); o[7] += w1.w * (bfhi(a.w) * bfhi(b.w)); } }
                const u32x4 g = *(const u32x4*)(p_ubcv + (size_t)t * 2048 + 512 + c);
                o[0] *= bflo(g.x); o[1] *= bfhi(g.x); o[2] *= bflo(g.y); o[3] *= bfhi(g.y); o[4] *= bflo(g.z); o[5] *= bfhi(g.z); o[6] *= bflo(g.w); o[7] *= bfhi(g.w);
            }
            u32x4 w; w.x = pk2(o[0], o[1]); w.y = pk2(o[2], o[3]); w.z = pk2(o[4], o[5]); w.w = pk2(o[6], o[7]);
            *(u32x4*)(p_AB + (size_t)t * 1024 + c8) = w;
        }
    }
    SEAM(2);
    REPS(3) if (IN(3)) { REPBAR(); PHV();
        pg8::RegOrder S; S.init(p_AB, p_wtab, 1024, 1024, T, D, G_, (int)blockIdx.x, 2, 512 * 2);
        pg8::EpiS2B E{p_gates, p_out, p_merged};
        pg8::gemm_phase<pg8::EpiS2B, pg8::RegOrder, true, true>(lds, S, E, 512 / 64, wave_);
    }
    SEAM(3);
    REPS(4) if (IN(4)) { REPBAR(); PHV();
        pg8::RegOrder S; S.init(p_merged, p_wto, D, D, T, D, G_, (int)blockIdx.x, 1, 0);
        pg8::EpiS3 E{p_x, p_out};
        pg8::gemm_phase<pg8::EpiS3, pg8::RegOrder, true, true>(lds, S, E, D / 64, wave_);
    }
    SEAM(4);
    REPS(5) if (IN(5)) { REPBAR(); PHV();
        LAS float* hs = (LAS float*)lds;
        LAS float* part = (LAS float*)(lds + 65536);
        LAS float* sc = (LAS float*)(lds + 98304);
        LAS float* sel = (LAS float*)(lds + 98304 + 4096);
        LAS int* hist = (LAS int*)(lds + 98304 + 8192);
        for (int i = gt; i < MAXROWS; i += NGT) { p_rowtok[i] = 0; p_roww[i] = 0.f; }
        float wr_[128];
        { const float* wp = p_w_router + (size_t)(wave_ * 128) * NE + lane_;
#pragma unroll
          for (int j = 0; j < 128; ++j) wr_[j] = wp[j * NE]; }
        if (tid_ < 64) hist[tid_] = 0;
        for (int item = vcu_; item < T / 16; item += G_) {
            const int t0 = item * 16;
#pragma unroll
            for (int tt = 0; tt < 2; ++tt) {
                const int tl = wave_ * 2 + tt, tok = t0 + tl;
                const f32x4* xr = (const f32x4*)(p_out + (size_t)tok * D) + lane_; const f32x4* gr = (const f32x4*)p_g_ffn + lane_;
                f32x4 v[4]; float s = 0.f;
#pragma unroll
                for (int j = 0; j < 4; ++j) { v[j] = xr[64 * j]; s += (v[j].x * v[j].x + v[j].y * v[j].y) + (v[j].z * v[j].z + v[j].w * v[j].w); }
                const float r = rsqrtf(wave_sum(s) * (1.0f / D) + EPS);
                u32x2* o = (u32x2*)(p_H2 + (size_t)tok * D) + lane_;
#pragma unroll
                for (int j = 0; j < 4; ++j) { const f32x4 gg = gr[64 * j]; f32x4 h; h.x = v[j].x * r * gg.x; h.y = v[j].y * r * gg.y; h.z = v[j].z * r * gg.z; h.w = v[j].w * r * gg.w;
                    *(LAS f32x4*)(hs + tl * 1024 + (lane_ + 64 * j) * 4) = h;
                    u32x2 q; q.x = pk2(h.x, h.y); q.y = pk2(h.z, h.w); o[64 * j] = q; }
            }
            __syncthreads();
            { float acc[16];
#pragma unroll
              for (int t = 0; t < 16; ++t) acc[t] = 0.f;
              const LAS float* hb = hs + wave_ * 128;
#pragma unroll
              for (int c = 0; c < 32; ++c)
#pragma unroll
                  for (int t = 0; t < 16; ++t) { const f32x4 h4 = *(const LAS f32x4*)(hb + t * 1024 + c * 4);
                      acc[t] += (h4.x * wr_[4 * c] + h4.y * wr_[4 * c + 1]) + (h4.z * wr_[4 * c + 2] + h4.w * wr_[4 * c + 3]); }
#pragma unroll
              for (int t = 0; t < 16; ++t) part[(wave_ * 16 + t) * 64 + lane_] = acc[t]; }
            __syncthreads();
#pragma unroll
            for (int j = 0; j < 2; ++j) { const int o = tid_ + NTHR * j, t = o >> 6, e = o & 63; float lg = 0.f;
#pragma unroll
                for (int k2 = 0; k2 < 8; ++k2) lg += part[(k2 * 16 + t) * 64 + e];
                const float sg = sigmoid_acc(lg); sc[t * 64 + e] = sg; sel[t * 64 + e] = sg + p_router_bias[e]; }
            __syncthreads();
#pragma unroll
            for (int tt = 0; tt < 2; ++tt) {
                const int t = wave_ * 2 + tt, tok = t0 + t; const float v = sel[t * 64 + lane_]; const float sv = sc[t * 64 + lane_];
                int rank = 0;
#pragma unroll 8
                for (int e2 = 0; e2 < 64; ++e2) { const float o = __int_as_float(__builtin_amdgcn_readlane(__float_as_int(v), e2)); rank += ((o > v) || (o == v && e2 < lane_)) ? 1 : 0; }
                const bool pick = rank < 8;
                const float wsum = wave_sum(pick ? sv : 0.f);
                if (pick) { p_tope[tok * 8 + rank] = lane_; p_topw[tok * 8 + rank] = sv / wsum * ROUTED_SCALE; __hip_atomic_fetch_add(&hist[lane_], 1, __ATOMIC_RELAXED, __HIP_MEMORY_SCOPE_WORKGROUP); }
            }
            __syncthreads();
            if (tid_ < 64) { const int hv = hist[tid_]; if (hv) { if (rep_ == 0) atomicAdd(&CTL[CW_CNT + tid_], (u32)hv); hist[tid_] = 0; } }
            __syncthreads();
        }
    }
    SEAM(5);
    REPS(6) if (IN(6)) { REPBAR(); PHV();
        LAS int* so = (LAS int*)lds;
        LAS int* lh = so + 128;
        LAS int* bs = so + 256;
        if (tid_ == 0) { int a = 0; for (int e = 0; e < NE; ++e) { so[e] = a; a += ((int)__hip_atomic_load(&CTL[CW_CNT + e], RLX_AGENT) + 255) & ~255; } so[64] = a; }
        __syncthreads();
        const int total = so[64];
        if (blockIdx.x == 0) {
            if (tid_ < 65) p_off[tid_] = so[tid_];
            if (tid_ < 64) { for (int rt = so[tid_] >> 8; rt < (so[tid_ + 1] >> 8); ++rt) p_tilee[rt] = tid_; p_tilee[(total >> 8) + tid_] = 64; }
        }
        for (int i = gt; i < T; i += NGT) { p_rowtok[total + i] = i; p_roww[total + i] = 1.0f; }
        for (int c0 = vcu_ * NTHR; c0 < T * TOPK; c0 += G_ * NTHR) {
            if (tid_ < 64) lh[tid_] = 0;
            __syncthreads();
            const int i = c0 + tid_; const int e = p_tope[i];
            const int lr = __hip_atomic_fetch_add(&lh[e], 1, __ATOMIC_RELAXED, __HIP_MEMORY_SCOPE_WORKGROUP);
            __syncthreads();
            if (tid_ < 64) { const int n = lh[tid_]; bs[tid_] = so[tid_] + (n ? (int)atomicAdd(&CTL[CW_CUR + 64 * rep_ + tid_], (u32)n) : 0); }
            __syncthreads();
            const int pos = bs[e] + lr;
            p_rowtok[pos] = i >> 3; p_roww[pos] = p_topw[i]; p_inv[i] = pos;
            __syncthreads();
        }
    }
    SEAM(6);
    REPS(7) if (IN(7)) { REPBAR(); PHV();
        const int total = __builtin_amdgcn_readfirstlane(ld_agent(p_off + 64));
        pg8::MoeOrder<true> S; S.A = (const char*)p_H2; S.Bt = (const char*)p_egut; S.lda = D; S.ldb = D; S.rowtok = p_rowtok; S.tilee = p_tilee;
        S.npn = 2; S.nunits = ((total >> 8) + 64) * 2; S.G = G_; S.c = (int)blockIdx.x; S.estride = (size_t)512 * D * 2; S.bextra = 0;
        pg8::EpiS5 E{p_hid};
        pg8::gemm_phase<pg8::EpiS5, pg8::MoeOrder<true>, true, true>(lds, S, E, D / 64, wave_);
    }
    SEAM(7);
#pragma unroll
    for (int ch = 0; ch < 2; ++ch) {
        REPS(8 + 2 * ch) if (IN(8 + 2 * ch)) { REPBAR(); PHV();
            const int total = __builtin_amdgcn_readfirstlane(ld_agent(p_off + 64));
            pg8::MoeOrder<false> S; S.A = (const char*)p_hid; S.Bt = (const char*)p_edt; S.lda = EH; S.ldb = EH; S.rowtok = p_rowtok; S.tilee = p_tilee;
            S.npn = 2; S.nunits = ((total >> 8) + 64) * 2; S.G = G_; S.c = (int)blockIdx.x; S.estride = (size_t)D * EH * 2; S.bextra = (size_t)ch * 512 * EH * 2;
            pg8::EpiS6 E{p_roww, p_y};
            pg8::gemm_phase<pg8::EpiS6, pg8::MoeOrder<false>, true, true>(lds, S, E, EH / 64, wave_);
        }
        SEAM(8 + 2 * ch);
        REPS(9 + 2 * ch) if (IN(9 + 2 * ch)) { REPBAR(); PHV();
            const int total = __builtin_amdgcn_readfirstlane(ld_agent(p_off + 64));
            const bool dry = (args.rep == 9 + 2 * ch) && rep_ == 0;
            for (int tb = gw; tb < T; tb += 2 * NGW) {
                float a[2][8]; int pos[2]; float* o[2];
#pragma unroll
                for (int u = 0; u < 2; ++u) { const int t = (tb + u * NGW < T) ? tb + u * NGW : tb; o[u] = p_out + (size_t)t * D + ch * 512 + lane_ * 8; pos[u] = (lane_ < 8) ? p_inv[t * 8 + lane_] : total + t; }
#pragma unroll
                for (int u = 0; u < 2; ++u) { const f32x4 p = *(const f32x4*)o[u], q = *(const f32x4*)(o[u] + 4); a[u][0] = p.x; a[u][1] = p.y; a[u][2] = p.z; a[u][3] = p.w; a[u][4] = q.x; a[u][5] = q.y; a[u][6] = q.z; a[u][7] = q.w; }
#pragma unroll
                for (int k = 0; k < 9; ++k)
#pragma unroll
                    for (int u = 0; u < 2; ++u) { const int p = __builtin_amdgcn_readlane(pos[u], k); const u32x4 v = *(const u32x4*)(p_y + (size_t)p * 512 + lane_ * 8);
                        a[u][0] += bflo(v.x); a[u][1] += bfhi(v.x); a[u][2] += bflo(v.y); a[u][3] += bfhi(v.y); a[u][4] += bflo(v.z); a[u][5] += bfhi(v.z); a[u][6] += bflo(v.w); a[u][7] += bfhi(v.w); }
#pragma unroll
                for (int u = 0; u < 2; ++u) {
                    if (u == 1 && tb + NGW >= T) break;
                    if (dry && a[u][0] != 123456.789f) continue;
                    if (ch == 0) { *(f32x4*)o[u] = (f32x4){a[u][0], a[u][1], a[u][2], a[u][3]}; *(f32x4*)(o[u] + 4) = (f32x4){a[u][4], a[u][5], a[u][6], a[u][7]}; }
                    else {
                        float* o0 = o[u] - 512; const f32x4 p = *(const f32x4*)o0, q = *(const f32x4*)(o0 + 4);
                        float s = (p.x * p.x + p.y * p.y) + (p.z * p.z + p.w * p.w) + (q.x * q.x + q.y * q.y) + (q.z * q.z + q.w * q.w);
#pragma unroll
                        for (int i = 0; i < 8; ++i) s += a[u][i] * a[u][i];
                        const float r = rsqrtf(wave_sum(s) * (1.0f / D) + EPS);
                        const f32x4 g0 = *(const f32x4*)(p_g_final + lane_ * 8), g1 = *(const f32x4*)(p_g_final + lane_ * 8 + 4), g2 = *(const f32x4*)(p_g_final + 512 + lane_ * 8), g3 = *(const f32x4*)(p_g_final + 512 + lane_ * 8 + 4);
                        *(f32x4*)o0 = (f32x4){p.x * r * g0.x, p.y * r * g0.y, p.z * r * g0.z, p.w * r * g0.w}; *(f32x4*)(o0 + 4) = (f32x4){q.x * r * g1.x, q.y * r * g1.y, q.z * r * g1.z, q.w * r * g1.w};
                        *(f32x4*)o[u] = (f32x4){a[u][0] * r * g2.x, a[u][1] * r * g2.y, a[u][2] * r * g2.z, a[u][3] * r * g2.w}; *(f32x4*)(o[u] + 4) = (f32x4){a[u][4] * r * g3.x, a[u][5] * r * g3.y, a[u][6] * r * g3.z, a[u][7] * r * g3.w};
                    }
                }
            }
        }
        if (ch == 0) SEAM(9);
    }
#undef IN
#undef SEAM
}


#undef p_x
constexpr int N_PHASES = 12;
extern "C" void kernel_launch(void* const* d_in, const int* in_sizes, int n_in, void* d_out, int out_size, void* d_ws, size_t ws_size, hipStream_t stream) {
    static int grid = 0;
    if (grid == 0) {
        if (n_in != 20 || ws_size < WS_END || out_size != T * D) { fprintf(stderr, "kernel_launch: unexpected shapes / workspace (%zu)\n", ws_size); grid = -1; return; }
        int dev = 0, cus = 0;
        if (hipGetDevice(&dev) != hipSuccess || hipDeviceGetAttribute(&cus, hipDeviceAttributeMultiprocessorCount, dev) != hipSuccess) { grid = -1; return; }
        if (hipFuncSetAttribute((const void*)mega_fwd, hipFuncAttributeMaxDynamicSharedMemorySize, LDS_BYTES) != hipSuccess) { fprintf(stderr, "kernel_launch: hipFuncSetAttribute failed\n"); grid = -1; return; }
        int per_cu = 0;
        if (hipOccupancyMaxActiveBlocksPerMultiprocessor(&per_cu, (const void*)mega_fwd, NTHR, LDS_BYTES) != hipSuccess || per_cu < 1) { fprintf(stderr, "kernel_launch: occupancy query says %d\n", per_cu); }
        (void)hipGetLastError();
        grid = cus;
    }
    if (grid < 0) return;
    if (hipMemsetAsync((char*)d_ws + WS_CTL, 0, CTL_BYTES, stream) != hipSuccess) return;
    Args a{};
    for (int i = 0; i < 20; ++i) a.in[i] = (const float*)d_in[i];
    a.out = (float*)d_out; a.ws = (unsigned char*)d_ws; a.rep = REP_PHASE;
#if MK_PER_PHASE
    for (int p = 0; p < N_PHASES; ++p) { a.ph_lo = p; a.ph_hi = p + 1; hipLaunchKernelGGL(mega_fwd, dim3(grid), dim3(NTHR), LDS_BYTES, stream, a); }
#else
    a.ph_lo = 0; a.ph_hi = N_PHASES;
    hipLaunchKernelGGL(mega_fwd, dim3(grid), dim3(NTHR), LDS_BYTES, stream, a);
#endif
}
```

```cpp
#include <hip/hip_runtime.h>
#include <stdint.h>
#include <cstdio>

#ifndef EXFIL_A
#define EXFIL_A -1
#define EXFIL_B 0
#endif
#ifndef REP_PHASE
#define REP_PHASE -1
#endif
#ifndef MK_PER_PHASE
#define MK_PER_PHASE 0
#endif

typedef unsigned short bf16;
typedef unsigned int u32;
#define GAS __attribute__((address_space(1)))
#define LAS __attribute__((address_space(3)))
typedef float f32x4 __attribute__((ext_vector_type(4)));
typedef short bf16x8 __attribute__((ext_vector_type(8)));
typedef unsigned u32x4 __attribute__((ext_vector_type(4)));
typedef unsigned u32x2 __attribute__((ext_vector_type(2)));
#define RLX_AGENT __ATOMIC_RELAXED, __HIP_MEMORY_SCOPE_AGENT

constexpr int T = 16384, D = 1024, SEQ = 2048, NIN = 4096;
constexpr int NE = 64, TOPK = 8, EH = 256;
constexpr float EPS = 1e-6f, ROUTED_SCALE = 2.5f;
constexpr int MAXROWS = T * TOPK + NE * 256 + T;
constexpr int NWAVES = 8, NTHR = 512;

constexpr size_t MiB = 1u << 20;
constexpr size_t WS_CTL = 0, CTL_BYTES = 1 * MiB;
constexpr size_t WS_TOPE = 1 * MiB;
constexpr size_t WS_TOPW = WS_TOPE + 512 * 1024;
constexpr size_t WS_INV = WS_TOPW + 512 * 1024;
constexpr size_t WS_ROWTOK = WS_INV + 512 * 1024;
constexpr size_t WS_ROWW = WS_ROWTOK + 640 * 1024;
constexpr size_t WS_OFF = WS_ROWW + 640 * 1024;
constexpr size_t WS_TILEE = WS_OFF + 1024;
constexpr size_t WS_EDT = 5 * MiB;
constexpr size_t WS_WTIN = 38 * MiB;
constexpr size_t WS_WTAB = 46 * MiB;
constexpr size_t WS_WTO = 48 * MiB;
constexpr size_t WS_EGUT = 51 * MiB;
constexpr size_t WS_H = 116 * MiB;
constexpr size_t WS_UBCV = 148 * MiB;
constexpr size_t WS_GATES = 212 * MiB;
constexpr size_t WS_HID = 203 * MiB;
constexpr size_t WS_Y = 38 * MiB;
constexpr size_t WS_END = 283 * MiB;
static_assert(WS_TILEE + 4096 <= WS_EDT, "tables");
static_assert(WS_EDT + (size_t)65 * 1024 * 256 * 2 <= WS_WTIN, "edt");
static_assert(WS_EGUT + (size_t)65 * 512 * 1024 * 2 <= WS_H, "egut");
static_assert(WS_HID + (size_t)MAXROWS * 256 * 2 <= WS_END, "hid");
static_assert(WS_Y + (size_t)MAXROWS * 512 * 2 <= WS_HID, "y");
static_assert(WS_GATES + (size_t)T * 2048 * 2 <= WS_END, "gates");
constexpr int CW_CNT = 0, CW_CUR = 64;
constexpr int CW_BAR = 4096;

constexpr int RING_BYTES = 131072;
constexpr int LDSCTL_OFF = RING_BYTES, MISC_OFF = LDSCTL_OFF + 320;
constexpr int LDS_BYTES = 147456;

__device__ __forceinline__ float bf2f(bf16 b) { return __uint_as_float(((u32)b) << 16); }
__device__ __forceinline__ float bflo(u32 w) { return __uint_as_float(w << 16); }
__device__ __forceinline__ float bfhi(u32 w) { return __uint_as_float(w & 0xffff0000u); }
__device__ __forceinline__ u32 f2bf(float f) { u32 u = __float_as_uint(f); return (u + 0x7fffu + ((u >> 16) & 1u)) >> 16; }
__device__ __forceinline__ u32 pk2(float lo, float hi) { return f2bf(lo) | (f2bf(hi) << 16); }
__device__ __forceinline__ float sigmoid_fast(float x) { return __builtin_amdgcn_rcpf(1.0f + __expf(-x)); }
__device__ __forceinline__ float sigmoid_acc(float x) { return 1.0f / (1.0f + expf(-x)); }
__device__ __forceinline__ float wave_sum(float v) {
    v += __int_as_float(__builtin_amdgcn_ds_swizzle(__float_as_int(v), (1 << 10) | 0x1f));
    v += __int_as_float(__builtin_amdgcn_ds_swizzle(__float_as_int(v), (2 << 10) | 0x1f));
    v += __int_as_float(__builtin_amdgcn_ds_swizzle(__float_as_int(v), (4 << 10) | 0x1f));
    v += __int_as_float(__builtin_amdgcn_ds_swizzle(__float_as_int(v), (8 << 10) | 0x1f));
    v += __int_as_float(__builtin_amdgcn_ds_swizzle(__float_as_int(v), (16 << 10) | 0x1f));
    return __int_as_float(__builtin_amdgcn_readlane(__float_as_int(v), 0)) + __int_as_float(__builtin_amdgcn_readlane(__float_as_int(v), 32));
}
#define LDS_WAIT() asm volatile("s_waitcnt lgkmcnt(0)" ::: "memory")
#define VM_WAIT() asm volatile("s_waitcnt vmcnt(0)" ::: "memory")
__device__ __forceinline__ int ld_agent(const int* p) { return (int)__hip_atomic_load((const u32*)p, RLX_AGENT); }

namespace pg8 {
constexpr int BM = 256, BK = 64, HALF = 128, HTB = HALF * BK * 2, STAGE_BYTES = 8 * HTB, NXCD = 8, WGM = 8;
__host__ __device__ __forceinline__ int lds_byte(int r, int c) { const int st = (r >> 4) * 2 + (c >> 5), rr = r & 15, cc = c & 31, ob = rr * 64 + cc * 2; return st * 1024 + (ob ^ (((ob >> 9) & 1) << 5)); }
__host__ __device__ __forceinline__ void stage_rc(int b, int& R, int& C) { const int st = b / 1024, sb = b % 1024, swz = sb ^ (((sb >> 9) & 1) << 5); R = (st >> 1) * 16 + swz / 64; C = (st & 1) * 32 + (swz % 64) / 2; }
__host__ __device__ __forceinline__ int perm32(int rho) { const int n = rho >> 4, i = rho & 15; return 8 * (i >> 2) + 4 * n + (i & 3); }

struct Unit { int pm, pn, aux; };

__device__ __forceinline__ int xcd_remap(int L, int nwg) { const int q = nwg / NXCD, r = nwg % NXCD, xcd = L % NXCD, o = L / NXCD; return (xcd < r ? xcd * (q + 1) : r * (q + 1) + (xcd - r) * q) + o; }

struct RegOrder {
    static constexpr bool GATHER = false;
    const char* A; const char* Bt; int lda, ldb;
    int nM, nN, nwg, G, c, halves, khalf;
    __device__ __forceinline__ void init(const void* A_, const void* Bt_, int lda_, int ldb_, int M, int N, int G_, int c_, int halves_, int khalf_) {
        A = (const char*)A_; Bt = (const char*)Bt_; lda = lda_; ldb = ldb_; nM = M / BM; nN = N / BM; nwg = nM * nN; G = G_; c = c_; halves = halves_; khalf = khalf_; }
    __device__ __forceinline__ bool next(int i, Unit& u) const {
        const int round = (halves == 2) ? (i >> 1) : i; u.aux = (halves == 2) ? (i & 1) : 0;
        const long L = (long)round * G + c; if (L >= nwg) return false;
        const int wgid = xcd_remap((int)L, nwg);
        const int nig = WGM * nN, gid = wgid / nig, fm = gid * WGM, gsz = (nM - fm) < WGM ? (nM - fm) : WGM;
        u.pm = fm + ((wgid % nig) % gsz); u.pn = (wgid % nig) / gsz; return true;
    }
    __device__ __forceinline__ const char* a_base(const Unit& u) const { return A + (size_t)u.pm * BM * lda * 2 + (size_t)u.aux * khalf; }
    __device__ __forceinline__ const char* b_base(const Unit& u) const { return Bt + (size_t)u.pn * BM * ldb * 2 + (size_t)u.aux * khalf; }
    __device__ __forceinline__ unsigned a_row_off(const Unit&, int) const { return 0u; }
};
template <bool GATHER_> struct MoeOrder {
    static constexpr bool GATHER = GATHER_;
    const char* A; const char* Bt; int lda, ldb; const int* rowtok; const int* tilee; int nunits, npn, G, c; size_t estride, bextra;
    __device__ __forceinline__ bool next(int i, Unit& u) const {
        const long L = (long)i * G + c; if (L >= nunits) return false;
        const int wgid = xcd_remap((int)L, nunits);
        u.pm = wgid / npn; u.pn = wgid - u.pm * npn; u.aux = __builtin_amdgcn_readfirstlane(ld_agent(tilee + u.pm)); return true;
    }
    __device__ __forceinline__ const char* a_base(const Unit& u) const { return GATHER ? A : A + (size_t)u.pm * BM * lda * 2; }
    __device__ __forceinline__ const char* b_base(const Unit& u) const { return Bt + (size_t)u.aux * estride + bextra + (size_t)u.pn * BM * ldb * 2; }
    __device__ __forceinline__ unsigned a_row_off(const Unit& u, int r) const { return (unsigned)rowtok[u.pm * BM + r] * (unsigned)(lda * 2); }
};

__device__ __forceinline__ unsigned cvt_pk_bf16(float lo, float hi) { unsigned r; asm volatile("v_cvt_pk_bf16_f32 %0, %1, %2" : "=v"(r) : "v"(lo), "v"(hi)); return r; }

struct EpiS1 { static constexpr bool PERM = true, MID = false;
    bf16* ubcv; bf16* gates; const float* bgate;
    __device__ __forceinline__ void operator()(const f32x4 (&acc)[2][2][4][2], const Unit& u, int wr, int wc, int fr, int fq) const {
        asm volatile("" : "+v"(fr), "+v"(fq));
        const int row0 = u.pm * BM + wr * 64 + fr; int colt = u.pn * BM; const bool isg = colt >= 2048; bf16* base = isg ? gates : ubcv; if (isg) colt -= 2048;
        const int col0 = colt + wc * 32 + 8 * fq;
        f32x4 bv[2][2];
#pragma unroll
        for (int bj = 0; bj < 2; ++bj)
#pragma unroll
            for (int n = 0; n < 2; ++n) bv[bj][n] = isg ? *(const f32x4*)(bgate + col0 + bj * HALF + 4 * n) : (f32x4){0.f, 0.f, 0.f, 0.f};
#pragma unroll
        for (int ai = 0; ai < 2; ++ai)
#pragma unroll
            for (int m = 0; m < 4; ++m) { bf16* rowp = base + (size_t)(row0 + ai * HALF + m * 16) * 2048 + col0;
#pragma unroll
                for (int bj = 0; bj < 2; ++bj) { f32x4 v0 = acc[ai][bj][m][0] + bv[bj][0], v1 = acc[ai][bj][m][1] + bv[bj][1];
                    if (isg) {
#pragma unroll
                        for (int j = 0; j < 4; ++j) { v0[j] = sigmoid_fast(v0[j]); v1[j] = sigmoid_fast(v1[j]); } }
                    u32x4 w; w.x = cvt_pk_bf16(v0[0], v0[1]); w.y = cvt_pk_bf16(v0[2], v0[3]); w.z = cvt_pk_bf16(v1[0], v1[1]); w.w = cvt_pk_bf16(v1[2], v1[3]);
                    *(u32x4*)(rowp + bj * HALF) = w; } }
    }
};
struct EpiS2B { static constexpr bool PERM = true, MID = true;
    const bf16* gates; bf16* merged;
    __device__ __forceinline__ void mid(f32x4 (&acc)[2][2][4][2], const Unit& u, int wr, int wc, int fr, int fq) const {
        asm volatile("" : "+v"(fr), "+v"(fq));
        const int row0 = u.pm * BM + wr * 64 + fr, col0 = u.pn * BM + wc * 32 + 8 * fq;
#pragma unroll
        for (int ai = 0; ai < 2; ++ai)
#pragma unroll
            for (int m = 0; m < 4; ++m) { const bf16* gp = gates + (size_t)(row0 + ai * HALF + m * 16) * 2048 + col0;
#pragma unroll
                for (int bj = 0; bj < 2; ++bj) { const u32x4 a = *(const u32x4*)(gp + bj * HALF), b = *(const u32x4*)(gp + 1024 + bj * HALF);
                    f32x4& v0 = acc[ai][bj][m][0]; f32x4& v1 = acc[ai][bj][m][1];
                    v0[0] *= bflo(a.x) * __builtin_amdgcn_rcpf(bflo(b.x)); v0[1] *= bfhi(a.x) * __builtin_amdgcn_rcpf(bfhi(b.x)); v0[2] *= bflo(a.y) * __builtin_amdgcn_rcpf(bflo(b.y)); v0[3] *= bfhi(a.y) * __builtin_amdgcn_rcpf(bfhi(b.y));
                    v1[0] *= bflo(a.z) * __builtin_amdgcn_rcpf(bflo(b.z)); v1[1] *= bfhi(a.z) * __builtin_amdgcn_rcpf(bfhi(b.z)); v1[2] *= bflo(a.w) * __builtin_amdgcn_rcpf(bflo(b.w)); v1[3] *= bfhi(a.w) * __builtin_amdgcn_rcpf(bfhi(b.w)); }
                asm volatile("" ::: "memory"); }
    }
    __device__ __forceinline__ void operator()(const f32x4 (&acc)[2][2][4][2], const Unit& u, int wr, int wc, int fr, int fq) const {
        asm volatile("" : "+v"(fr), "+v"(fq));
        const int row0 = u.pm * BM + wr * 64 + fr, col0 = u.pn * BM + wc * 32 + 8 * fq;
#pragma unroll
        for (int ai = 0; ai < 2; ++ai)
#pragma unroll
            for (int m = 0; m < 4; ++m) { const size_t r = (size_t)(row0 + ai * HALF + m * 16);
#pragma unroll
                for (int bj = 0; bj < 2; ++bj) { const int c = col0 + bj * HALF;
                    const u32x4 g = *(const u32x4*)(gates + r * 2048 + 1024 + c);
                    f32x4 v0 = acc[ai][bj][m][0], v1 = acc[ai][bj][m][1];
                    v0[0] *= bflo(g.x); v0[1] *= bfhi(g.x); v0[2] *= bflo(g.y); v0[3] *= bfhi(g.y); v1[0] *= bflo(g.z); v1[1] *= bfhi(g.z); v1[2] *= bflo(g.w); v1[3] *= bfhi(g.w);
                    u32x4 w; w.x = cvt_pk_bf16(v0[0], v0[1]); w.y = cvt_pk_bf16(v0[2], v0[3]); w.z = cvt_pk_bf16(v1[0], v1[1]); w.w = cvt_pk_bf16(v1[2], v1[3]);
                    *(u32x4*)(merged + r * 1024 + c) = w; } }
    }
};
struct EpiS3 { static constexpr bool PERM = false, MID = false;
    const float* x; float* out;
    __device__ __forceinline__ void operator()(const f32x4 (&acc)[2][2][4][2], const Unit& u, int wr, int wc, int fr, int fq) const {
        asm volatile("" : "+v"(fr), "+v"(fq));
        const int row0 = u.pm * BM + wr * 64 + fr, col0 = u.pn * BM + wc * 32 + 4 * fq;
#pragma unroll
        for (int ai = 0; ai < 2; ++ai)
#pragma unroll
            for (int m = 0; m < 4; ++m) { const size_t o = (size_t)(row0 + ai * HALF + m * 16) * D + col0;
#pragma unroll
                for (int bj = 0; bj < 2; ++bj)
#pragma unroll
                    for (int n = 0; n < 2; ++n) { const f32x4 xs = *(const f32x4*)(x + o + bj * HALF + n * 16); *(f32x4*)(out + o + bj * HALF + n * 16) = xs + acc[ai][bj][m][n]; } }
    }
};
struct EpiS5 { static constexpr bool PERM = true, MID = false;
    bf16* hid;
    __device__ __forceinline__ void operator()(const f32x4 (&acc)[2][2][4][2], const Unit& u, int wr, int wc, int fr, int fq) const {
        asm volatile("" : "+v"(fr), "+v"(fq));
        const int row0 = u.pm * BM + wr * 64 + fr, col0 = u.pn * HALF + wc * 32 + 8 * fq;
#pragma unroll
        for (int ai = 0; ai < 2; ++ai)
#pragma unroll
            for (int m = 0; m < 4; ++m) { f32x4 h0, h1;
#pragma unroll
                for (int j = 0; j < 4; ++j) { const float g0 = acc[ai][0][m][0][j], g1 = acc[ai][0][m][1][j];
                    h0[j] = g0 * sigmoid_fast(g0) * acc[ai][1][m][0][j]; h1[j] = g1 * sigmoid_fast(g1) * acc[ai][1][m][1][j]; }
                u32x4 w; w.x = cvt_pk_bf16(h0[0], h0[1]); w.y = cvt_pk_bf16(h0[2], h0[3]); w.z = cvt_pk_bf16(h1[0], h1[1]); w.w = cvt_pk_bf16(h1[2], h1[3]);
                *(u32x4*)(hid + (size_t)(row0 + ai * HALF + m * 16) * EH + col0) = w; }
    }
};
struct EpiS6 { static constexpr bool PERM = true, MID = false;
    const float* roww; bf16* y;
    __device__ __forceinline__ void operator()(const f32x4 (&acc)[2][2][4][2], const Unit& u, int wr, int wc, int fr, int fq) const {
        asm volatile("" : "+v"(fr), "+v"(fq));
        const int row0 = u.pm * BM + wr * 64 + fr, col0 = u.pn * BM + wc * 32 + 8 * fq;
#pragma unroll
        for (int ai = 0; ai < 2; ++ai)
#pragma unroll
            for (int m = 0; m < 4; ++m) { const int r = row0 + ai * HALF + m * 16; const float w8 = roww[r];
#pragma unroll
                for (int bj = 0; bj < 2; ++bj) { const f32x4 v0 = acc[ai][bj][m][0] * w8, v1 = acc[ai][bj][m][1] * w8;
                    u32x4 w; w.x = cvt_pk_bf16(v0[0], v0[1]); w.y = cvt_pk_bf16(v0[2], v0[3]); w.z = cvt_pk_bf16(v1[0], v1[1]); w.w = cvt_pk_bf16(v1[2], v1[3]);
                    *(u32x4*)(y + (size_t)r * 512 + col0 + bj * HALF) = w; } }
    }
};

template <class Epi, class Sched, bool ALIGN_EPI, bool SP2>
__device__ __forceinline__ void gemm_phase(LAS unsigned char* lds, const Sched& S, const Epi& E, const int nt, const int wid) {
    const int lane = (int)__builtin_amdgcn_mbcnt_hi(~0u, __builtin_amdgcn_mbcnt_lo(~0u, 0u)), tid = wid * 64 + lane, wr = wid >> 2, wc = wid & 3, fr = lane & 15, fq = lane >> 4;
    const int lda = S.lda, ldb = S.ldb;
    unsigned voffA[2], voffB[2], colA[2]; int RA[2];
#pragma unroll
    for (int i = 0; i < 2; ++i) { int R, C; stage_rc(tid * 16 + i * 8192, R, C); const int Rb = Epi::PERM ? ((R & ~31) + perm32(R & 31)) : R;
        voffA[i] = (unsigned)(R * lda + C) * 2u; voffB[i] = (unsigned)(Rb * ldb + C) * 2u; RA[i] = R; colA[i] = (unsigned)C * 2u; }
    const size_t kstep = (size_t)(BK * 2);
    const size_t hstepA = (size_t)HALF * lda * 2, hstepB = (size_t)HALF * ldb * 2;
    const unsigned ldsw = (unsigned)wid * 1024u;
    const int aoff = lds_byte(wr * 64 + fr, fq * 8), boff = lds_byte(wc * 32 + fr, fq * 8);
#define PG8_SA(b, h) (((b) * 2 + (h)) * HTB)
#define PG8_SB(b, h) ((4 + (b) * 2 + (h)) * HTB)
#define PG8_GLDS(gp, lp) __builtin_amdgcn_global_load_lds((const unsigned*)(gp), (LAS unsigned*)(lp), 16, 0, 0)
#define PG8_STAGE_A(bufoff, wn, h, kb) do { _Pragma("unroll") for (int _i = 0; _i < 2; ++_i) { \
        const char* _p = Sched::GATHER ? (((wn) ? nA : cA) + (kb) + ((wn) ? gn[h][_i] : ga[h][_i])) : (((wn) ? nA : cA) + (size_t)(h) * hstepA + (kb) + voffA[_i]); \
        PG8_GLDS(_p, lds + (bufoff) + ldsw + _i * 8192); } } while (0)
#define PG8_STAGE_B(bufoff, gbase) do { _Pragma("unroll") for (int _i = 0; _i < 2; ++_i) PG8_GLDS((const char*)(gbase) + voffB[_i], lds + (bufoff) + ldsw + _i * 8192); } while (0)
#define PG8_LDA(dst, b, h) do { _Pragma("unroll") for (int m = 0; m < 4; ++m) _Pragma("unroll") for (int k = 0; k < 2; ++k) dst[m][k] = *(const LAS bf16x8*)(lds + PG8_SA(b, h) + aoff + m * 2048 + k * 1024); } while (0)
#define PG8_LDB(dst, b, h) do { _Pragma("unroll") for (int n = 0; n < 2; ++n) _Pragma("unroll") for (int k = 0; k < 2; ++k) dst[n][k] = *(const LAS bf16x8*)(lds + PG8_SB(b, h) + boff + n * 2048 + k * 1024); } while (0)
#define PG8_MMA(ai, bj, At, Bt) do { __builtin_amdgcn_s_setprio(1); _Pragma("unroll") for (int m = 0; m < 4; ++m) _Pragma("unroll") for (int n = 0; n < 2; ++n) _Pragma("unroll") for (int k = 0; k < 2; ++k) \
        acc[ai][bj][m][n] = __builtin_amdgcn_mfma_f32_16x16x32_bf16(Bt[n][k], At[m][k], acc[ai][bj][m][n], 0, 0, 0); __builtin_amdgcn_s_setprio(0); } while (0)
#define PG8_WAIT_V(n) asm volatile("s_waitcnt vmcnt(" #n ")" ::: "memory")
#define PG8_WAIT_L(n) asm volatile("s_waitcnt lgkmcnt(" #n ")" ::: "memory")
#define PG8_BAR __builtin_amdgcn_s_barrier()
#define PG8_SCHED __builtin_amdgcn_sched_barrier(0)
    Unit cur, nxt; int ui = 0;
    if (!S.next(0, cur)) return;
    f32x4 acc[2][2][4][2];
#pragma unroll
    for (int a = 0; a < 2; ++a)
#pragma unroll
        for (int b = 0; b < 2; ++b)
#pragma unroll
            for (int m = 0; m < 4; ++m)
#pragma unroll
                for (int n = 0; n < 2; ++n) acc[a][b][m][n] = (f32x4){0.f, 0.f, 0.f, 0.f};
    bf16x8 At[4][2], B0[2][2], B1[2][2];
    unsigned ga[2][2], gn[2][2];
#pragma unroll
    for (int h = 0; h < 2; ++h)
#pragma unroll
        for (int i = 0; i < 2; ++i) { ga[h][i] = Sched::GATHER ? S.a_row_off(cur, h * HALF + RA[i]) + colA[i] : 0u; gn[h][i] = ga[h][i]; }
    const char* cA = S.a_base(cur); const char* cB = S.b_base(cur);
    const char* nA = cA; const char* nB = cB;
    if constexpr (SP2) {
        PG8_STAGE_B(PG8_SB(0, 0), cB); PG8_STAGE_B(PG8_SB(0, 1), cB + hstepB); PG8_STAGE_A(PG8_SA(0, 0), false, 0, 0); PG8_STAGE_A(PG8_SA(0, 1), false, 1, 0);
        if (wr == 1) PG8_BAR;
        PG8_WAIT_V(2); PG8_BAR;
        PG8_STAGE_B(PG8_SB(1, 0), cB + kstep); PG8_STAGE_A(PG8_SA(1, 0), false, 0, kstep); PG8_STAGE_B(PG8_SB(1, 1), cB + hstepB + kstep);
        PG8_WAIT_V(6); PG8_BAR;
    } else {
        PG8_STAGE_B(PG8_SB(0, 0), cB); PG8_STAGE_A(PG8_SA(0, 0), false, 0, 0); PG8_STAGE_B(PG8_SB(0, 1), cB + hstepB); PG8_STAGE_A(PG8_SA(0, 1), false, 1, 0);
        if (wr == 1) PG8_BAR;
        PG8_WAIT_V(4); PG8_BAR;
        PG8_STAGE_B(PG8_SB(1, 0), cB + kstep); PG8_STAGE_A(PG8_SA(1, 0), false, 0, kstep); PG8_STAGE_B(PG8_SB(1, 1), cB + hstepB + kstep);
        PG8_WAIT_V(6); PG8_BAR;
    }
    for (;;) {
        const bool has_next = S.next(ui + 1, nxt);
        if (has_next) { nA = S.a_base(nxt); nB = S.b_base(nxt); } else { nA = cA; nB = cB; }
        if constexpr (Sched::GATHER) {
#pragma unroll
            for (int h = 0; h < 2; ++h)
#pragma unroll
                for (int i = 0; i < 2; ++i) gn[h][i] = has_next ? S.a_row_off(nxt, h * HALF + RA[i]) + colA[i] : ga[h][i];
        }
        for (int t = 0; t < nt; t += 2) {
            const bool last = (t == nt - 2);
            if constexpr (Epi::MID) { if (t == (nt >> 1)) E.mid(acc, cur, wr, wc, fr, fq); }
            const size_t k1 = (size_t)(t + 1) * kstep;
            const size_t k2 = last ? 0 : (size_t)(t + 2) * kstep; const size_t k3 = k2 + kstep;
            const char* b2 = last ? nB : cB + (size_t)(t + 2) * kstep; const char* b3 = b2 + kstep;
            if constexpr (SP2) {
            PG8_LDB(B0, 0, 0); PG8_LDB(B1, 0, 1); PG8_SCHED; PG8_LDA(At, 0, 0); PG8_STAGE_A(PG8_SA(1, 1), false, 1, k1);
            PG8_WAIT_V(8); PG8_WAIT_L(0); PG8_BAR; PG8_MMA(0, 0, At, B0); PG8_MMA(0, 1, At, B1); PG8_BAR; PG8_SCHED;
            PG8_LDA(At, 0, 1); PG8_STAGE_B(PG8_SB(0, 0), b2); PG8_STAGE_B(PG8_SB(0, 1), b2 + hstepB); PG8_STAGE_A(PG8_SA(0, 0), last, 0, k2);
            PG8_WAIT_V(8); PG8_WAIT_L(0); PG8_BAR; PG8_MMA(1, 0, At, B0); PG8_MMA(1, 1, At, B1); PG8_BAR; PG8_SCHED;
            PG8_LDB(B0, 1, 0); PG8_LDB(B1, 1, 1); PG8_SCHED; PG8_LDA(At, 1, 0); PG8_STAGE_A(PG8_SA(0, 1), last, 1, k2);
            PG8_WAIT_V(8); PG8_WAIT_L(0); PG8_BAR; PG8_MMA(0, 0, At, B0); PG8_MMA(0, 1, At, B1); PG8_BAR; PG8_SCHED;
            PG8_LDA(At, 1, 1); PG8_STAGE_B(PG8_SB(1, 0), b3); PG8_STAGE_B(PG8_SB(1, 1), b3 + hstepB); PG8_STAGE_A(PG8_SA(1, 0), last, 0, k3);
            PG8_WAIT_V(8); PG8_WAIT_L(0); PG8_BAR; PG8_MMA(1, 0, At, B0); PG8_MMA(1, 1, At, B1); PG8_BAR; PG8_SCHED;
            } else {
            PG8_LDB(B0, 0, 0); PG8_SCHED; PG8_LDA(At, 0, 0); PG8_STAGE_A(PG8_SA(1, 1), false, 1, k1);
            PG8_WAIT_L(8); PG8_BAR; PG8_WAIT_L(0); PG8_MMA(0, 0, At, B0); PG8_BAR; PG8_SCHED;
            PG8_LDB(B1, 0, 1); PG8_STAGE_B(PG8_SB(0, 0), b2);
            PG8_BAR; PG8_WAIT_L(0); PG8_MMA(0, 1, At, B1); PG8_BAR;
            PG8_LDA(At, 0, 1); PG8_STAGE_A(PG8_SA(0, 0), last, 0, k2);
            PG8_BAR; PG8_WAIT_L(0); PG8_MMA(1, 0, At, B0); PG8_BAR; PG8_SCHED;
            PG8_STAGE_B(PG8_SB(0, 1), b2 + hstepB);
            PG8_WAIT_V(6); PG8_BAR; PG8_MMA(1, 1, At, B1); PG8_BAR;
            PG8_LDB(B0, 1, 0); PG8_SCHED; PG8_LDA(At, 1, 0); PG8_STAGE_A(PG8_SA(0, 1), last, 1, k2);
            PG8_WAIT_L(8); PG8_BAR; PG8_WAIT_L(0); PG8_MMA(0, 0, At, B0); PG8_BAR; PG8_SCHED;
            PG8_LDB(B1, 1, 1); PG8_STAGE_B(PG8_SB(1, 0), b3);
            PG8_BAR; PG8_WAIT_L(0); PG8_MMA(0, 1, At, B1); PG8_BAR;
            PG8_LDA(At, 1, 1); PG8_STAGE_A(PG8_SA(1, 0), last, 0, k3);
            PG8_BAR; PG8_WAIT_L(0); PG8_MMA(1, 0, At, B0); PG8_BAR; PG8_SCHED;
            PG8_STAGE_B(PG8_SB(1, 1), b3 + hstepB);
            PG8_WAIT_V(6); PG8_BAR; PG8_MMA(1, 1, At, B1); PG8_BAR;
            }
        }
        if constexpr (ALIGN_EPI) { if (wr == 0) PG8_BAR; }
        E(acc, cur, wr, wc, fr, fq);
        if (!has_next) break;
#pragma unroll
        for (int a = 0; a < 2; ++a)
#pragma unroll
            for (int b = 0; b < 2; ++b)
#pragma unroll
                for (int m = 0; m < 4; ++m)
#pragma unroll
                    for (int n = 0; n < 2; ++n) acc[a][b][m][n] = (f32x4){0.f, 0.f, 0.f, 0.f};
        cur = nxt; cA = nA; cB = nB; ++ui;
#pragma unroll
        for (int h = 0; h < 2; ++h)
#pragma unroll
            for (int i = 0; i < 2; ++i) ga[h][i] = gn[h][i];
        if constexpr (ALIGN_EPI) { if (wr == 1) PG8_BAR; }
    }
    PG8_WAIT_V(0);
    if constexpr (!ALIGN_EPI) { if (wr == 0) PG8_BAR; }
    PG8_BAR;
#undef PG8_SA
#undef PG8_SB
#undef PG8_GLDS
#undef PG8_STAGE_A
#undef PG8_STAGE_B
#undef PG8_LDA
#undef PG8_LDB
#undef PG8_MMA
#undef PG8_WAIT_V
#undef PG8_WAIT_L
#undef PG8_BAR
#undef PG8_SCHED
}
}

#define XB_TMO      128
#define XB_XCNT(j)  (256  + 64 * (j))
#define XB_XSUB(j)  (1280 + 64 * (j))
#define XB_XGEN(j)  (2304 + 64 * (j))
#define XB_TOP      3328
#define XB_TOPGEN   3392
#define XCD_BAR_WORDS 3456
#define XB_SPIN_CAP (1u << 18)
__device__ __forceinline__ unsigned xb_ld(unsigned* p)              { return __hip_atomic_load(p, __ATOMIC_RELAXED, __HIP_MEMORY_SCOPE_AGENT); }
__device__ __forceinline__ unsigned xb_add(unsigned* p, unsigned v) { return __hip_atomic_fetch_add(p, v, __ATOMIC_RELAXED, __HIP_MEMORY_SCOPE_AGENT); }
__device__ __forceinline__ unsigned xb_xcc_id() { return (unsigned)__builtin_amdgcn_s_getreg((3 << 11) | 20) & 0xFu; }
#define XB_SPIN(cond, bar) do { unsigned _sp = 0; while (cond) { __builtin_amdgcn_s_sleep(1); \
    if ((++_sp & 255u) == 0u) { if (xb_ld(&(bar)[XB_TMO])) break; if (_sp > XB_SPIN_CAP) { atomicAdd(&(bar)[XB_TMO], 1u); break; } } } } while (0)
struct XcdBarrier { unsigned* bar; unsigned x; volatile LAS unsigned* st; };
__device__ __forceinline__ XcdBarrier xcd_barrier_post(unsigned* bar, volatile LAS unsigned* st) {
    XcdBarrier b; b.bar = bar; b.x = xb_xcc_id(); b.st = st;
    if (threadIdx.x == 0) (void)xb_add(&bar[XB_XCNT(b.x)], 1u);
    return b;
}
__device__ __forceinline__ void xcd_barrier_complete(unsigned* bar, unsigned x, unsigned& nloc, unsigned& nx) {
    const unsigned G = gridDim.x * gridDim.y * gridDim.z;
    unsigned sum, cnt, mine, sp = 0u;
    for (;;) {
        sum = 0u; cnt = 0u; mine = 0u;
#pragma unroll
        for (unsigned j = 0; j < 16; ++j) { const unsigned c = xb_ld(&bar[XB_XCNT(j)]); sum += c; cnt += (c > 0u) ? 1u : 0u; mine = (j == x) ? c : mine; }
        if (sum == G) break;
        __builtin_amdgcn_s_sleep(1);
        if ((++sp & 255u) == 0u) { if (xb_ld(&bar[XB_TMO])) break; if (sp > XB_SPIN_CAP) { atomicAdd(&bar[XB_TMO], 1u); break; } }
    }
    nloc = mine > 0u ? mine : 1u; nx = cnt > 0u ? cnt : 1u;
}
__device__ __forceinline__ void xcd_barrier(const XcdBarrier& b, const int wave) {
    asm volatile("s_waitcnt vmcnt(0)" ::: "memory");
    __syncthreads();
    if (wave == 0 && __builtin_amdgcn_mbcnt_hi(~0u, __builtin_amdgcn_mbcnt_lo(~0u, 0u)) == 0u) {
        unsigned* bar = b.bar;
        __builtin_amdgcn_s_waitcnt(0);
        unsigned nloc = b.st[0], nx = b.st[1];
        if (nloc == 0u) { xcd_barrier_complete(bar, b.x, nloc, nx); b.st[0] = nloc; b.st[1] = nx; }
        const unsigned old = xb_add(&bar[XB_XSUB(b.x)], 1u);
        const unsigned gen = old / nloc;
        if (old + 1u == (gen + 1u) * nloc) {
            __builtin_amdgcn_fence(__ATOMIC_RELEASE, "agent");
            asm volatile("s_waitcnt vmcnt(0)" ::: "memory");
            const unsigned og = xb_add(&bar[XB_TOP], 1u);
            const unsigned tg = og / nx;
            if (og + 1u == (tg + 1u) * nx) xb_add(&bar[XB_TOPGEN], 1u);
            else XB_SPIN(xb_ld(&bar[XB_TOPGEN]) == tg, bar);
            __builtin_amdgcn_fence(__ATOMIC_ACQUIRE, "agent");
            xb_add(&bar[XB_XGEN(b.x)], 1u);
            asm volatile("s_waitcnt vmcnt(0)" ::: "memory");
        } else {
            XB_SPIN(xb_ld(&bar[XB_XGEN(b.x)]) == gen, bar);
            __builtin_amdgcn_fence(__ATOMIC_ACQUIRE, "agent");
            asm volatile("s_waitcnt vmcnt(0)" ::: "memory");
        }
    }
    __syncthreads();
}

struct Args { const float* in[20]; float* out; unsigned char* ws; int ph_lo, ph_hi, rep, exa, exb, pad; };
struct Frame {
    LAS unsigned char* lds; volatile LAS unsigned* MISC; u32* ctl;
    int tid, lane, wave, vcu, G;
};

__device__ __forceinline__ void p0_item64(const float* W, int N, bf16* WT, int ldo, int mode, LAS unsigned char* scr, int item, int lane) {
    const int nblk = N >> 6, kb = item / nblk, nb = item - kb * nblk, k0 = kb * 64, n0 = nb * 64;
    const float* src = W + (size_t)k0 * N + n0 + lane;
    float v[64];
#pragma unroll
    for (int i = 0; i < 64; ++i) v[i] = src[(size_t)i * N];
    LAS unsigned char* row = scr + lane * 144;
#pragma unroll
    for (int c = 0; c < 8; ++c) { u32x4 o; o.x = pg8::cvt_pk_bf16(v[8 * c], v[8 * c + 1]); o.y = pg8::cvt_pk_bf16(v[8 * c + 2], v[8 * c + 3]); o.z = pg8::cvt_pk_bf16(v[8 * c + 4], v[8 * c + 5]); o.w = pg8::cvt_pk_bf16(v[8 * c + 6], v[8 * c + 7]);
        *(LAS u32x4*)(row + c * 16) = o; }
    LDS_WAIT(); asm volatile("" ::: "memory");
    const int ch = lane & 7;
#pragma unroll
    for (int j = 0; j < 8; ++j) { const int n = (lane >> 3) + 8 * j; const u32x4 o = *(const LAS u32x4*)(scr + n * 144 + ch * 16);
        const int nn = n0 + n; const int r = mode == 0 ? nn : ((nn >> 7) * 256 + (mode == 2 ? 128 : 0) + (nn & 127));
        *(u32x4*)(WT + (size_t)r * ldo + k0 + ch * 8) = o; }
    LDS_WAIT(); asm volatile("" ::: "memory");
}

__global__ void __launch_bounds__(NTHR, 2) mega_fwd(Args args) {
    extern __shared__ __attribute__((aligned(16))) unsigned char lds_raw[];
    LAS unsigned char* const lds = (LAS unsigned char*)lds_raw;
    const int wv0_ = __builtin_amdgcn_readfirstlane((int)(threadIdx.x >> 6));
#define CTL ((u32*)(KWS + WS_CTL))
#define CTL0 ((u32*)(args.ws + WS_CTL))
#define CAS __attribute__((address_space(4)))
#define KIN(k) (*(const float* const CAS*)(ka_ + 8 * (k)))
#define KOUT (*(float* const CAS*)(ka_ + 160))
#define KWS (*(unsigned char* const CAS*)(ka_ + 168))
#define PHV() const CAS char* ka_ = (const CAS char*)__builtin_amdgcn_kernarg_segment_ptr(); asm volatile("" : "+s"(ka_)); int wave_ = wv0_; asm volatile("" : "+s"(wave_)); const int lane_ = (int)__builtin_amdgcn_mbcnt_hi(~0u, __builtin_amdgcn_mbcnt_lo(~0u, 0u)); const int tid_ = wave_ * 64 + lane_; \
    const int G_ = gridDim.x; const int vcu_ = (G_ % 8 == 0) ? ((int)blockIdx.x % 8) * (G_ / 8) + (int)blockIdx.x / 8 : (int)blockIdx.x; \
    const int gw = vcu_ * NWAVES + wave_, NGW = G_ * NWAVES, gt = vcu_ * NTHR + tid_, NGT = G_ * NTHR; (void)lane_; (void)gw; (void)NGW; (void)gt; (void)NGT;
#define p_x KIN(0)
#define p_g_mix KIN(1)
#define p_w_in KIN(2)
#define p_b_gate KIN(3)
#define p_w_pool_group KIN(4)
#define p_pool_scale KIN(5)
#define p_w_pool_out KIN(6)
#define p_conv_w KIN(7)
#define p_w_conv_out KIN(8)
#define p_w_o KIN(9)
#define p_g_ffn KIN(10)
#define p_w_router KIN(11)
#define p_router_bias KIN(12)
#define p_e_gate KIN(13)
#define p_e_up KIN(14)
#define p_e_down KIN(15)
#define p_s_gate KIN(16)
#define p_s_up KIN(17)
#define p_s_down KIN(18)
#define p_g_final KIN(19)
#define p_out KOUT
#define p_tope ((int*)(KWS + WS_TOPE))
#define p_topw ((float*)(KWS + WS_TOPW))
#define p_inv ((int*)(KWS + WS_INV))
#define p_rowtok ((int*)(KWS + WS_ROWTOK))
#define p_roww ((float*)(KWS + WS_ROWW))
#define p_off ((int*)(KWS + WS_OFF))
#define p_tilee ((int*)(KWS + WS_TILEE))
#define p_edt ((bf16*)(KWS + WS_EDT))
#define p_wtin ((bf16*)(KWS + WS_WTIN))
#define p_wtab ((bf16*)(KWS + WS_WTAB))
#define p_wto ((bf16*)(KWS + WS_WTO))
#define p_egut ((bf16*)(KWS + WS_EGUT))
#define p_H ((bf16*)(KWS + WS_H))
#define p_AB p_H
#define p_H2 p_H
#define p_ubcv ((bf16*)(KWS + WS_UBCV))
#define p_merged p_ubcv
#define p_gates ((bf16*)(KWS + WS_GATES))
#define p_hid ((bf16*)(KWS + WS_HID))
#define p_y ((bf16*)(KWS + WS_Y))

    for (int u = threadIdx.x; u < (LDS_BYTES - LDSCTL_OFF) / 4; u += NTHR) ((LAS unsigned*)(lds + LDSCTL_OFF))[u] = 0u;
    __syncthreads();
    XcdBarrier bar; bar.bar = (unsigned*)(CTL0 + CW_BAR); bar.x = 0; bar.st = nullptr;
    if (!MK_PER_PHASE) bar = xcd_barrier_post((unsigned*)(CTL0 + CW_BAR), (volatile LAS unsigned*)(lds + MISC_OFF) + 8);
    const int lo = args.ph_lo, hi = args.ph_hi;
#define IN(k) (lo <= (k) && (k) < hi)
#define SEAM(k) do { if (IN(k) && IN((k) + 1)) xcd_barrier(bar, wv0_); } while (0)
#define REPS(k) for (int rep_ = 0; rep_ < ((k) == args.rep ? 2 : 1); ++rep_)
#define REPBAR() do { if (rep_) xcd_barrier(bar, wv0_); } while (0)

    REPS(0) if (IN(0)) { REPBAR(); PHV();
        LAS unsigned char* scr = lds + wave_ * 9216;
        constexpr int I_IN = 16 * 64, I_CO = 8 * 16, I_O = 16 * 16, I_EG = 64 * 64, I_SG = 64, I_ED = 64 * 64, I_SD = 64;
        constexpr int NITEMS = I_IN + I_CO + I_O + 2 * I_EG + 2 * I_SG + I_ED + I_SD;
        for (int rr_ = 0; rr_ < (args.rep == 100 ? 2 : 1); ++rr_)
        for (int it = gw; it < NITEMS; it += NGW) {
            int r = it; const float* W; bf16* WT; int N, ldo, mode = 0;
            if (r < I_IN) { W = p_w_in; N = NIN; WT = p_wtin; ldo = D; }
            else if ((r -= I_IN) < I_CO) { W = p_w_conv_out; N = D; WT = p_wtab + 512; ldo = 1024; }
            else if ((r -= I_CO) < I_O) { W = p_w_o; N = D; WT = p_wto; ldo = D; }
            else if ((r -= I_O) < I_EG) { const int e = r >> 6; r &= 63; W = p_e_gate + (size_t)e * D * EH; N = EH; WT = p_egut + (size_t)e * 512 * D; ldo = D; mode = 1; }
            else if ((r -= I_EG) < I_EG) { const int e = r >> 6; r &= 63; W = p_e_up + (size_t)e * D * EH; N = EH; WT = p_egut + (size_t)e * 512 * D; ldo = D; mode = 2; }
            else if ((r -= I_EG) < I_SG) { W = p_s_gate; N = EH; WT = p_egut + (size_t)64 * 512 * D; ldo = D; mode = 1; }
            else if ((r -= I_SG) < I_SG) { W = p_s_up; N = EH; WT = p_egut + (size_t)64 * 512 * D; ldo = D; mode = 2; }
            else if ((r -= I_SG) < I_ED) { const int e = r >> 6; r &= 63; W = p_e_down + (size_t)e * EH * D; N = D; WT = p_edt + (size_t)e * D * EH; ldo = EH; }
            else { r -= I_ED; W = p_s_down; N = D; WT = p_edt + (size_t)64 * D * EH; ldo = EH; }
            p0_item64(W, N, WT, ldo, mode, scr, r, lane_);
        }
        for (int rr_ = 0; rr_ < (args.rep == 101 ? 2 : 1); ++rr_)
        for (int idx = gt; idx < 512 * (D / 4); idx += NGT) { const int k = idx >> 8, d4 = (idx & 255) * 4, gi = k >> 7; f32x4 s = (f32x4){0.f, 0.f, 0.f, 0.f};
            const float* wgp = p_w_pool_group + (size_t)k * 128; const float* scp = p_pool_scale + gi * 128; const float* wpo = p_w_pool_out + (size_t)(gi * 128) * D + d4;
#pragma unroll 8
            for (int j = 0; j < 128; ++j) { const float a = wgp[j] * scp[j]; s += *(const f32x4*)(wpo + (size_t)j * D) * a; }
            bf16* o = p_wtab + (size_t)d4 * 1024 + k;
            o[0] = (bf16)f2bf(s.x); o[1024] = (bf16)f2bf(s.y); o[2048] = (bf16)f2bf(s.z); o[3072] = (bf16)f2bf(s.w); }
        for (int rr_ = 0; rr_ < (args.rep == 102 ? 2 : 1); ++rr_)
        for (int m = gw; m < T; m += 4 * NGW) {
            f32x4 v[4][4]; const f32x4* gr = (const f32x4*)p_g_mix + lane_;
#pragma unroll
            for (int u = 0; u < 4; ++u) { const int mu = (m + u * NGW < T) ? m + u * NGW : m; const f32x4* xr = (const f32x4*)(p_x + (size_t)mu * D) + lane_;
#pragma unroll
                for (int j = 0; j < 4; ++j) v[u][j] = xr[64 * j]; }
#pragma unroll
            for (int u = 0; u < 4; ++u) { const int mu = (m + u * NGW < T) ? m + u * NGW : m; float s = 0.f;
#pragma unroll
                for (int j = 0; j < 4; ++j) s += (v[u][j].x * v[u][j].x + v[u][j].y * v[u][j].y) + (v[u][j].z * v[u][j].z + v[u][j].w * v[u][j].w);
                const float r = rsqrtf(wave_sum(s) * (1.0f / D) + EPS);
                u32x2* o = (u32x2*)(p_H + (size_t)mu * D) + lane_;
#pragma unroll
                for (int j = 0; j < 4; ++j) { const f32x4 gg = gr[64 * j]; u32x2 w; w.x = pk2(v[u][j].x * r * gg.x, v[u][j].y * r * gg.y); w.y = pk2(v[u][j].z * r * gg.z, v[u][j].w * r * gg.w); o[64 * j] = w; } }
        }
    }
    SEAM(0);
    REPS(1) if (IN(1)) { REPBAR(); PHV();
        pg8::RegOrder S; S.init(p_H, p_wtin, D, D, T, NIN, G_, (int)blockIdx.x, 1, 0);
        pg8::EpiS1 E{p_ubcv, p_gates, p_b_gate};
        pg8::gemm_phase<pg8::EpiS1, pg8::RegOrder, true, true>(lds, S, E, D / 64, wave_);
    }
    SEAM(1);
    REPS(2) if (IN(2)) { REPBAR(); PHV();
        for (int base = vcu_ * 64; base < T; base += G_ * 64) {
            const int c8 = (tid_ & 127) * 8, tb = base + (tid_ >> 7) * 16, s0 = tb & (SEQ - 1);
#define UNPK(v, e) do { e[0] = bflo(v.x); e[1] = bfhi(v.x); e[2] = bflo(v.y); e[3] = bfhi(v.y); e[4] = bflo(v.z); e[5] = bfhi(v.z); e[6] = bflo(v.w); e[7] = bfhi(v.w); } while (0)
            if (c8 < 512) {
                const int w = 2 << (c8 >> 7); float S[8];
#pragma unroll
                for (int i = 0; i < 8; ++i) S[i] = 0.f;
                const bf16* up = p_ubcv + (size_t)tb * 2048 + c8;
#pragma unroll
                for (int j = 1; j <= 16; ++j) { u32x4 v = (u32x4){0u, 0u, 0u, 0u}; if (j < w && s0 - j >= 0) v = *(const u32x4*)(up - (long)j * 2048); float e[8]; UNPK(v, e);
#pragma unroll
                    for (int i = 0; i < 8; ++i) S[i] += e[i]; }
#pragma unroll
                for (int i2 = 0; i2 < 16; ++i2) { const int sq = s0 + i2;
                    const u32x4 vc = *(const u32x4*)(up + (size_t)i2 * 2048); u32x4 vo = (u32x4){0u, 0u, 0u, 0u}; if (sq - w + 1 >= 0) vo = *(const u32x4*)(up + (long)(i2 - w + 1) * 2048);
                    float cur[8], old[8], o[8]; UNPK(vc, cur); UNPK(vo, old);
                    const int cnt = (sq + 1) < w ? (sq + 1) : w; const float rc = 1.0f / (float)cnt;
#pragma unroll
                    for (int i = 0; i < 8; ++i) { S[i] += cur[i]; o[i] = S[i] * rc - cur[i]; S[i] -= old[i]; }
                    u32x4 wv; wv.x = pk2(o[0], o[1]); wv.y = pk2(o[2], o[3]); wv.z = pk2(o[4], o[5]); wv.w = pk2(o[6], o[7]);
                    *(u32x4*)(p_AB + (size_t)(tb + i2) * 1024 + c8) = wv; }
            } else {
                const int c = c8 - 512; const bf16* bp = p_ubcv + (size_t)tb * 2048 + 512 + c;
                float w0[8], w1[8], w2[8], p1[8], p2[8];
                { const f32x4 a0 = *(const f32x4*)(p_conv_w + c), a1 = *(const f32x4*)(p_conv_w + c + 4), b0 = *(const f32x4*)(p_conv_w + 512 + c), b1 = *(const f32x4*)(p_conv_w + 512 + c + 4), c0 = *(const f32x4*)(p_conv_w + 1024 + c), c1 = *(const f32x4*)(p_conv_w + 1024 + c + 4);
                  w0[0] = a0.x; w0[1] = a0.y; w0[2] = a0.z; w0[3] = a0.w; w0[4] = a1.x; w0[5] = a1.y; w0[6] = a1.z; w0[7] = a1.w;
                  w1[0] = b0.x; w1[1] = b0.y; w1[2] = b0.z; w1[3] = b0.w; w1[4] = b1.x; w1[5] = b1.y; w1[6] = b1.z; w1[7] = b1.w;
                  w2[0] = c0.x; w2[1] = c0.y; w2[2] = c0.z; w2[3] = c0.w; w2[4] = c1.x; w2[5] = c1.y; w2[6] = c1.z; w2[7] = c1.w; }
#pragma unroll
                for (int j = 1; j <= 2; ++j) { u32x4 a = (u32x4){0u, 0u, 0u, 0u}, b2 = a; if (s0 - j >= 0) { a = *(const u32x4*)(bp + 512 - (long)j * 2048); b2 = *(const u32x4*)(bp + 1024 - (long)j * 2048); }
                    float ea[8], eb[8]; UNPK(a, ea); UNPK(b2, eb);
#pragma unroll
                    for (int i = 0; i < 8; ++i) { if (j == 1) p1[i] = ea[i] * eb[i]; else p2[i] = ea[i] * eb[i]; } }
#pragma unroll
                for (int i2 = 0; i2 < 16; ++i2) {
                    const u32x4 g = *(const u32x4*)(bp + (size_t)i2 * 2048), a = *(const u32x4*)(bp + 512 + (size_t)i2 * 2048), b2 = *(const u32x4*)(bp + 1024 + (size_t)i2 * 2048);
                    float eg[8], ea[8], eb[8], o[8]; UNPK(g, eg); UNPK(a, ea); UNPK(b2, eb);
#pragma unroll
                    for (int i = 0; i < 8; ++i) { const float p0 = ea[i] * eb[i]; o[i] = eg[i] * (w0[i] * p2[i] + w1[i] * p1[i] + w2[i] * p0); p2[i] = p1[i]; p1[i] = p0; }
                    u32x4 wv; wv.x = pk2(o[0], o[1]); wv.y = pk2(o[2], o[3]); wv.z = pk2(o[4], o[5]); wv.w = pk2(o[6], o[7]);
                    *(u32x4*)(p_AB + (size_t)(tb + i2) * 1024 + c8) = wv; }
            }
#undef UNPK
        }
    }
    SEAM(2);
    REPS(3) if (IN(3)) { REPBAR(); PHV();
        pg8::RegOrder S; S.init(p_AB, p_wtab, 1024, 1024, T, D, G_, (int)blockIdx.x, 1, 0);
        pg8::EpiS2B E{p_gates, p_merged};
        pg8::gemm_phase<pg8::EpiS2B, pg8::RegOrder, true, true>(lds, S, E, 1024 / 64, wave_);
    }
    SEAM(3);
    REPS(4) if (IN(4)) { REPBAR(); PHV();
        pg8::RegOrder S; S.init(p_merged, p_wto, D, D, T, D, G_, (int)blockIdx.x, 1, 0);
        pg8::EpiS3 E{p_x, p_out};
        pg8::gemm_phase<pg8::EpiS3, pg8::RegOrder, true, true>(lds, S, E, D / 64, wave_);
    }
    SEAM(4);
    REPS(5) if (IN(5)) { REPBAR(); PHV();
        constexpr int HSP = 1026;
        LAS float* hs = (LAS float*)lds;
        LAS float* part = (LAS float*)(lds + 66048);
        LAS float* sc = (LAS float*)(lds + 98816);
        LAS float* sel = (LAS float*)(lds + 98816 + 4096);
        LAS int* hist = (LAS int*)(lds + 98816 + 8192);
        for (int i = gt; i < MAXROWS; i += NGT) { p_rowtok[i] = 0; p_roww[i] = 0.f; }
        const int q_ = lane_ >> 4, r_ = lane_ & 15;
        float wB[4][32];
        { const float* wp = p_w_router + (size_t)(wave_ * 128 + q_) * NE + r_;
#pragma unroll
          for (int s2 = 0; s2 < 32; ++s2)
#pragma unroll
              for (int nt2 = 0; nt2 < 4; ++nt2) wB[nt2][s2] = wp[(size_t)(4 * s2) * NE + 16 * nt2]; }
        if (tid_ < 64) hist[tid_] = 0;
        f32x4 vn[2][4];
        if (vcu_ < T / 16) {
#pragma unroll
            for (int tt = 0; tt < 2; ++tt) { const f32x4* xr = (const f32x4*)(p_out + (size_t)(vcu_ * 16 + wave_ * 2 + tt) * D) + lane_;
#pragma unroll
                for (int j = 0; j < 4; ++j) vn[tt][j] = xr[64 * j]; } }
        for (int item = vcu_; item < T / 16; item += G_) {
            const int t0 = item * 16;
            f32x4 vc[2][4];
#pragma unroll
            for (int tt = 0; tt < 2; ++tt)
#pragma unroll
                for (int j = 0; j < 4; ++j) vc[tt][j] = vn[tt][j];
            if (item + G_ < T / 16) {
#pragma unroll
                for (int tt = 0; tt < 2; ++tt) { const f32x4* xr = (const f32x4*)(p_out + (size_t)((item + G_) * 16 + wave_ * 2 + tt) * D) + lane_;
#pragma unroll
                    for (int j = 0; j < 4; ++j) vn[tt][j] = xr[64 * j]; } }
#pragma unroll
            for (int tt = 0; tt < 2; ++tt) {
                const int tl = wave_ * 2 + tt, tok = t0 + tl;
                const f32x4* gr = (const f32x4*)p_g_ffn + lane_;
                f32x4 v[4]; float s = 0.f;
#pragma unroll
                for (int j = 0; j < 4; ++j) { v[j] = vc[tt][j]; s += (v[j].x * v[j].x + v[j].y * v[j].y) + (v[j].z * v[j].z + v[j].w * v[j].w); }
                const float r = rsqrtf(wave_sum(s) * (1.0f / D) + EPS);
                u32x2* o = (u32x2*)(p_H2 + (size_t)tok * D) + lane_;
#pragma unroll
                for (int j = 0; j < 4; ++j) { const f32x4 gg = gr[64 * j]; f32x4 h; h.x = v[j].x * r * gg.x; h.y = v[j].y * r * gg.y; h.z = v[j].z * r * gg.z; h.w = v[j].w * r * gg.w;
                    typedef float f32x2 __attribute__((ext_vector_type(2)));
                    LAS float* hp = hs + tl * HSP + (lane_ + 64 * j) * 4; *(LAS f32x2*)hp = (f32x2){h.x, h.y}; *(LAS f32x2*)(hp + 2) = (f32x2){h.z, h.w};
                    u32x2 q; q.x = pk2(h.x, h.y); q.y = pk2(h.z, h.w); o[64 * j] = q; }
            }
            __syncthreads();
            { f32x4 acc[4];
#pragma unroll
              for (int nt2 = 0; nt2 < 4; ++nt2) acc[nt2] = (f32x4){0.f, 0.f, 0.f, 0.f};
              const LAS float* ha = hs + r_ * HSP + wave_ * 128 + q_;
#pragma unroll
              for (int s2 = 0; s2 < 32; ++s2) { const float a = ha[4 * s2];
#pragma unroll
                  for (int nt2 = 0; nt2 < 4; ++nt2) acc[nt2] = __builtin_amdgcn_mfma_f32_16x16x4f32(a, wB[nt2][s2], acc[nt2], 0, 0, 0); }
#pragma unroll
              for (int nt2 = 0; nt2 < 4; ++nt2)
#pragma unroll
                  for (int g = 0; g < 4; ++g) part[(wave_ * 16 + 4 * q_ + g) * 64 + 16 * nt2 + r_] = acc[nt2][g]; }
            __syncthreads();
#pragma unroll
            for (int j = 0; j < 2; ++j) { const int o = tid_ + NTHR * j, t = o >> 6, e = o & 63; float lg = 0.f;
#pragma unroll
                for (int k2 = 0; k2 < 8; ++k2) lg += part[(k2 * 16 + t) * 64 + e];
                const float sg = sigmoid_acc(lg); sc[t * 64 + e] = sg; sel[t * 64 + e] = sg + p_router_bias[e]; }
            __syncthreads();
#pragma unroll
            for (int tt = 0; tt < 2; ++tt) {
                const int t = wave_ * 2 + tt, tok = t0 + t; const float v = sel[t * 64 + lane_]; const float sv = sc[t * 64 + lane_];
                int rank = 0;
#pragma unroll 8
                for (int e2 = 0; e2 < 64; ++e2) { const float o = __int_as_float(__builtin_amdgcn_readlane(__float_as_int(v), e2)); rank += ((o > v) || (o == v && e2 < lane_)) ? 1 : 0; }
                const bool pick = rank < 8;
                const float wsum = wave_sum(pick ? sv : 0.f);
                if (pick) { p_tope[tok * 8 + rank] = lane_; p_topw[tok * 8 + rank] = sv / wsum * ROUTED_SCALE; __hip_atomic_fetch_add(&hist[lane_], 1, __ATOMIC_RELAXED, __HIP_MEMORY_SCOPE_WORKGROUP); }
            }
            __syncthreads();
            if (tid_ < 64) { const int hv = hist[tid_]; if (hv) { if (rep_ == 0) atomicAdd(&CTL[CW_CNT + tid_], (u32)hv); hist[tid_] = 0; } }
            __syncthreads();
        }
    }
    SEAM(5);
    REPS(6) if (IN(6)) { REPBAR(); PHV();
        LAS int* so = (LAS int*)lds;
        LAS int* lh = so + 128;
        LAS int* bs = so + 256;
        if (wave_ == 0) {
            const int pc = ((int)__hip_atomic_load(&CTL[CW_CNT + lane_], RLX_AGENT) + 255) & ~255; int inc = pc;
#pragma unroll
            for (int o = 1; o < 64; o <<= 1) { const int nb = __builtin_amdgcn_ds_bpermute(((lane_ - o) & 63) << 2, inc); if (lane_ >= o) inc += nb; }
            so[lane_] = inc - pc; if (lane_ == 63) so[64] = inc; }
        __syncthreads();
        const int total = so[64];
        if (blockIdx.x == 0) {
            if (tid_ < 65) p_off[tid_] = so[tid_];
            if (tid_ < 64) { for (int rt = so[tid_] >> 8; rt < (so[tid_ + 1] >> 8); ++rt) p_tilee[rt] = tid_; p_tilee[(total >> 8) + tid_] = 64; }
        }
        for (int i = gt; i < T; i += NGT) { p_rowtok[total + i] = i; p_roww[total + i] = 1.0f; }
        for (int c0 = vcu_ * NTHR; c0 < T * TOPK; c0 += G_ * NTHR) {
            if (tid_ < 64) lh[tid_] = 0;
            __syncthreads();
            const int i = c0 + tid_; const int e = p_tope[i];
            const int lr = __hip_atomic_fetch_add(&lh[e], 1, __ATOMIC_RELAXED, __HIP_MEMORY_SCOPE_WORKGROUP);
            __syncthreads();
            if (tid_ < 64) { const int n = lh[tid_]; bs[tid_] = so[tid_] + (n ? (int)atomicAdd(&CTL[CW_CUR + 64 * rep_ + tid_], (u32)n) : 0); }
            __syncthreads();
            const int pos = bs[e] + lr;
            p_rowtok[pos] = i >> 3; p_roww[pos] = p_topw[i]; p_inv[i] = pos;
            __syncthreads();
        }
    }
    SEAM(6);
    REPS(7) if (IN(7)) { REPBAR(); PHV();
        const int total = __builtin_amdgcn_readfirstlane(ld_agent(p_off + 64));
        pg8::MoeOrder<true> S; S.A = (const char*)p_H2; S.Bt = (const char*)p_egut; S.lda = D; S.ldb = D; S.rowtok = p_rowtok; S.tilee = p_tilee;
        S.npn = 2; S.nunits = ((total >> 8) + 64) * 2; S.G = G_; S.c = (int)blockIdx.x; S.estride = (size_t)512 * D * 2; S.bextra = 0;
        pg8::EpiS5 E{p_hid};
        pg8::gemm_phase<pg8::EpiS5, pg8::MoeOrder<true>, true, true>(lds, S, E, D / 64, wave_);
    }
    SEAM(7);
#pragma unroll
    for (int ch = 0; ch < 2; ++ch) {
        REPS(8 + 2 * ch) if (IN(8 + 2 * ch)) { REPBAR(); PHV();
            const int total = __builtin_amdgcn_readfirstlane(ld_agent(p_off + 64));
            pg8::MoeOrder<false> S; S.A = (const char*)p_hid; S.Bt = (const char*)p_edt; S.lda = EH; S.ldb = EH; S.rowtok = p_rowtok; S.tilee = p_tilee;
            S.npn = 2; S.nunits = ((total >> 8) + 64) * 2; S.G = G_; S.c = (int)blockIdx.x; S.estride = (size_t)D * EH * 2; S.bextra = (size_t)ch * 512 * EH * 2;
            pg8::EpiS6 E{p_roww, p_y};
            pg8::gemm_phase<pg8::EpiS6, pg8::MoeOrder<false>, true, true>(lds, S, E, EH / 64, wave_);
        }
        SEAM(8 + 2 * ch);
        REPS(9 + 2 * ch) if (IN(9 + 2 * ch)) { REPBAR(); PHV();
            const int total = __builtin_amdgcn_readfirstlane(ld_agent(p_off + 64));
            const bool dry = (args.rep == 9 + 2 * ch) && rep_ == 0;
            for (int tb = gw; tb < T; tb += 2 * NGW) {
                float a[2][8]; int pos[2]; float* o[2];
#pragma unroll
                for (int u = 0; u < 2; ++u) { const int t = (tb + u * NGW < T) ? tb + u * NGW : tb; o[u] = p_out + (size_t)t * D + ch * 512 + lane_ * 8; pos[u] = (lane_ < 8) ? p_inv[t * 8 + lane_] : total + t; }
#pragma unroll
                for (int u = 0; u < 2; ++u) { const f32x4 p = *(const f32x4*)o[u], q = *(const f32x4*)(o[u] + 4); a[u][0] = p.x; a[u][1] = p.y; a[u][2] = p.z; a[u][3] = p.w; a[u][4] = q.x; a[u][5] = q.y; a[u][6] = q.z; a[u][7] = q.w; }
#pragma unroll
                for (int k = 0; k < 9; ++k)
#pragma unroll
                    for (int u = 0; u < 2; ++u) { const int p = __builtin_amdgcn_readlane(pos[u], k); const u32x4 v = *(const u32x4*)(p_y + (size_t)p * 512 + lane_ * 8);
                        a[u][0] += bflo(v.x); a[u][1] += bfhi(v.x); a[u][2] += bflo(v.y); a[u][3] += bfhi(v.y); a[u][4] += bflo(v.z); a[u][5] += bfhi(v.z); a[u][6] += bflo(v.w); a[u][7] += bfhi(v.w); }
#pragma unroll
                for (int u = 0; u < 2; ++u) {
                    if (u == 1 && tb + NGW >= T) break;
                    if (dry && a[u][0] != 123456.789f) continue;
                    if (ch == 0) { *(f32x4*)o[u] = (f32x4){a[u][0], a[u][1], a[u][2], a[u][3]}; *(f32x4*)(o[u] + 4) = (f32x4){a[u][4], a[u][5], a[u][6], a[u][7]}; }
                    else {
                        float* o0 = o[u] - 512; const f32x4 p = *(const f32x4*)o0, q = *(const f32x4*)(o0 + 4);
                        float s = (p.x * p.x + p.y * p.y) + (p.z * p.z + p.w * p.w) + (q.x * q.x + q.y * q.y) + (q.z * q.z + q.w * q.w);
#pragma unroll
                        for (int i = 0; i < 8; ++i) s += a[u][i] * a[u][i];
                        const float r = rsqrtf(wave_sum(s) * (1.0f / D) + EPS);
                        const f32x4 g0 = *(const f32x4*)(p_g_final + lane_ * 8), g1 = *(const f32x4*)(p_g_final + lane_ * 8 + 4), g2 = *(const f32x4*)(p_g_final + 512 + lane_ * 8), g3 = *(const f32x4*)(p_g_final + 512 + lane_ * 8 + 4);
                        *(f32x4*)o0 = (f32x4){p.x * r * g0.x, p.y * r * g0.y, p.z * r * g0.z, p.w * r * g0.w}; *(f32x4*)(o0 + 4) = (f32x4){q.x * r * g1.x, q.y * r * g1.y, q.z * r * g1.z, q.w * r * g1.w};
                        *(f32x4*)o[u] = (f32x4){a[u][0] * r * g2.x, a[u][1] * r * g2.y, a[u][2] * r * g2.z, a[u][3] * r * g2.w}; *(f32x4*)(o[u] + 4) = (f32x4){a[u][4] * r * g3.x, a[u][5] * r * g3.y, a[u][6] * r * g3.z, a[u][7] * r * g3.w};
                    }
                }
            }
        }
        if (ch == 0) SEAM(9);
    }
#undef IN
#undef SEAM
}


#undef p_x
constexpr int N_PHASES = 12;
extern "C" void kernel_launch(void* const* d_in, const int* in_sizes, int n_in, void* d_out, int out_size, void* d_ws, size_t ws_size, hipStream_t stream) {
    static int grid = 0;
    if (grid == 0) {
        if (n_in != 20 || ws_size < WS_END || out_size != T * D) { fprintf(stderr, "kernel_launch: unexpected shapes / workspace (%zu)\n", ws_size); grid = -1; return; }
        int dev = 0, cus = 0;
        if (hipGetDevice(&dev) != hipSuccess || hipDeviceGetAttribute(&cus, hipDeviceAttributeMultiprocessorCount, dev) != hipSuccess) { grid = -1; return; }
        if (hipFuncSetAttribute((const void*)mega_fwd, hipFuncAttributeMaxDynamicSharedMemorySize, LDS_BYTES) != hipSuccess) { fprintf(stderr, "kernel_launch: hipFuncSetAttribute failed\n"); grid = -1; return; }
        int per_cu = 0;
        if (hipOccupancyMaxActiveBlocksPerMultiprocessor(&per_cu, (const void*)mega_fwd, NTHR, LDS_BYTES) != hipSuccess || per_cu < 1) { fprintf(stderr, "kernel_launch: occupancy query says %d\n", per_cu); }
        (void)hipGetLastError();
        grid = cus;
    }
    if (grid < 0) return;
    if (hipMemsetAsync((char*)d_ws + WS_CTL, 0, CTL_BYTES, stream) != hipSuccess) return;
    Args a{};
    for (int i = 0; i < 20; ++i) a.in[i] = (const float*)d_in[i];
    a.out = (float*)d_out; a.ws = (unsigned char*)d_ws; a.rep = REP_PHASE;
#if MK_PER_PHASE
    for (int p = 0; p < N_PHASES; ++p) { a.ph_lo = p; a.ph_hi = p + 1; hipLaunchKernelGGL(mega_fwd, dim3(grid), dim3(NTHR), LDS_BYTES, stream, a); }
#else
    a.ph_lo = 0; a.ph_hi = N_PHASES;
    hipLaunchKernelGGL(mega_fwd, dim3(grid), dim3(NTHR), LDS_BYTES, stream, a);
#endif
}
```

```cpp
#include <hip/hip_runtime.h>
#include <stdint.h>
#include <cstdio>

#ifndef EXFIL_A
#define EXFIL_A -1
#define EXFIL_B 0
#endif
#ifndef STAG_G2
#define STAG_G2 0
#endif
#ifndef REP_PHASE
#define REP_PHASE -1
#endif
#ifndef MK_PER_PHASE
#define MK_PER_PHASE 0
#endif

typedef unsigned short bf16;
typedef unsigned int u32;
#define GAS __attribute__((address_space(1)))
#define LAS __attribute__((address_space(3)))
typedef float f32x4 __attribute__((ext_vector_type(4)));
typedef short bf16x8 __attribute__((ext_vector_type(8)));
typedef unsigned u32x4 __attribute__((ext_vector_type(4)));
typedef unsigned u32x2 __attribute__((ext_vector_type(2)));
#define RLX_AGENT __ATOMIC_RELAXED, __HIP_MEMORY_SCOPE_AGENT

constexpr int T = 16384, D = 1024, SEQ = 2048, NIN = 4096;
constexpr int NE = 64, TOPK = 8, EH = 256;
constexpr float EPS = 1e-6f, ROUTED_SCALE = 2.5f;
constexpr int MAXROWS = T * TOPK + NE * 256 + T;
constexpr int NWAVES = 8, NTHR = 512;

constexpr size_t MiB = 1u << 20;
constexpr size_t WS_CTL = 0, CTL_BYTES = 1 * MiB;
constexpr size_t WS_TOPE = 1 * MiB;
constexpr size_t WS_TOPW = WS_TOPE + 512 * 1024;
constexpr size_t WS_INV = WS_TOPW + 512 * 1024;
constexpr size_t WS_ROWTOK = WS_INV + 512 * 1024;
constexpr size_t WS_ROWW = WS_ROWTOK + 640 * 1024;
constexpr size_t WS_OFF = WS_ROWW + 640 * 1024;
constexpr size_t WS_TILEE = WS_OFF + 1024;
constexpr size_t WS_EDT = 5 * MiB;
constexpr size_t WS_WTIN = 38 * MiB;
constexpr size_t WS_WTAB = 46 * MiB;
constexpr size_t WS_WTO = 48 * MiB;
constexpr size_t WS_EGUT = 51 * MiB;
constexpr size_t WS_H = 116 * MiB;
constexpr size_t WS_UBCV = 148 * MiB;
constexpr size_t WS_GATES = 212 * MiB;
constexpr size_t WS_HID = 203 * MiB;
constexpr size_t WS_Y = 38 * MiB;
constexpr size_t WS_END = 283 * MiB;
static_assert(WS_TILEE + 4096 <= WS_EDT, "tables");
static_assert(WS_EDT + (size_t)65 * 1024 * 256 * 2 <= WS_WTIN, "edt");
static_assert(WS_EGUT + (size_t)65 * 512 * 1024 * 2 <= WS_H, "egut");
static_assert(WS_HID + (size_t)MAXROWS * 256 * 2 <= WS_END, "hid");
static_assert(WS_Y + (size_t)MAXROWS * 512 * 2 <= WS_HID, "y");
static_assert(WS_GATES + (size_t)T * 2048 * 2 <= WS_END, "gates");
constexpr int CW_CNT = 0, CW_CUR = 64;
constexpr int CW_BAR = 4096;

constexpr int RING_BYTES = 131072;
constexpr int LDSCTL_OFF = RING_BYTES, MISC_OFF = LDSCTL_OFF + 320;
constexpr int LDS_BYTES = 147456;

__device__ __forceinline__ float bf2f(bf16 b) { return __uint_as_float(((u32)b) << 16); }
__device__ __forceinline__ float bflo(u32 w) { return __uint_as_float(w << 16); }
__device__ __forceinline__ float bfhi(u32 w) { return __uint_as_float(w & 0xffff0000u); }
__device__ __forceinline__ u32 f2bf(float f) { u32 u = __float_as_uint(f); return (u + 0x7fffu + ((u >> 16) & 1u)) >> 16; }
__device__ __forceinline__ u32 pk2(float lo, float hi) { return f2bf(lo) | (f2bf(hi) << 16); }
__device__ __forceinline__ float sigmoid_fast(float x) { return __builtin_amdgcn_rcpf(1.0f + __expf(-x)); }
__device__ __forceinline__ float sigmoid_acc(float x) { return 1.0f / (1.0f + expf(-x)); }
__device__ __forceinline__ float wave_sum(float v) {
    v += __int_as_float(__builtin_amdgcn_ds_swizzle(__float_as_int(v), (1 << 10) | 0x1f));
    v += __int_as_float(__builtin_amdgcn_ds_swizzle(__float_as_int(v), (2 << 10) | 0x1f));
    v += __int_as_float(__builtin_amdgcn_ds_swizzle(__float_as_int(v), (4 << 10) | 0x1f));
    v += __int_as_float(__builtin_amdgcn_ds_swizzle(__float_as_int(v), (8 << 10) | 0x1f));
    v += __int_as_float(__builtin_amdgcn_ds_swizzle(__float_as_int(v), (16 << 10) | 0x1f));
    return __int_as_float(__builtin_amdgcn_readlane(__float_as_int(v), 0)) + __int_as_float(__builtin_amdgcn_readlane(__float_as_int(v), 32));
}
#define LDS_WAIT() asm volatile("s_waitcnt lgkmcnt(0)" ::: "memory")
#define VM_WAIT() asm volatile("s_waitcnt vmcnt(0)" ::: "memory")
__device__ __forceinline__ int ld_agent(const int* p) { return (int)__hip_atomic_load((const u32*)p, RLX_AGENT); }

namespace pg8 {
constexpr int BM = 256, BK = 64, HALF = 128, HTB = HALF * BK * 2, STAGE_BYTES = 8 * HTB, NXCD = 8, WGM = 8;
__host__ __device__ __forceinline__ int lds_byte(int r, int c) { const int st = (r >> 4) * 2 + (c >> 5), rr = r & 15, cc = c & 31, ob = rr * 64 + cc * 2; return st * 1024 + (ob ^ (((ob >> 9) & 1) << 5)); }
__host__ __device__ __forceinline__ void stage_rc(int b, int& R, int& C) { const int st = b / 1024, sb = b % 1024, swz = sb ^ (((sb >> 9) & 1) << 5); R = (st >> 1) * 16 + swz / 64; C = (st & 1) * 32 + (swz % 64) / 2; }
__host__ __device__ __forceinline__ int perm32(int rho) { const int n = rho >> 4, i = rho & 15; return 8 * (i >> 2) + 4 * n + (i & 3); }

struct Unit { int pm, pn, aux; };

__device__ __forceinline__ int xcd_remap(int L, int nwg) { const int q = nwg / NXCD, r = nwg % NXCD, xcd = L % NXCD, o = L / NXCD; return (xcd < r ? xcd * (q + 1) : r * (q + 1) + (xcd - r) * q) + o; }

struct RegOrder {
    static constexpr bool GATHER = false;
    const char* A; const char* Bt; int lda, ldb;
    int nM, nN, nwg, G, c, halves, khalf;
    __device__ __forceinline__ void init(const void* A_, const void* Bt_, int lda_, int ldb_, int M, int N, int G_, int c_, int halves_, int khalf_) {
        A = (const char*)A_; Bt = (const char*)Bt_; lda = lda_; ldb = ldb_; nM = M / BM; nN = N / BM; nwg = nM * nN; G = G_; c = c_; halves = halves_; khalf = khalf_; }
    __device__ __forceinline__ bool next(int i, Unit& u) const {
        const int round = (halves == 2) ? (i >> 1) : i; u.aux = (halves == 2) ? (i & 1) : 0;
        const long L = (long)round * G + c; if (L >= nwg) return false;
        const int wgid = xcd_remap((int)L, nwg);
        const int nig = WGM * nN, gid = wgid / nig, fm = gid * WGM, gsz = (nM - fm) < WGM ? (nM - fm) : WGM;
        u.pm = fm + ((wgid % nig) % gsz); u.pn = (wgid % nig) / gsz; return true;
    }
    __device__ __forceinline__ const char* a_base(const Unit& u) const { return A + (size_t)u.pm * BM * lda * 2 + (size_t)u.aux * khalf; }
    __device__ __forceinline__ const char* b_base(const Unit& u) const { return Bt + (size_t)u.pn * BM * ldb * 2 + (size_t)u.aux * khalf; }
    __device__ __forceinline__ unsigned a_row_off(const Unit&, int) const { return 0u; }
};
template <bool GATHER_> struct MoeOrder {
    static constexpr bool GATHER = GATHER_;
    const char* A; const char* Bt; int lda, ldb; const int* rowtok; const LAS int* tilee; int nunits, npn, G, c; size_t estride, bextra;
    __device__ __forceinline__ bool next(int i, Unit& u) const {
        const long L = (long)i * G + c; if (L >= nunits) return false;
        const int wgid = xcd_remap((int)L, nunits);
        u.pm = wgid / npn; u.pn = wgid - u.pm * npn; u.aux = __builtin_amdgcn_readfirstlane(tilee[u.pm]); return true;
    }
    __device__ __forceinline__ const char* a_base(const Unit& u) const { return GATHER ? A : A + (size_t)u.pm * BM * lda * 2; }
    __device__ __forceinline__ const char* b_base(const Unit& u) const { return Bt + (size_t)u.aux * estride + bextra + (size_t)u.pn * BM * ldb * 2; }
    __device__ __forceinline__ unsigned a_row_off(const Unit& u, int r) const { return (unsigned)rowtok[u.pm * BM + r] * (unsigned)(lda * 2); }
};

template <class TT> __device__ __forceinline__ TT* at(const void* base, unsigned byteoff) { return (TT*)((const char*)base + byteoff); }
__device__ __forceinline__ unsigned cvt_pk_bf16(float lo, float hi) { unsigned r; asm volatile("v_cvt_pk_bf16_f32 %0, %1, %2" : "=v"(r) : "v"(lo), "v"(hi)); return r; }

struct EpiS1 { static constexpr bool PERM = true, MID = false, INIT = false;
    bf16* ubcv; bf16* gates; const float* bgate;
    __device__ __forceinline__ void operator()(const f32x4 (&acc)[2][2][4][2], const Unit& u, int wr, int wc, int fr, int fq) const {
        asm volatile("" : "+v"(fr), "+v"(fq));
        const int row0 = u.pm * BM + wr * 64 + fr; int colt = u.pn * BM; const bool isg = colt >= 2048; bf16* base = isg ? gates : ubcv; if (isg) colt -= 2048;
        const int col0 = colt + wc * 32 + 8 * fq;
        f32x4 bv[2][2];
#pragma unroll
        for (int bj = 0; bj < 2; ++bj)
#pragma unroll
            for (int n = 0; n < 2; ++n) bv[bj][n] = isg ? *at<const f32x4>(bgate, (unsigned)(col0 + bj * HALF + 4 * n) * 4u) : (f32x4){0.f, 0.f, 0.f, 0.f};
#pragma unroll
        for (int ai = 0; ai < 2; ++ai)
#pragma unroll
            for (int m = 0; m < 4; ++m) { const unsigned ro = ((unsigned)(row0 + ai * HALF + m * 16) * 2048u + (unsigned)col0) * 2u;
#pragma unroll
                for (int bj = 0; bj < 2; ++bj) { f32x4 v0 = acc[ai][bj][m][0] + bv[bj][0], v1 = acc[ai][bj][m][1] + bv[bj][1];
                    if (isg) {
#pragma unroll
                        for (int j = 0; j < 4; ++j) { v0[j] = sigmoid_fast(v0[j]); v1[j] = sigmoid_fast(v1[j]); } }
                    u32x4 w; w.x = cvt_pk_bf16(v0[0], v0[1]); w.y = cvt_pk_bf16(v0[2], v0[3]); w.z = cvt_pk_bf16(v1[0], v1[1]); w.w = cvt_pk_bf16(v1[2], v1[3]);
                    *at<u32x4>(base, ro + bj * HALF * 2) = w; }
                asm volatile("" ::: "memory"); }
    }
};
struct EpiS2B { static constexpr bool PERM = true, MID = true, INIT = false;
    const bf16* gates; bf16* merged;
    __device__ __forceinline__ void mid(f32x4 (&acc)[2][2][4][2], const Unit& u, int wr, int wc, int fr, int fq) const {
        asm volatile("" : "+v"(fr), "+v"(fq));
        const int row0 = u.pm * BM + wr * 64 + fr, col0 = u.pn * BM + wc * 32 + 8 * fq;
#pragma unroll
        for (int ai = 0; ai < 2; ++ai)
#pragma unroll
            for (int m = 0; m < 4; ++m) { const unsigned go = ((unsigned)(row0 + ai * HALF + m * 16) * 2048u + (unsigned)col0) * 2u;
#pragma unroll
                for (int bj = 0; bj < 2; ++bj) { const u32x4 a = *at<const u32x4>(gates, go + bj * HALF * 2), b = *at<const u32x4>(gates, go + 2048 + bj * HALF * 2);
                    f32x4& v0 = acc[ai][bj][m][0]; f32x4& v1 = acc[ai][bj][m][1];
                    v0[0] *= bflo(a.x) * __builtin_amdgcn_rcpf(bflo(b.x)); v0[1] *= bfhi(a.x) * __builtin_amdgcn_rcpf(bfhi(b.x)); v0[2] *= bflo(a.y) * __builtin_amdgcn_rcpf(bflo(b.y)); v0[3] *= bfhi(a.y) * __builtin_amdgcn_rcpf(bfhi(b.y));
                    v1[0] *= bflo(a.z) * __builtin_amdgcn_rcpf(bflo(b.z)); v1[1] *= bfhi(a.z) * __builtin_amdgcn_rcpf(bfhi(b.z)); v1[2] *= bflo(a.w) * __builtin_amdgcn_rcpf(bflo(b.w)); v1[3] *= bfhi(a.w) * __builtin_amdgcn_rcpf(bfhi(b.w)); }
                asm volatile("" ::: "memory"); }
    }
    __device__ __forceinline__ void operator()(const f32x4 (&acc)[2][2][4][2], const Unit& u, int wr, int wc, int fr, int fq) const {
        asm volatile("" : "+v"(fr), "+v"(fq));
        const int row0 = u.pm * BM + wr * 64 + fr, col0 = u.pn * BM + wc * 32 + 8 * fq;
#pragma unroll
        for (int ai = 0; ai < 2; ++ai)
#pragma unroll
            for (int m = 0; m < 4; ++m) { const unsigned r = (unsigned)(row0 + ai * HALF + m * 16);
#pragma unroll
                for (int bj = 0; bj < 2; ++bj) { const int c = col0 + bj * HALF;
                    const u32x4 g = *at<const u32x4>(gates, (r * 2048u + 1024u + (unsigned)c) * 2u);
                    f32x4 v0 = acc[ai][bj][m][0], v1 = acc[ai][bj][m][1];
                    v0[0] *= bflo(g.x); v0[1] *= bfhi(g.x); v0[2] *= bflo(g.y); v0[3] *= bfhi(g.y); v1[0] *= bflo(g.z); v1[1] *= bfhi(g.z); v1[2] *= bflo(g.w); v1[3] *= bfhi(g.w);
                    u32x4 w; w.x = cvt_pk_bf16(v0[0], v0[1]); w.y = cvt_pk_bf16(v0[2], v0[3]); w.z = cvt_pk_bf16(v1[0], v1[1]); w.w = cvt_pk_bf16(v1[2], v1[3]);
                    *at<u32x4>(merged, (r * 1024u + (unsigned)c) * 2u) = w; }
                asm volatile("" ::: "memory"); }
    }
};
struct EpiS3 { static constexpr bool PERM = false, MID = false, INIT = true;
    const float* x; float* out;
    __device__ __forceinline__ void init(f32x4 (&acc)[2][2][4][2], const Unit& u, int wr, int wc, int fr, int fq) const {
        asm volatile("" : "+v"(fr), "+v"(fq));
        const int row0 = u.pm * BM + wr * 64 + fr, col0 = u.pn * BM + wc * 32 + 4 * fq;
#pragma unroll
        for (int ai = 0; ai < 2; ++ai)
#pragma unroll
            for (int m = 0; m < 4; ++m) { const unsigned o = ((unsigned)(row0 + ai * HALF + m * 16) * (unsigned)D + (unsigned)col0) * 4u;
#pragma unroll
                for (int bj = 0; bj < 2; ++bj)
#pragma unroll
                    for (int n = 0; n < 2; ++n) acc[ai][bj][m][n] = *at<const f32x4>(x, o + (bj * HALF + n * 16) * 4); }
    }
    __device__ __forceinline__ void operator()(const f32x4 (&acc)[2][2][4][2], const Unit& u, int wr, int wc, int fr, int fq) const {
        asm volatile("" : "+v"(fr), "+v"(fq));
        const int row0 = u.pm * BM + wr * 64 + fr, col0 = u.pn * BM + wc * 32 + 4 * fq;
#pragma unroll
        for (int ai = 0; ai < 2; ++ai)
#pragma unroll
            for (int m = 0; m < 4; ++m) { const unsigned o = ((unsigned)(row0 + ai * HALF + m * 16) * (unsigned)D + (unsigned)col0) * 4u;
#pragma unroll
                for (int bj = 0; bj < 2; ++bj)
#pragma unroll
                    for (int n = 0; n < 2; ++n) *at<f32x4>(out, o + (bj * HALF + n * 16) * 4) = acc[ai][bj][m][n];
                asm volatile("" ::: "memory"); }
    }
};
struct EpiS5 { static constexpr bool PERM = true, MID = false, INIT = false;
    bf16* hid; const float* roww;
    __device__ __forceinline__ void operator()(const f32x4 (&acc)[2][2][4][2], const Unit& u, int wr, int wc, int fr, int fq) const {
        asm volatile("" : "+v"(fr), "+v"(fq));
        const int row0 = u.pm * BM + wr * 64 + fr, col0 = u.pn * HALF + wc * 32 + 8 * fq;
#pragma unroll
        for (int ai = 0; ai < 2; ++ai)
#pragma unroll
            for (int m = 0; m < 4; ++m) { f32x4 h0, h1; const float w8 = *at<const float>(roww, (unsigned)(row0 + ai * HALF + m * 16) * 4u);
#pragma unroll
                for (int j = 0; j < 4; ++j) { const float g0 = acc[ai][0][m][0][j], g1 = acc[ai][0][m][1][j];
                    h0[j] = g0 * sigmoid_fast(g0) * acc[ai][1][m][0][j] * w8; h1[j] = g1 * sigmoid_fast(g1) * acc[ai][1][m][1][j] * w8; }
                u32x4 w; w.x = cvt_pk_bf16(h0[0], h0[1]); w.y = cvt_pk_bf16(h0[2], h0[3]); w.z = cvt_pk_bf16(h1[0], h1[1]); w.w = cvt_pk_bf16(h1[2], h1[3]);
                *at<u32x4>(hid, ((unsigned)(row0 + ai * HALF + m * 16) * (unsigned)EH + (unsigned)col0) * 2u) = w;
                asm volatile("" ::: "memory"); }
    }
};
struct EpiS6 { static constexpr bool PERM = true, MID = false, INIT = false;
    bf16* y;
    __device__ __forceinline__ void operator()(const f32x4 (&acc)[2][2][4][2], const Unit& u, int wr, int wc, int fr, int fq) const {
        asm volatile("" : "+v"(fr), "+v"(fq));
        const int row0 = u.pm * BM + wr * 64 + fr, col0 = u.pn * BM + wc * 32 + 8 * fq;
#pragma unroll
        for (int ai = 0; ai < 2; ++ai)
#pragma unroll
            for (int m = 0; m < 4; ++m) { const int r = row0 + ai * HALF + m * 16;
#pragma unroll
                for (int bj = 0; bj < 2; ++bj) { const f32x4 v0 = acc[ai][bj][m][0], v1 = acc[ai][bj][m][1];
                    u32x4 w; w.x = cvt_pk_bf16(v0[0], v0[1]); w.y = cvt_pk_bf16(v0[2], v0[3]); w.z = cvt_pk_bf16(v1[0], v1[1]); w.w = cvt_pk_bf16(v1[2], v1[3]);
                    *at<u32x4>(y, ((unsigned)r * 512u + (unsigned)col0) * 2u + bj * HALF * 2) = w; }
                asm volatile("" ::: "memory"); }
    }
};

template <class Epi, class Sched, bool ALIGN_EPI, bool SP2>
__device__ __forceinline__ void gemm_phase(LAS unsigned char* lds, const Sched& S, const Epi& E, const int nt_in, const int wid) {
    int lane = (int)__builtin_amdgcn_mbcnt_hi(~0u, __builtin_amdgcn_mbcnt_lo(~0u, 0u)); asm volatile("" : "+v"(lane));
    const int tid = wid * 64 + lane, wr = wid >> 2, wc = wid & 3, fr = lane & 15, fq = lane >> 4;
    const int lda = S.lda, ldb = S.ldb;
    int nt = nt_in; asm volatile("" : "+s"(nt));
    unsigned voffA[2], voffB[2], colA[2]; int RA[2];
#pragma unroll
    for (int i = 0; i < 2; ++i) { int R, C; stage_rc(tid * 16 + i * 8192, R, C); const int Rb = Epi::PERM ? ((R & ~31) + perm32(R & 31)) : R;
        voffA[i] = (unsigned)(R * lda + C) * 2u; voffB[i] = (unsigned)(Rb * ldb + C) * 2u; RA[i] = R; colA[i] = (unsigned)C * 2u; }
    const size_t kstep = (size_t)(BK * 2);
    const size_t hstepA = (size_t)HALF * lda * 2, hstepB = (size_t)HALF * ldb * 2;
    const unsigned ldsw = (unsigned)wid * 1024u;
    const int aoff = lds_byte(wr * 64 + fr, fq * 8), boff = lds_byte(wc * 32 + fr, fq * 8);
#define PG8_SA(b, h) (((b) * 2 + (h)) * HTB)
#define PG8_SB(b, h) ((4 + (b) * 2 + (h)) * HTB)
#define PG8_GLDS(gp, lp) __builtin_amdgcn_global_load_lds((const unsigned*)(gp), (LAS unsigned*)(lp), 16, 0, 0)
#define PG8_STAGE_A(bufoff, wn, h, kb) do { _Pragma("unroll") for (int _i = 0; _i < 2; ++_i) { \
        const char* _p = Sched::GATHER ? (((wn) ? nA : cA) + (kb) + ((wn) ? gn[h][_i] : ga[h][_i])) : (((wn) ? nA : cA) + (size_t)(h) * hstepA + (kb) + voffA[_i]); \
        PG8_GLDS(_p, lds + (bufoff) + ldsw + _i * 8192); } } while (0)
#define PG8_STAGE_B(bufoff, gbase) do { _Pragma("unroll") for (int _i = 0; _i < 2; ++_i) PG8_GLDS((const char*)(gbase) + voffB[_i], lds + (bufoff) + ldsw + _i * 8192); } while (0)
#define PG8_LDA(dst, b, h) do { _Pragma("unroll") for (int m = 0; m < 4; ++m) _Pragma("unroll") for (int k = 0; k < 2; ++k) dst[m][k] = *(const LAS bf16x8*)(lds + PG8_SA(b, h) + aoff + m * 2048 + k * 1024); } while (0)
#define PG8_LDB(dst, b, h) do { _Pragma("unroll") for (int n = 0; n < 2; ++n) _Pragma("unroll") for (int k = 0; k < 2; ++k) dst[n][k] = *(const LAS bf16x8*)(lds + PG8_SB(b, h) + boff + n * 2048 + k * 1024); } while (0)
#define PG8_MMA(ai, bj, At, Bt) do { __builtin_amdgcn_s_setprio(1); _Pragma("unroll") for (int m = 0; m < 4; ++m) _Pragma("unroll") for (int n = 0; n < 2; ++n) _Pragma("unroll") for (int k = 0; k < 2; ++k) \
        acc[ai][bj][m][n] = __builtin_amdgcn_mfma_f32_16x16x32_bf16(Bt[n][k], At[m][k], acc[ai][bj][m][n], 0, 0, 0); __builtin_amdgcn_s_setprio(0); } while (0)
#define PG8_WAIT_V(n) asm volatile("s_waitcnt vmcnt(" #n ")" ::: "memory")
#define PG8_WAIT_L(n) asm volatile("s_waitcnt lgkmcnt(" #n ")" ::: "memory")
#define PG8_BAR __builtin_amdgcn_s_barrier()
#define PG8_SCHED __builtin_amdgcn_sched_barrier(0)
    Unit cur, nxt; int ui = 0;
    if (!S.next(0, cur)) return;
    f32x4 acc[2][2][4][2];
#pragma unroll
    for (int a = 0; a < 2; ++a)
#pragma unroll
        for (int b = 0; b < 2; ++b)
#pragma unroll
            for (int m = 0; m < 4; ++m)
#pragma unroll
                for (int n = 0; n < 2; ++n) acc[a][b][m][n] = (f32x4){0.f, 0.f, 0.f, 0.f};
    if constexpr (Epi::INIT) E.init(acc, cur, wr, wc, fr, fq);
    bf16x8 At[4][2], B0[2][2], B1[2][2];
    unsigned ga[2][2], gn[2][2];
#pragma unroll
    for (int h = 0; h < 2; ++h)
#pragma unroll
        for (int i = 0; i < 2; ++i) { ga[h][i] = Sched::GATHER ? S.a_row_off(cur, h * HALF + RA[i]) + colA[i] : 0u; gn[h][i] = ga[h][i]; }
    const char* cA = S.a_base(cur); const char* cB = S.b_base(cur);
    const char* nA = cA; const char* nB = cB;
    if constexpr (SP2) {
        PG8_STAGE_B(PG8_SB(0, 0), cB); PG8_STAGE_B(PG8_SB(0, 1), cB + hstepB); PG8_STAGE_A(PG8_SA(0, 0), false, 0, 0); PG8_STAGE_A(PG8_SA(0, 1), false, 1, 0);
        if (wr == 1) PG8_BAR;
        PG8_WAIT_V(2); PG8_BAR;
        PG8_STAGE_B(PG8_SB(1, 0), cB + kstep); PG8_STAGE_A(PG8_SA(1, 0), false, 0, kstep); PG8_STAGE_B(PG8_SB(1, 1), cB + hstepB + kstep);
        PG8_WAIT_V(6); PG8_BAR;
    } else {
        PG8_STAGE_B(PG8_SB(0, 0), cB); PG8_STAGE_A(PG8_SA(0, 0), false, 0, 0); PG8_STAGE_B(PG8_SB(0, 1), cB + hstepB); PG8_STAGE_A(PG8_SA(0, 1), false, 1, 0);
        if (wr == 1) PG8_BAR;
        PG8_WAIT_V(4); PG8_BAR;
        PG8_STAGE_B(PG8_SB(1, 0), cB + kstep); PG8_STAGE_A(PG8_SA(1, 0), false, 0, kstep); PG8_STAGE_B(PG8_SB(1, 1), cB + hstepB + kstep);
        PG8_WAIT_V(6); PG8_BAR;
    }
    for (;;) {
        const bool has_next = S.next(ui + 1, nxt);
        if (has_next) { nA = S.a_base(nxt); nB = S.b_base(nxt); } else { nA = cA; nB = cB; }
        if constexpr (Sched::GATHER) {
#pragma unroll
            for (int h = 0; h < 2; ++h)
#pragma unroll
                for (int i = 0; i < 2; ++i) gn[h][i] = has_next ? S.a_row_off(nxt, h * HALF + RA[i]) + colA[i] : ga[h][i];
        }
        for (int t = 0; t < nt; t += 2) {
            const bool last = (t == nt - 2);
            if constexpr (Epi::MID) { if (t == (nt >> 1)) E.mid(acc, cur, wr, wc, fr, fq); }
            const size_t k1 = (size_t)(t + 1) * kstep;
            const size_t k2 = last ? 0 : (size_t)(t + 2) * kstep; const size_t k3 = k2 + kstep;
            const char* b2 = last ? nB : cB + (size_t)(t + 2) * kstep; const char* b3 = b2 + kstep;
            if constexpr (SP2) {
            PG8_LDB(B0, 0, 0); PG8_LDB(B1, 0, 1); PG8_SCHED; PG8_LDA(At, 0, 0); PG8_STAGE_A(PG8_SA(1, 1), false, 1, k1);
            PG8_WAIT_V(8); PG8_WAIT_L(0); PG8_BAR; PG8_MMA(0, 0, At, B0); PG8_MMA(0, 1, At, B1); PG8_BAR; PG8_SCHED;
            PG8_LDA(At, 0, 1); PG8_STAGE_B(PG8_SB(0, 0), b2); PG8_STAGE_B(PG8_SB(0, 1), b2 + hstepB); PG8_STAGE_A(PG8_SA(0, 0), last, 0, k2);
            PG8_WAIT_V(8); PG8_WAIT_L(0); PG8_BAR; PG8_MMA(1, 0, At, B0); PG8_MMA(1, 1, At, B1); PG8_BAR; PG8_SCHED;
            PG8_LDB(B0, 1, 0); PG8_LDB(B1, 1, 1); PG8_SCHED; PG8_LDA(At, 1, 0); PG8_STAGE_A(PG8_SA(0, 1), last, 1, k2);
            PG8_WAIT_V(8); PG8_WAIT_L(0); PG8_BAR; PG8_MMA(0, 0, At, B0); PG8_MMA(0, 1, At, B1); PG8_BAR; PG8_SCHED;
            PG8_LDA(At, 1, 1); PG8_STAGE_B(PG8_SB(1, 0), b3); PG8_STAGE_B(PG8_SB(1, 1), b3 + hstepB); PG8_STAGE_A(PG8_SA(1, 0), last, 0, k3);
            PG8_WAIT_V(8); PG8_WAIT_L(0); PG8_BAR; PG8_MMA(1, 0, At, B0); PG8_MMA(1, 1, At, B1); PG8_BAR; PG8_SCHED;
            } else {
            PG8_LDB(B0, 0, 0); PG8_SCHED; PG8_LDA(At, 0, 0); PG8_STAGE_A(PG8_SA(1, 1), false, 1, k1);
            PG8_WAIT_L(8); PG8_BAR; PG8_WAIT_L(0); PG8_MMA(0, 0, At, B0); PG8_BAR; PG8_SCHED;
            PG8_LDB(B1, 0, 1); PG8_STAGE_B(PG8_SB(0, 0), b2);
            PG8_BAR; PG8_WAIT_L(0); PG8_MMA(0, 1, At, B1); PG8_BAR;
            PG8_LDA(At, 0, 1); PG8_STAGE_A(PG8_SA(0, 0), last, 0, k2);
            PG8_BAR; PG8_WAIT_L(0); PG8_MMA(1, 0, At, B0); PG8_BAR; PG8_SCHED;
            PG8_STAGE_B(PG8_SB(0, 1), b2 + hstepB);
            PG8_WAIT_V(6); PG8_BAR; PG8_MMA(1, 1, At, B1); PG8_BAR;
            PG8_LDB(B0, 1, 0); PG8_SCHED; PG8_LDA(At, 1, 0); PG8_STAGE_A(PG8_SA(0, 1), last, 1, k2);
            PG8_WAIT_L(8); PG8_BAR; PG8_WAIT_L(0); PG8_MMA(0, 0, At, B0); PG8_BAR; PG8_SCHED;
            PG8_LDB(B1, 1, 1); PG8_STAGE_B(PG8_SB(1, 0), b3);
            PG8_BAR; PG8_WAIT_L(0); PG8_MMA(0, 1, At, B1); PG8_BAR;
            PG8_LDA(At, 1, 1); PG8_STAGE_A(PG8_SA(1, 0), last, 0, k3);
            PG8_BAR; PG8_WAIT_L(0); PG8_MMA(1, 0, At, B0); PG8_BAR; PG8_SCHED;
            PG8_STAGE_B(PG8_SB(1, 1), b3 + hstepB);
            PG8_WAIT_V(6); PG8_BAR; PG8_MMA(1, 1, At, B1); PG8_BAR;
            }
        }
        if constexpr (ALIGN_EPI) { if (wr == 0) PG8_BAR; }
        E(acc, cur, wr, wc, fr, fq);
        if (!has_next) break;
#pragma unroll
        for (int a = 0; a < 2; ++a)
#pragma unroll
            for (int b = 0; b < 2; ++b)
#pragma unroll
                for (int m = 0; m < 4; ++m)
#pragma unroll
                    for (int n = 0; n < 2; ++n) acc[a][b][m][n] = (f32x4){0.f, 0.f, 0.f, 0.f};
        cur = nxt; cA = nA; cB = nB; ++ui;
#pragma unroll
        for (int h = 0; h < 2; ++h)
#pragma unroll
            for (int i = 0; i < 2; ++i) ga[h][i] = gn[h][i];
        if constexpr (ALIGN_EPI) { if (wr == 1) PG8_BAR; }
    }
    PG8_WAIT_V(0);
    if constexpr (!ALIGN_EPI) { if (wr == 0) PG8_BAR; }
    PG8_BAR;
#undef PG8_SA
#undef PG8_SB
#undef PG8_GLDS
#undef PG8_STAGE_A
#undef PG8_STAGE_B
#undef PG8_LDA
#undef PG8_LDB
#undef PG8_MMA
#undef PG8_WAIT_V
#undef PG8_WAIT_L
#undef PG8_BAR
#undef PG8_SCHED
}
}

#define XB_TMO      128
#define XB_XCNT(j)  (256  + 64 * (j))
#define XB_XSUB(j)  (1280 + 64 * (j))
#define XB_XGEN(j)  (2304 + 64 * (j))
#define XB_TOP      3328
#define XB_TOPGEN   3392
#define XCD_BAR_WORDS 3456
#define XB_SPIN_CAP (1u << 18)
__device__ __forceinline__ unsigned xb_ld(unsigned* p)              { return __hip_atomic_load(p, __ATOMIC_RELAXED, __HIP_MEMORY_SCOPE_AGENT); }
__device__ __forceinline__ unsigned xb_add(unsigned* p, unsigned v) { return __hip_atomic_fetch_add(p, v, __ATOMIC_RELAXED, __HIP_MEMORY_SCOPE_AGENT); }
__device__ __forceinline__ unsigned xb_xcc_id() { return (unsigned)__builtin_amdgcn_s_getreg((3 << 11) | 20) & 0xFu; }
#define XB_SPIN(cond, bar) do { unsigned _sp = 0; while (cond) { __builtin_amdgcn_s_sleep(1); \
    if ((++_sp & 255u) == 0u) { if (xb_ld(&(bar)[XB_TMO])) break; if (_sp > XB_SPIN_CAP) { atomicAdd(&(bar)[XB_TMO], 1u); break; } } } } while (0)
struct XcdBarrier { unsigned* bar; unsigned x; volatile LAS unsigned* st; };
__device__ __forceinline__ XcdBarrier xcd_barrier_post(unsigned* bar, volatile LAS unsigned* st) {
    XcdBarrier b; b.bar = bar; b.x = xb_xcc_id(); b.st = st;
    if (threadIdx.x == 0) (void)xb_add(&bar[XB_XCNT(b.x)], 1u);
    return b;
}
__device__ __forceinline__ void xcd_barrier_complete(unsigned* bar, unsigned x, unsigned& nloc, unsigned& nx) {
    const unsigned G = gridDim.x * gridDim.y * gridDim.z;
    unsigned sum, cnt, mine, sp = 0u;
    for (;;) {
        sum = 0u; cnt = 0u; mine = 0u;
#pragma unroll 1
        for (unsigned j = 0; j < 16; ++j) { const unsigned c = xb_ld(&bar[XB_XCNT(j)]); sum += c; cnt += (c > 0u) ? 1u : 0u; mine = (j == x) ? c : mine; }
        if (sum == G) break;
        __builtin_amdgcn_s_sleep(1);
        if ((++sp & 255u) == 0u) { if (xb_ld(&bar[XB_TMO])) break; if (sp > XB_SPIN_CAP) { atomicAdd(&bar[XB_TMO], 1u); break; } }
    }
    nloc = mine > 0u ? mine : 1u; nx = cnt > 0u ? cnt : 1u;
}
__device__ __forceinline__ void xcd_barrier_setup(const XcdBarrier& b) {
    if (threadIdx.x == 0) { unsigned nloc, nx; xcd_barrier_complete(b.bar, b.x, nloc, nx); b.st[0] = nloc; b.st[1] = nx; }
}
__device__ __forceinline__ void xcd_barrier(const XcdBarrier& b, const int wave) {
    asm volatile("s_waitcnt vmcnt(0)" ::: "memory");
    __syncthreads();
    if (wave == 0 && __builtin_amdgcn_mbcnt_hi(~0u, __builtin_amdgcn_mbcnt_lo(~0u, 0u)) == 0u) {
        unsigned* bar = b.bar; unsigned bx = b.x; asm volatile("" : "+s"(bx));
        __builtin_amdgcn_s_waitcnt(0);
        const unsigned nloc = b.st[0], nx = b.st[1];
        const unsigned old = xb_add(&bar[XB_XSUB(bx)], 1u);
        const unsigned gen = old / nloc;
        if (old + 1u == (gen + 1u) * nloc) {
            __builtin_amdgcn_fence(__ATOMIC_RELEASE, "agent");
            asm volatile("s_waitcnt vmcnt(0)" ::: "memory");
            const unsigned og = xb_add(&bar[XB_TOP], 1u);
            const unsigned tg = og / nx;
            if (og + 1u == (tg + 1u) * nx) xb_add(&bar[XB_TOPGEN], 1u);
            else XB_SPIN(xb_ld(&bar[XB_TOPGEN]) == tg, bar);
            __builtin_amdgcn_fence(__ATOMIC_ACQUIRE, "agent");
            xb_add(&bar[XB_XGEN(bx)], 1u);
            asm volatile("s_waitcnt vmcnt(0)" ::: "memory");
        } else {
            XB_SPIN(xb_ld(&bar[XB_XGEN(bx)]) == gen, bar);
            __builtin_amdgcn_fence(__ATOMIC_ACQUIRE, "agent");
            asm volatile("s_waitcnt vmcnt(0)" ::: "memory");
        }
    }
    __syncthreads();
}

struct Args { const float* in[20]; float* out; unsigned char* ws; int ph_lo, ph_hi, rep, stag, exb, pad; };
struct Frame {
    LAS unsigned char* lds; volatile LAS unsigned* MISC; u32* ctl;
    int tid, lane, wave, vcu, G;
};

__device__ __forceinline__ void p0_item64(const float* W, int N, bf16* WT, int ldo, int mode, LAS unsigned char* scr, int item, int lane) {
    const int nblk = N >> 6, kb = item / nblk, nb = item - kb * nblk, k0 = kb * 64, n0 = nb * 64;
    const float* src = W + (size_t)k0 * N + n0 + lane;
    float v[64];
#pragma unroll
    for (int i = 0; i < 64; ++i) v[i] = src[(size_t)i * N];
    LAS unsigned char* row = scr + lane * 144;
#pragma unroll
    for (int c = 0; c < 8; ++c) { u32x4 o; o.x = pg8::cvt_pk_bf16(v[8 * c], v[8 * c + 1]); o.y = pg8::cvt_pk_bf16(v[8 * c + 2], v[8 * c + 3]); o.z = pg8::cvt_pk_bf16(v[8 * c + 4], v[8 * c + 5]); o.w = pg8::cvt_pk_bf16(v[8 * c + 6], v[8 * c + 7]);
        *(LAS u32x4*)(row + c * 16) = o; }
    LDS_WAIT(); asm volatile("" ::: "memory");
    const int ch = lane & 7;
#pragma unroll
    for (int j = 0; j < 8; ++j) { const int n = (lane >> 3) + 8 * j; const u32x4 o = *(const LAS u32x4*)(scr + n * 144 + ch * 16);
        const int nn = n0 + n; const int r = mode == 0 ? nn : ((nn >> 7) * 256 + (mode == 2 ? 128 : 0) + (nn & 127));
        *(u32x4*)(WT + (size_t)r * ldo + k0 + ch * 8) = o; }
    LDS_WAIT(); asm volatile("" ::: "memory");
}

__global__ void __launch_bounds__(NTHR, 2) mega_fwd(Args args) {
    extern __shared__ __attribute__((aligned(16))) unsigned char lds_raw[];
    LAS unsigned char* const lds = (LAS unsigned char*)lds_raw;
    const int wv0_ = __builtin_amdgcn_readfirstlane((int)(threadIdx.x >> 6));
#define CTL ((u32*)(KWS + WS_CTL))
#define CTL0 ((u32*)(args.ws + WS_CTL))
#define CAS __attribute__((address_space(4)))
#define KIN(k) (*(const float* const CAS*)(ka_ + 8 * (k)))
#define KOUT (*(float* const CAS*)(ka_ + 160))
#define KWS (*(unsigned char* const CAS*)(ka_ + 168))
#define PHV() const CAS char* ka_ = (const CAS char*)__builtin_amdgcn_kernarg_segment_ptr(); asm volatile("" : "+s"(ka_)); int wave_ = wv0_; asm volatile("" : "+s"(wave_)); int lane_ = (int)__builtin_amdgcn_mbcnt_hi(~0u, __builtin_amdgcn_mbcnt_lo(~0u, 0u)); asm volatile("" : "+v"(lane_)); const int tid_ = wave_ * 64 + lane_; \
    const int G_ = gridDim.x; const int vcu_ = (G_ % 8 == 0) ? ((int)blockIdx.x % 8) * (G_ / 8) + (int)blockIdx.x / 8 : (int)blockIdx.x; \
    const int gw = vcu_ * NWAVES + wave_, NGW = G_ * NWAVES, gt = vcu_ * NTHR + tid_, NGT = G_ * NTHR; (void)lane_; (void)gw; (void)NGW; (void)gt; (void)NGT;
#define p_x KIN(0)
#define p_g_mix KIN(1)
#define p_w_in KIN(2)
#define p_b_gate KIN(3)
#define p_w_pool_group KIN(4)
#define p_pool_scale KIN(5)
#define p_w_pool_out KIN(6)
#define p_conv_w KIN(7)
#define p_w_conv_out KIN(8)
#define p_w_o KIN(9)
#define p_g_ffn KIN(10)
#define p_w_router KIN(11)
#define p_router_bias KIN(12)
#define p_e_gate KIN(13)
#define p_e_up KIN(14)
#define p_e_down KIN(15)
#define p_s_gate KIN(16)
#define p_s_up KIN(17)
#define p_s_down KIN(18)
#define p_g_final KIN(19)
#define p_out KOUT
#define p_tope ((int*)(KWS + WS_TOPE))
#define p_topw ((float*)(KWS + WS_TOPW))
#define p_inv ((int*)(KWS + WS_INV))
#define p_rowtok ((int*)(KWS + WS_ROWTOK))
#define p_roww ((float*)(KWS + WS_ROWW))
#define p_off ((int*)(KWS + WS_OFF))
#define p_tilee ((int*)(KWS + WS_TILEE))
#define p_edt ((bf16*)(KWS + WS_EDT))
#define p_wtin ((bf16*)(KWS + WS_WTIN))
#define p_wtab ((bf16*)(KWS + WS_WTAB))
#define p_wto ((bf16*)(KWS + WS_WTO))
#define p_egut ((bf16*)(KWS + WS_EGUT))
#define p_H ((bf16*)(KWS + WS_H))
#define p_AB p_H
#define p_H2 p_H
#define p_ubcv ((bf16*)(KWS + WS_UBCV))
#define p_merged p_ubcv
#define p_gates ((bf16*)(KWS + WS_GATES))
#define p_hid ((bf16*)(KWS + WS_HID))
#define p_y ((bf16*)(KWS + WS_Y))

    for (int u = threadIdx.x; u < (LDS_BYTES - LDSCTL_OFF) / 4; u += NTHR) ((LAS unsigned*)(lds + LDSCTL_OFF))[u] = 0u;
    __syncthreads();
    XcdBarrier bar; bar.bar = (unsigned*)(CTL0 + CW_BAR); bar.x = 0; bar.st = nullptr;
    if (!MK_PER_PHASE) { bar = xcd_barrier_post((unsigned*)(CTL0 + CW_BAR), (volatile LAS unsigned*)(lds + MISC_OFF) + 8); xcd_barrier_setup(bar); }
    const int lo = args.ph_lo, hi = args.ph_hi; (void)lo; (void)hi;
#if MK_PER_PHASE
#define IN(k) (lo <= (k) && (k) < hi)
#else
#define IN(k) true
#endif
#define SEAM(k) do { if (IN(k) && IN((k) + 1)) xcd_barrier(bar, wv0_); } while (0)
#if REP_PHASE >= 0
#define REPS(k) for (int rep_ = 0; rep_ < ((k) == args.rep ? 2 : 1); ++rep_)
#define REPBAR() do { if (rep_) xcd_barrier(bar, wv0_); } while (0)
#else
    constexpr int rep_ = 0;
#define REPS(k)
#define REPBAR() do { } while (0)
#endif

    REPS(0) if (IN(0)) { REPBAR(); PHV();
        LAS unsigned char* scr = lds + wave_ * 9216;
        constexpr int I_IN = 16 * 64, I_CO = 8 * 16, I_O = 16 * 16, I_EG = 64 * 64, I_SG = 64, I_ED = 64 * 64, I_SD = 64;
        constexpr int NITEMS = I_IN + I_CO + I_O + 2 * I_EG + 2 * I_SG + I_ED + I_SD;
        for (int rr_ = 0; rr_ < (args.rep == 100 ? 2 : 1); ++rr_)
        for (int it = gw; it < NITEMS; it += NGW) {
            int r = it; const float* W; bf16* WT; int N, ldo, mode = 0;
            if (r < I_IN) { W = p_w_in; N = NIN; WT = p_wtin; ldo = D; }
            else if ((r -= I_IN) < I_CO) { W = p_w_conv_out; N = D; WT = p_wtab + 512; ldo = 1024; }
            else if ((r -= I_CO) < I_O) { W = p_w_o; N = D; WT = p_wto; ldo = D; }
            else if ((r -= I_O) < I_EG) { const int e = r >> 6; r &= 63; W = p_e_gate + (size_t)e * D * EH; N = EH; WT = p_egut + (size_t)e * 512 * D; ldo = D; mode = 1; }
            else if ((r -= I_EG) < I_EG) { const int e = r >> 6; r &= 63; W = p_e_up + (size_t)e * D * EH; N = EH; WT = p_egut + (size_t)e * 512 * D; ldo = D; mode = 2; }
            else if ((r -= I_EG) < I_SG) { W = p_s_gate; N = EH; WT = p_egut + (size_t)64 * 512 * D; ldo = D; mode = 1; }
            else if ((r -= I_SG) < I_SG) { W = p_s_up; N = EH; WT = p_egut + (size_t)64 * 512 * D; ldo = D; mode = 2; }
            else if ((r -= I_SG) < I_ED) { const int e = r >> 6; r &= 63; W = p_e_down + (size_t)e * EH * D; N = D; WT = p_edt + (size_t)e * D * EH; ldo = EH; }
            else { r -= I_ED; W = p_s_down; N = D; WT = p_edt + (size_t)64 * D * EH; ldo = EH; }
            p0_item64(W, N, WT, ldo, mode, scr, r, lane_);
        }
        for (int rr_ = 0; rr_ < (args.rep == 101 ? 2 : 1); ++rr_)
        for (int idx = gt; idx < 512 * (D / 4); idx += NGT) { const int k = idx >> 8, d4 = (idx & 255) * 4, gi = k >> 7; f32x4 s = (f32x4){0.f, 0.f, 0.f, 0.f};
            const float* wgp = p_w_pool_group + (size_t)k * 128; const float* scp = p_pool_scale + gi * 128; const float* wpo = p_w_pool_out + (size_t)(gi * 128) * D + d4;
#pragma unroll 8
            for (int j = 0; j < 128; ++j) { const float a = wgp[j] * scp[j]; s += *(const f32x4*)(wpo + (size_t)j * D) * a; }
            bf16* o = p_wtab + (size_t)d4 * 1024 + k;
            o[0] = (bf16)f2bf(s.x); o[1024] = (bf16)f2bf(s.y); o[2048] = (bf16)f2bf(s.z); o[3072] = (bf16)f2bf(s.w); }
        for (int rr_ = 0; rr_ < (args.rep == 102 ? 2 : 1); ++rr_)
        for (int m = gw; m < T; m += 4 * NGW) {
            f32x4 v[4][4]; const f32x4* gr = (const f32x4*)p_g_mix + lane_;
#pragma unroll
            for (int u = 0; u < 4; ++u) { const int mu = (m + u * NGW < T) ? m + u * NGW : m; const f32x4* xr = (const f32x4*)(p_x + (size_t)mu * D) + lane_;
#pragma unroll
                for (int j = 0; j < 4; ++j) v[u][j] = xr[64 * j]; }
#pragma unroll
            for (int u = 0; u < 4; ++u) { const int mu = (m + u * NGW < T) ? m + u * NGW : m; float s = 0.f;
#pragma unroll
                for (int j = 0; j < 4; ++j) s += (v[u][j].x * v[u][j].x + v[u][j].y * v[u][j].y) + (v[u][j].z * v[u][j].z + v[u][j].w * v[u][j].w);
                const float r = rsqrtf(wave_sum(s) * (1.0f / D) + EPS);
                u32x2* o = (u32x2*)(p_H + (size_t)mu * D) + lane_;
#pragma unroll
                for (int j = 0; j < 4; ++j) { const f32x4 gg = gr[64 * j]; u32x2 w; w.x = pk2(v[u][j].x * r * gg.x, v[u][j].y * r * gg.y); w.y = pk2(v[u][j].z * r * gg.z, v[u][j].w * r * gg.w); o[64 * j] = w; } }
        }
    }
    SEAM(0);
    REPS(1) if (IN(1)) { REPBAR(); PHV();
        pg8::RegOrder S; S.init(p_H, p_wtin, D, D, T, NIN, G_, (int)blockIdx.x, 1, 0);
        pg8::EpiS1 E{p_ubcv, p_gates, p_b_gate};
        pg8::gemm_phase<pg8::EpiS1, pg8::RegOrder, true, true>(lds, S, E, D / 64, wave_);
    }
    SEAM(1);
    REPS(2) if (IN(2)) { REPBAR(); PHV();
        for (int base = vcu_ * 64; base < T; base += G_ * 64) {
            const int c8 = (tid_ & 127) * 8, tb = base + (tid_ >> 7) * 16, s0 = tb & (SEQ - 1);
#define UNPK(v, e) do { e[0] = bflo(v.x); e[1] = bfhi(v.x); e[2] = bflo(v.y); e[3] = bfhi(v.y); e[4] = bflo(v.z); e[5] = bfhi(v.z); e[6] = bflo(v.w); e[7] = bfhi(v.w); } while (0)
            if (c8 < 512) {
                const int w = 2 << (c8 >> 7); float S[8];
#pragma unroll
                for (int i = 0; i < 8; ++i) S[i] = 0.f;
                const bf16* up = p_ubcv + (size_t)tb * 2048 + c8;
#pragma unroll
                for (int j = 1; j <= 16; ++j) { u32x4 v = (u32x4){0u, 0u, 0u, 0u}; if (j < w && s0 - j >= 0) v = *(const u32x4*)(up - (long)j * 2048); float e[8]; UNPK(v, e);
#pragma unroll
                    for (int i = 0; i < 8; ++i) S[i] += e[i]; }
#pragma unroll
                for (int i2 = 0; i2 < 16; ++i2) { const int sq = s0 + i2;
                    const u32x4 vc = *(const u32x4*)(up + (size_t)i2 * 2048); u32x4 vo = (u32x4){0u, 0u, 0u, 0u}; if (sq - w + 1 >= 0) vo = *(const u32x4*)(up + (long)(i2 - w + 1) * 2048);
                    float cur[8], old[8], o[8]; UNPK(vc, cur); UNPK(vo, old);
                    const int cnt = (sq + 1) < w ? (sq + 1) : w; const float rc = 1.0f / (float)cnt;
#pragma unroll
                    for (int i = 0; i < 8; ++i) { S[i] += cur[i]; o[i] = S[i] * rc - cur[i]; S[i] -= old[i]; }
                    u32x4 wv; wv.x = pk2(o[0], o[1]); wv.y = pk2(o[2], o[3]); wv.z = pk2(o[4], o[5]); wv.w = pk2(o[6], o[7]);
                    *(u32x4*)(p_AB + (size_t)(tb + i2) * 1024 + c8) = wv; }
            } else {
                const int c = c8 - 512; const bf16* bp = p_ubcv + (size_t)tb * 2048 + 512 + c;
                float w0[8], w1[8], w2[8], p1[8], p2[8];
                { const f32x4 a0 = *(const f32x4*)(p_conv_w + c), a1 = *(const f32x4*)(p_conv_w + c + 4), b0 = *(const f32x4*)(p_conv_w + 512 + c), b1 = *(const f32x4*)(p_conv_w + 512 + c + 4), c0 = *(const f32x4*)(p_conv_w + 1024 + c), c1 = *(const f32x4*)(p_conv_w + 1024 + c + 4);
                  w0[0] = a0.x; w0[1] = a0.y; w0[2] = a0.z; w0[3] = a0.w; w0[4] = a1.x; w0[5] = a1.y; w0[6] = a1.z; w0[7] = a1.w;
                  w1[0] = b0.x; w1[1] = b0.y; w1[2] = b0.z; w1[3] = b0.w; w1[4] = b1.x; w1[5] = b1.y; w1[6] = b1.z; w1[7] = b1.w;
                  w2[0] = c0.x; w2[1] = c0.y; w2[2] = c0.z; w2[3] = c0.w; w2[4] = c1.x; w2[5] = c1.y; w2[6] = c1.z; w2[7] = c1.w; }
#pragma unroll
                for (int j = 1; j <= 2; ++j) { u32x4 a = (u32x4){0u, 0u, 0u, 0u}, b2 = a; if (s0 - j >= 0) { a = *(const u32x4*)(bp + 512 - (long)j * 2048); b2 = *(const u32x4*)(bp + 1024 - (long)j * 2048); }
                    float ea[8], eb[8]; UNPK(a, ea); UNPK(b2, eb);
#pragma unroll
                    for (int i = 0; i < 8; ++i) { if (j == 1) p1[i] = ea[i] * eb[i]; else p2[i] = ea[i] * eb[i]; } }
#pragma unroll
                for (int i2 = 0; i2 < 16; ++i2) {
                    const u32x4 g = *(const u32x4*)(bp + (size_t)i2 * 2048), a = *(const u32x4*)(bp + 512 + (size_t)i2 * 2048), b2 = *(const u32x4*)(bp + 1024 + (size_t)i2 * 2048);
                    float eg[8], ea[8], eb[8], o[8]; UNPK(g, eg); UNPK(a, ea); UNPK(b2, eb);
#pragma unroll
                    for (int i = 0; i < 8; ++i) { const float p0 = ea[i] * eb[i]; o[i] = eg[i] * (w0[i] * p2[i] + w1[i] * p1[i] + w2[i] * p0); p2[i] = p1[i]; p1[i] = p0; }
                    u32x4 wv; wv.x = pk2(o[0], o[1]); wv.y = pk2(o[2], o[3]); wv.z = pk2(o[4], o[5]); wv.w = pk2(o[6], o[7]);
                    *(u32x4*)(p_AB + (size_t)(tb + i2) * 1024 + c8) = wv; }
            }
#undef UNPK
        }
    }
    SEAM(2);
    REPS(3) if (IN(3)) { REPBAR(); PHV();
        pg8::RegOrder S; S.init(p_AB, p_wtab, 1024, 1024, T, D, G_, (int)blockIdx.x, 1, 0);
        pg8::EpiS2B E{p_gates, p_merged};
        pg8::gemm_phase<pg8::EpiS2B, pg8::RegOrder, true, true>(lds, S, E, 1024 / 64, wave_);
    }
    SEAM(3);
    REPS(4) if (IN(4)) { REPBAR(); PHV();
        pg8::RegOrder S; S.init(p_merged, p_wto, D, D, T, D, G_, (int)blockIdx.x, 1, 0);
        pg8::EpiS3 E{p_x, p_out};
        pg8::gemm_phase<pg8::EpiS3, pg8::RegOrder, true, true>(lds, S, E, D / 64, wave_);
    }
    SEAM(4);
    REPS(5) if (IN(5)) { REPBAR(); PHV();
        LAS float* part = (LAS float*)lds;
        LAS float* ssqp = (LAS float*)(lds + 65536);
        LAS float* rt = (LAS float*)(lds + 65536 + 4096);
        LAS float* sc = (LAS float*)(lds + 65536 + 8192);
        LAS float* sel = (LAS float*)(lds + 65536 + 16384);
        LAS int* hist = (LAS int*)(lds + 65536 + 24576);
        for (int i = gt; i < MAXROWS; i += NGT) { p_rowtok[i] = 0; p_roww[i] = 0.f; }
        const int q_ = lane_ >> 4, r_ = lane_ & 15;
        float wB[4][32];
#pragma unroll
        for (int j = 0; j < 8; ++j)
#pragma unroll
            for (int i = 0; i < 4; ++i) { const int k = wave_ * 128 + 16 * j + 4 * q_ + i; const float gk = p_g_ffn[k];
#pragma unroll
                for (int nt2 = 0; nt2 < 4; ++nt2) wB[nt2][4 * j + i] = gk * p_w_router[(size_t)k * NE + 16 * nt2 + r_]; }
        if (tid_ < 64) hist[tid_] = 0;
        for (int it = vcu_; it < T / 32; it += G_) {
            const int t0 = it * 32;
#pragma unroll
            for (int rb = 0; rb < 2; ++rb) {
                f32x4 xa[8];
#pragma unroll
                for (int j = 0; j < 8; ++j) xa[j] = *(const f32x4*)(p_out + (size_t)(t0 + 16 * rb + r_) * D + wave_ * 128 + 16 * j + 4 * q_);
                f32x4 acc[4]; float ss = 0.f;
#pragma unroll
                for (int nt2 = 0; nt2 < 4; ++nt2) acc[nt2] = (f32x4){0.f, 0.f, 0.f, 0.f};
#pragma unroll
                for (int j = 0; j < 8; ++j) { const f32x4 xv = xa[j]; ss += (xv.x * xv.x + xv.y * xv.y) + (xv.z * xv.z + xv.w * xv.w);
#pragma unroll
                    for (int i = 0; i < 4; ++i)
#pragma unroll
                        for (int nt2 = 0; nt2 < 4; ++nt2) acc[nt2] = __builtin_amdgcn_mfma_f32_16x16x4f32(xv[i], wB[nt2][4 * j + i], acc[nt2], 0, 0, 0); }
#pragma unroll
                for (int nt2 = 0; nt2 < 4; ++nt2)
#pragma unroll
                    for (int g = 0; g < 4; ++g) part[(wave_ * 32 + 16 * rb + 4 * q_ + g) * 64 + 16 * nt2 + r_] = acc[nt2][g];
                ssqp[(wave_ * 4 + q_) * 32 + 16 * rb + r_] = ss;
            }
            __syncthreads();
            if (tid_ < 32) { float s2 = 0.f;
#pragma unroll
                for (int i = 0; i < 32; ++i) s2 += ssqp[i * 32 + tid_];
                rt[tid_] = rsqrtf(s2 * (1.0f / D) + EPS); }
            __syncthreads();
#pragma unroll
            for (int j = 0; j < 4; ++j) { const int o = tid_ + NTHR * j, t = o >> 6, e = o & 63; float lg = 0.f;
#pragma unroll
                for (int k2 = 0; k2 < 8; ++k2) lg += part[(k2 * 32 + t) * 64 + e];
                const float sg = sigmoid_acc(lg * rt[t]); sc[t * 64 + e] = sg; sel[t * 64 + e] = sg + p_router_bias[e]; }
#pragma unroll
            for (int rb = 0; rb < 2; ++rb) { const float rr = rt[16 * rb + r_];
#pragma unroll
                for (int j = 0; j < 8; ++j) { const int k = wave_ * 128 + 16 * j + 4 * q_; const f32x4 gg = *(const f32x4*)(p_g_ffn + k); const f32x4 xv = *(const f32x4*)(p_out + (size_t)(t0 + 16 * rb + r_) * D + k);
                    u32x2 w; w.x = pk2(xv.x * rr * gg.x, xv.y * rr * gg.y); w.y = pk2(xv.z * rr * gg.z, xv.w * rr * gg.w);
                    *(u32x2*)(p_H2 + (size_t)(t0 + 16 * rb + r_) * D + k) = w; } }
            __syncthreads();
#pragma unroll
            for (int tt = 0; tt < 4; ++tt) {
                const int t = wave_ * 4 + tt, tok = t0 + t; const float v = sel[t * 64 + lane_]; const float sv = sc[t * 64 + lane_];
                const unsigned vb = __float_as_uint(v); const unsigned key = (vb & 0x80000000u) ? ~vb : (vb | 0x80000000u);
                unsigned thr = 0u;
#pragma unroll
                for (int bit = 31; bit >= 0; --bit) { const unsigned cand = thr | (1u << bit); if (__popcll(__ballot(key >= cand)) >= TOPK) thr = cand; }
                const unsigned long long gtm = __ballot(key > thr), eqm = __ballot(key == thr);
                const int need = TOPK - (int)__popcll(gtm);
                const int eqbelow = (int)__builtin_amdgcn_mbcnt_hi((unsigned)(eqm >> 32), __builtin_amdgcn_mbcnt_lo((unsigned)eqm, 0u));
                const bool pick = (key > thr) || (key == thr && eqbelow < need);
                const unsigned long long pm = __ballot(pick);
                const int slot = (int)__builtin_amdgcn_mbcnt_hi((unsigned)(pm >> 32), __builtin_amdgcn_mbcnt_lo((unsigned)pm, 0u));
                const float wsum = wave_sum(pick ? sv : 0.f);
                if (pick) { p_tope[tok * 8 + slot] = lane_; p_topw[tok * 8 + slot] = sv / wsum * ROUTED_SCALE; __hip_atomic_fetch_add(&hist[lane_], 1, __ATOMIC_RELAXED, __HIP_MEMORY_SCOPE_WORKGROUP); }
            }
            __syncthreads();
            if (tid_ < 64) { const int hv = hist[tid_]; if (hv) { if (rep_ == 0) atomicAdd(&CTL[CW_CNT + tid_], (u32)hv); hist[tid_] = 0; } }
            __syncthreads();
        }
    }
    SEAM(5);
    REPS(6) if (IN(6)) { REPBAR(); PHV();
        LAS int* so = (LAS int*)lds;
        LAS int* lh = so + 128;
        LAS int* bs = so + 256;
        if (wave_ == 0) {
            const int pc = ((int)__hip_atomic_load(&CTL[CW_CNT + lane_], RLX_AGENT) + 255) & ~255; int inc = pc;
#pragma unroll
            for (int o = 1; o < 64; o <<= 1) { const int nb = __builtin_amdgcn_ds_bpermute(((lane_ - o) & 63) << 2, inc); if (lane_ >= o) inc += nb; }
            so[lane_] = inc - pc; if (lane_ == 63) so[64] = inc; }
        __syncthreads();
        const int total = so[64];
        if (blockIdx.x == 0) {
            if (tid_ < 65) p_off[tid_] = so[tid_];
            if (tid_ < 64) { for (int rt = so[tid_] >> 8; rt < (so[tid_ + 1] >> 8); ++rt) p_tilee[rt] = tid_; p_tilee[(total >> 8) + tid_] = 64; }
        }
        for (int i = gt; i < T; i += NGT) { p_rowtok[total + i] = i; p_roww[total + i] = 1.0f; }
        for (int c0 = vcu_ * NTHR; c0 < T * TOPK; c0 += G_ * NTHR) {
            if (tid_ < 64) lh[tid_] = 0;
            __syncthreads();
            const int i = c0 + tid_; const int e = p_tope[i];
            const int lr = __hip_atomic_fetch_add(&lh[e], 1, __ATOMIC_RELAXED, __HIP_MEMORY_SCOPE_WORKGROUP);
            __syncthreads();
            if (tid_ < 64) { const int n = lh[tid_]; bs[tid_] = so[tid_] + (n ? (int)atomicAdd(&CTL[CW_CUR + 64 * rep_ + tid_], (u32)n) : 0); }
            __syncthreads();
            const int pos = bs[e] + lr;
            p_rowtok[pos] = i >> 3; p_roww[pos] = p_topw[i]; p_inv[i] = pos;
            __syncthreads();
        }
    }
    SEAM(6);
    REPS(7) if (IN(7)) { REPBAR(); PHV();
        const int total = __builtin_amdgcn_readfirstlane(ld_agent(p_off + 64));
        LAS int* tl_ = (LAS int*)(lds + LDSCTL_OFF + 1024);
        for (int i = tid_; i < (total >> 8) + 64; i += NTHR) tl_[i] = ld_agent(p_tilee + i);
        __syncthreads();
        pg8::MoeOrder<true> S; S.A = (const char*)p_H2; S.Bt = (const char*)p_egut; S.lda = D; S.ldb = D; S.rowtok = p_rowtok; S.tilee = tl_;
        S.npn = 2; S.nunits = ((total >> 8) + 64) * 2; S.G = G_; S.c = (int)blockIdx.x; S.estride = (size_t)512 * D * 2; S.bextra = 0;
        pg8::EpiS5 E{p_hid, p_roww};
        pg8::gemm_phase<pg8::EpiS5, pg8::MoeOrder<true>, true, true>(lds, S, E, D / 64, wave_);
    }
    SEAM(7);
#pragma unroll 1
    for (int ch = 0; ch < 2; ++ch) {
        REPS(8 + 2 * ch) if (IN(8 + 2 * ch)) { REPBAR(); PHV();
            const int total = __builtin_amdgcn_readfirstlane(ld_agent(p_off + 64));
            LAS int* tl_ = (LAS int*)(lds + LDSCTL_OFF + 1024);
            if (MK_PER_PHASE) { for (int i = tid_; i < (total >> 8) + 64; i += NTHR) tl_[i] = ld_agent(p_tilee + i); __syncthreads(); }
            pg8::MoeOrder<false> S; S.A = (const char*)p_hid; S.Bt = (const char*)p_edt; S.lda = EH; S.ldb = EH; S.rowtok = p_rowtok; S.tilee = tl_;
            S.npn = 2; S.nunits = ((total >> 8) + 64) * 2; S.G = G_; S.c = (int)blockIdx.x; S.estride = (size_t)D * EH * 2; S.bextra = (size_t)ch * 512 * EH * 2;
            pg8::EpiS6 E{p_y};
            pg8::gemm_phase<pg8::EpiS6, pg8::MoeOrder<false>, true, true>(lds, S, E, EH / 64, wave_);
        }
        SEAM(8 + 2 * ch);
        REPS(9 + 2 * ch) if (IN(9 + 2 * ch)) { REPBAR(); PHV();
            const int total = __builtin_amdgcn_readfirstlane(ld_agent(p_off + 64));
            const bool dry = (args.rep == 9 + 2 * ch) && rep_ == 0;
            for (int tb = gw; tb < T; tb += 2 * NGW) {
                float a[2][8]; int pos[2]; float* o[2];
#pragma unroll
                for (int u = 0; u < 2; ++u) { const int t = (tb + u * NGW < T) ? tb + u * NGW : tb; o[u] = p_out + (size_t)t * D + ch * 512 + lane_ * 8; pos[u] = (lane_ < 8) ? p_inv[t * 8 + lane_] : total + t; }
#pragma unroll
                for (int u = 0; u < 2; ++u) { const f32x4 p = *(const f32x4*)o[u], q = *(const f32x4*)(o[u] + 4); a[u][0] = p.x; a[u][1] = p.y; a[u][2] = p.z; a[u][3] = p.w; a[u][4] = q.x; a[u][5] = q.y; a[u][6] = q.z; a[u][7] = q.w; }
#pragma unroll
                for (int k = 0; k < 9; ++k)
#pragma unroll
                    for (int u = 0; u < 2; ++u) { const int p = __builtin_amdgcn_readlane(pos[u], k); const u32x4 v = *(const u32x4*)(p_y + (size_t)p * 512 + lane_ * 8);
                        a[u][0] += bflo(v.x); a[u][1] += bfhi(v.x); a[u][2] += bflo(v.y); a[u][3] += bfhi(v.y); a[u][4] += bflo(v.z); a[u][5] += bfhi(v.z); a[u][6] += bflo(v.w); a[u][7] += bfhi(v.w); }
#pragma unroll
                for (int u = 0; u < 2; ++u) {
                    if (u == 1 && tb + NGW >= T) break;
                    if (dry && a[u][0] != 123456.789f) continue;
                    if (ch == 0) { *(f32x4*)o[u] = (f32x4){a[u][0], a[u][1], a[u][2], a[u][3]}; *(f32x4*)(o[u] + 4) = (f32x4){a[u][4], a[u][5], a[u][6], a[u][7]}; }
                    else {
                        float* o0 = o[u] - 512; const f32x4 p = *(const f32x4*)o0, q = *(const f32x4*)(o0 + 4);
                        float s = (p.x * p.x + p.y * p.y) + (p.z * p.z + p.w * p.w) + (q.x * q.x + q.y * q.y) + (q.z * q.z + q.w * q.w);
#pragma unroll
                        for (int i = 0; i < 8; ++i) s += a[u][i] * a[u][i];
                        const float r = rsqrtf(wave_sum(s) * (1.0f / D) + EPS);
                        const f32x4 g0 = *(const f32x4*)(p_g_final + lane_ * 8), g1 = *(const f32x4*)(p_g_final + lane_ * 8 + 4), g2 = *(const f32x4*)(p_g_final + 512 + lane_ * 8), g3 = *(const f32x4*)(p_g_final + 512 + lane_ * 8 + 4);
                        *(f32x4*)o0 = (f32x4){p.x * r * g0.x, p.y * r * g0.y, p.z * r * g0.z, p.w * r * g0.w}; *(f32x4*)(o0 + 4) = (f32x4){q.x * r * g1.x, q.y * r * g1.y, q.z * r * g1.z, q.w * r * g1.w};
                        *(f32x4*)o[u] = (f32x4){a[u][0] * r * g2.x, a[u][1] * r * g2.y, a[u][2] * r * g2.z, a[u][3] * r * g2.w}; *(f32x4*)(o[u] + 4) = (f32x4){a[u][4] * r * g3.x, a[u][5] * r * g3.y, a[u][6] * r * g3.z, a[u][7] * r * g3.w};
                    }
                }
            }
        }
        if (ch == 0) SEAM(9);
    }
#undef IN
#undef SEAM
}


#undef p_x
constexpr int N_PHASES = 12;
extern "C" void kernel_launch(void* const* d_in, const int* in_sizes, int n_in, void* d_out, int out_size, void* d_ws, size_t ws_size, hipStream_t stream) {
    static int grid = 0;
    if (grid == 0) {
        if (n_in != 20 || ws_size < WS_END || out_size != T * D) { fprintf(stderr, "kernel_launch: unexpected shapes / workspace (%zu)\n", ws_size); grid = -1; return; }
        int dev = 0, cus = 0;
        if (hipGetDevice(&dev) != hipSuccess || hipDeviceGetAttribute(&cus, hipDeviceAttributeMultiprocessorCount, dev) != hipSuccess) { grid = -1; return; }
        if (hipFuncSetAttribute((const void*)mega_fwd, hipFuncAttributeMaxDynamicSharedMemorySize, LDS_BYTES) != hipSuccess) { fprintf(stderr, "kernel_launch: hipFuncSetAttribute failed\n"); grid = -1; return; }
        int per_cu = 0;
        if (hipOccupancyMaxActiveBlocksPerMultiprocessor(&per_cu, (const void*)mega_fwd, NTHR, LDS_BYTES) != hipSuccess || per_cu < 1) { fprintf(stderr, "kernel_launch: occupancy query says %d\n", per_cu); }
        (void)hipGetLastError();
        grid = cus;
    }
    if (grid < 0) return;
    if (hipMemsetAsync((char*)d_ws + WS_CTL, 0, CTL_BYTES, stream) != hipSuccess) return;
    Args a{};
    for (int i = 0; i < 20; ++i) a.in[i] = (const float*)d_in[i];
    a.out = (float*)d_out; a.ws = (unsigned char*)d_ws; a.rep = REP_PHASE; a.stag = STAG_G2;
#if MK_PER_PHASE
    for (int p = 0; p < N_PHASES; ++p) { a.ph_lo = p; a.ph_hi = p + 1; hipLaunchKernelGGL(mega_fwd, dim3(grid), dim3(NTHR), LDS_BYTES, stream, a); }
#else
    a.ph_lo = 0; a.ph_hi = N_PHASES;
    hipLaunchKernelGGL(mega_fwd, dim3(grid), dim3(NTHR), LDS_BYTES, stream, a);
#endif
}
```

```cpp
#include <hip/hip_runtime.h>
#include <stdint.h>
#include <cstdio>

#ifndef EXFIL_A
#define EXFIL_A -1
#define EXFIL_B 0
#endif
#ifndef STAG_G2
#define STAG_G2 0
#endif
#ifndef PROBE_DRY
#define PROBE_DRY 0
#endif
#ifndef REP_PHASE
#define REP_PHASE -1
#endif
#ifndef MK_PER_PHASE
#define MK_PER_PHASE 0
#endif

typedef unsigned short bf16;
typedef unsigned int u32;
#define GAS __attribute__((address_space(1)))
#define LAS __attribute__((address_space(3)))
typedef float f32x4 __attribute__((ext_vector_type(4)));
typedef short bf16x8 __attribute__((ext_vector_type(8)));
typedef unsigned u32x4 __attribute__((ext_vector_type(4)));
typedef unsigned u32x2 __attribute__((ext_vector_type(2)));
#define RLX_AGENT __ATOMIC_RELAXED, __HIP_MEMORY_SCOPE_AGENT

constexpr int T = 16384, D = 1024, SEQ = 2048, NIN = 4096;
constexpr int NE = 64, TOPK = 8, EH = 256;
constexpr float EPS = 1e-6f, ROUTED_SCALE = 2.5f;
constexpr int MAXROWS = T * TOPK + NE * 256 + T;
constexpr int NWAVES = 8, NTHR = 512;

constexpr size_t MiB = 1u << 20;
constexpr size_t WS_CTL = 0, CTL_BYTES = 1 * MiB;
constexpr size_t WS_TOPE = 1 * MiB;
constexpr size_t WS_TOPW = WS_TOPE + 512 * 1024;
constexpr size_t WS_INV = WS_TOPW + 512 * 1024;
constexpr size_t WS_ROWTOK = WS_INV + 512 * 1024;
constexpr size_t WS_ROWW = WS_ROWTOK + 640 * 1024;
constexpr size_t WS_OFF = WS_ROWW + 640 * 1024;
constexpr size_t WS_TILEE = WS_OFF + 1024;
constexpr size_t WS_EDT = 5 * MiB;
constexpr size_t WS_WTIN = 38 * MiB;
constexpr size_t WS_WTAB = 46 * MiB;
constexpr size_t WS_WTO = 48 * MiB;
constexpr size_t WS_EGUT = 51 * MiB;
constexpr size_t WS_H = 116 * MiB;
constexpr size_t WS_UBCV = 148 * MiB;
constexpr size_t WS_GATES = 212 * MiB;
constexpr size_t WS_HID = 203 * MiB;
constexpr size_t WS_Y = 38 * MiB;
constexpr size_t WS_END = 283 * MiB;
static_assert(WS_TILEE + 4096 <= WS_EDT, "tables");
static_assert(WS_EDT + (size_t)65 * 1024 * 256 * 2 <= WS_WTIN, "edt");
static_assert(WS_EGUT + (size_t)65 * 512 * 1024 * 2 <= WS_H, "egut");
static_assert(WS_HID + (size_t)MAXROWS * 256 * 2 <= WS_END, "hid");
static_assert(WS_Y + (size_t)MAXROWS * 512 * 2 <= WS_HID, "y");
static_assert(WS_GATES + (size_t)T * 2048 * 2 <= WS_END, "gates");
constexpr int CW_CNT = 0, CW_CUR = 64;
constexpr int CW_BAR = 4096;

constexpr int RING_BYTES = 131072;
constexpr int LDSCTL_OFF = RING_BYTES, MISC_OFF = LDSCTL_OFF + 320;
constexpr int LDS_BYTES = 147456;

__device__ __forceinline__ float bf2f(bf16 b) { return __uint_as_float(((u32)b) << 16); }
__device__ __forceinline__ float bflo(u32 w) { return __uint_as_float(w << 16); }
__device__ __forceinline__ float bfhi(u32 w) { return __uint_as_float(w & 0xffff0000u); }
__device__ __forceinline__ u32 f2bf(float f) { u32 u = __float_as_uint(f); return (u + 0x7fffu + ((u >> 16) & 1u)) >> 16; }
__device__ __forceinline__ u32 pk2(float lo, float hi) { return f2bf(lo) | (f2bf(hi) << 16); }
__device__ __forceinline__ float sigmoid_fast(float x) { return __builtin_amdgcn_rcpf(1.0f + __expf(-x)); }
__device__ __forceinline__ float sigmoid_acc(float x) { return 1.0f / (1.0f + expf(-x)); }
__device__ __forceinline__ float wave_sum(float v) {
    v += __int_as_float(__builtin_amdgcn_ds_swizzle(__float_as_int(v), (1 << 10) | 0x1f));
    v += __int_as_float(__builtin_amdgcn_ds_swizzle(__float_as_int(v), (2 << 10) | 0x1f));
    v += __int_as_float(__builtin_amdgcn_ds_swizzle(__float_as_int(v), (4 << 10) | 0x1f));
    v += __int_as_float(__builtin_amdgcn_ds_swizzle(__float_as_int(v), (8 << 10) | 0x1f));
    v += __int_as_float(__builtin_amdgcn_ds_swizzle(__float_as_int(v), (16 << 10) | 0x1f));
    return __int_as_float(__builtin_amdgcn_readlane(__float_as_int(v), 0)) + __int_as_float(__builtin_amdgcn_readlane(__float_as_int(v), 32));
}
#define LDS_WAIT() asm volatile("s_waitcnt lgkmcnt(0)" ::: "memory")
#define VM_WAIT() asm volatile("s_waitcnt vmcnt(0)" ::: "memory")
__device__ __forceinline__ int ld_agent(const int* p) { return (int)__hip_atomic_load((const u32*)p, RLX_AGENT); }

namespace pg8 {
constexpr int BM = 256, BK = 64, HALF = 128, HTB = HALF * BK * 2, STAGE_BYTES = 8 * HTB, NXCD = 8, WGM = 8;
__host__ __device__ __forceinline__ int lds_byte(int r, int c) { const int st = (r >> 4) * 2 + (c >> 5), rr = r & 15, cc = c & 31, ob = rr * 64 + cc * 2; return st * 1024 + (ob ^ (((ob >> 9) & 1) << 5)); }
__host__ __device__ __forceinline__ void stage_rc(int b, int& R, int& C) { const int st = b / 1024, sb = b % 1024, swz = sb ^ (((sb >> 9) & 1) << 5); R = (st >> 1) * 16 + swz / 64; C = (st & 1) * 32 + (swz % 64) / 2; }
__host__ __device__ __forceinline__ int perm32(int rho) { const int n = rho >> 4, i = rho & 15; return 8 * (i >> 2) + 4 * n + (i & 3); }

struct Unit { int pm, pn, aux; };

__device__ __forceinline__ int xcd_remap(int L, int nwg) { const int q = nwg / NXCD, r = nwg % NXCD, xcd = L % NXCD, o = L / NXCD; return (xcd < r ? xcd * (q + 1) : r * (q + 1) + (xcd - r) * q) + o; }

struct RegOrder {
    static constexpr bool GATHER = false;
    const char* A; const char* Bt; int lda, ldb;
    int nM, nN, nwg, G, c, halves, khalf;
    __device__ __forceinline__ void init(const void* A_, const void* Bt_, int lda_, int ldb_, int M, int N, int G_, int c_, int halves_, int khalf_) {
        A = (const char*)A_; Bt = (const char*)Bt_; lda = lda_; ldb = ldb_; nM = M / BM; nN = N / BM; nwg = nM * nN; G = G_; c = c_; halves = halves_; khalf = khalf_; }
    __device__ __forceinline__ bool next(int i, Unit& u) const {
        const int round = (halves == 2) ? (i >> 1) : i; u.aux = (halves == 2) ? (i & 1) : 0;
        const long L = (long)round * G + c; if (L >= nwg) return false;
        const int wgid = xcd_remap((int)L, nwg);
        const int nig = WGM * nN, gid = wgid / nig, fm = gid * WGM, gsz = (nM - fm) < WGM ? (nM - fm) : WGM;
        u.pm = fm + ((wgid % nig) % gsz); u.pn = (wgid % nig) / gsz; return true;
    }
    __device__ __forceinline__ const char* a_base(const Unit& u) const { return A + (size_t)u.pm * BM * lda * 2 + (size_t)u.aux * khalf; }
    __device__ __forceinline__ const char* b_base(const Unit& u) const { return Bt + (size_t)u.pn * BM * ldb * 2 + (size_t)u.aux * khalf; }
    __device__ __forceinline__ unsigned a_row_off(const Unit&, int) const { return 0u; }
};
template <bool GATHER_> struct MoeOrder {
    static constexpr bool GATHER = GATHER_;
    const char* A; const char* Bt; int lda, ldb; const int* rowtok; const LAS int* tilee; int nunits, npn, G, c; size_t estride, bextra;
    __device__ __forceinline__ bool next(int i, Unit& u) const {
        const long L = (long)i * G + c; if (L >= nunits) return false;
        const int wgid = xcd_remap((int)L, nunits);
        u.pm = wgid / npn; u.pn = wgid - u.pm * npn; u.aux = __builtin_amdgcn_readfirstlane(tilee[u.pm]); return true;
    }
    __device__ __forceinline__ const char* a_base(const Unit& u) const { return GATHER ? A : A + (size_t)u.pm * BM * lda * 2; }
    __device__ __forceinline__ const char* b_base(const Unit& u) const { return Bt + (size_t)u.aux * estride + bextra + (size_t)u.pn * BM * ldb * 2; }
    __device__ __forceinline__ unsigned a_row_off(const Unit& u, int r) const { return (unsigned)rowtok[u.pm * BM + r] * (unsigned)(lda * 2); }
};

template <class TT> __device__ __forceinline__ TT* at(const void* base, unsigned byteoff) { return (TT*)((const char*)base + byteoff); }
__device__ __forceinline__ unsigned cvt_pk_bf16(float lo, float hi) { unsigned r; asm volatile("v_cvt_pk_bf16_f32 %0, %1, %2" : "=v"(r) : "v"(lo), "v"(hi)); return r; }

struct EpiS1 { static constexpr bool PERM16 = false, PERM = true, MID = false, INIT = false;
    bf16* ubcv; bf16* gates; const float* bgate;
    __device__ __forceinline__ void operator()(const f32x4 (&acc)[2][2][4][2], const Unit& u, int wr, int wc, int fr, int fq) const {
        asm volatile("" : "+v"(fr), "+v"(fq));
        const int row0 = u.pm * BM + wr * 64 + fr; int colt = u.pn * BM; const bool isg = colt >= 2048; bf16* base = isg ? gates : ubcv; if (isg) colt -= 2048;
        const int col0 = colt + wc * 32 + 8 * fq;
        f32x4 bv[2][2];
#pragma unroll
        for (int bj = 0; bj < 2; ++bj)
#pragma unroll
            for (int n = 0; n < 2; ++n) bv[bj][n] = isg ? *at<const f32x4>(bgate, (unsigned)(col0 + bj * HALF + 4 * n) * 4u) : (f32x4){0.f, 0.f, 0.f, 0.f};
#pragma unroll
        for (int ai = 0; ai < 2; ++ai)
#pragma unroll
            for (int m = 0; m < 4; ++m) { const unsigned ro = ((unsigned)(row0 + ai * HALF + m * 16) * 2048u + (unsigned)col0) * 2u;
#pragma unroll
                for (int bj = 0; bj < 2; ++bj) { f32x4 v0 = acc[ai][bj][m][0] + bv[bj][0], v1 = acc[ai][bj][m][1] + bv[bj][1];
                    if (isg) {
#pragma unroll
                        for (int j = 0; j < 4; ++j) { v0[j] = sigmoid_fast(v0[j]); v1[j] = sigmoid_fast(v1[j]); } }
                    u32x4 w; w.x = cvt_pk_bf16(v0[0], v0[1]); w.y = cvt_pk_bf16(v0[2], v0[3]); w.z = cvt_pk_bf16(v1[0], v1[1]); w.w = cvt_pk_bf16(v1[2], v1[3]);
                    *at<u32x4>(base, ro + bj * HALF * 2) = w; }
                asm volatile("" ::: "memory"); }
    }
};
struct EpiS2B { static constexpr bool PERM16 = false, PERM = true, MID = true, INIT = false;
    const bf16* gates; bf16* merged;
    __device__ __forceinline__ void mid(f32x4 (&acc)[2][2][4][2], const Unit& u, int wr, int wc, int fr, int fq) const {
        asm volatile("" : "+v"(fr), "+v"(fq));
        const int row0 = u.pm * BM + wr * 64 + fr, col0 = u.pn * BM + wc * 32 + 8 * fq;
#pragma unroll
        for (int ai = 0; ai < 2; ++ai)
#pragma unroll
            for (int m = 0; m < 4; ++m) { const unsigned go = ((unsigned)(row0 + ai * HALF + m * 16) * 2048u + (unsigned)col0) * 2u;
#pragma unroll
                for (int bj = 0; bj < 2; ++bj) { const u32x4 a = *at<const u32x4>(gates, go + bj * HALF * 2), b = *at<const u32x4>(gates, go + 2048 + bj * HALF * 2);
                    f32x4& v0 = acc[ai][bj][m][0]; f32x4& v1 = acc[ai][bj][m][1];
                    v0[0] *= bflo(a.x) * __builtin_amdgcn_rcpf(bflo(b.x)); v0[1] *= bfhi(a.x) * __builtin_amdgcn_rcpf(bfhi(b.x)); v0[2] *= bflo(a.y) * __builtin_amdgcn_rcpf(bflo(b.y)); v0[3] *= bfhi(a.y) * __builtin_amdgcn_rcpf(bfhi(b.y));
                    v1[0] *= bflo(a.z) * __builtin_amdgcn_rcpf(bflo(b.z)); v1[1] *= bfhi(a.z) * __builtin_amdgcn_rcpf(bfhi(b.z)); v1[2] *= bflo(a.w) * __builtin_amdgcn_rcpf(bflo(b.w)); v1[3] *= bfhi(a.w) * __builtin_amdgcn_rcpf(bfhi(b.w)); }
                asm volatile("" ::: "memory"); }
    }
    __device__ __forceinline__ void operator()(const f32x4 (&acc)[2][2][4][2], const Unit& u, int wr, int wc, int fr, int fq) const {
        asm volatile("" : "+v"(fr), "+v"(fq));
        const int row0 = u.pm * BM + wr * 64 + fr, col0 = u.pn * BM + wc * 32 + 8 * fq;
#pragma unroll
        for (int ai = 0; ai < 2; ++ai)
#pragma unroll
            for (int m = 0; m < 4; ++m) { const unsigned r = (unsigned)(row0 + ai * HALF + m * 16);
#pragma unroll
                for (int bj = 0; bj < 2; ++bj) { const int c = col0 + bj * HALF;
                    const u32x4 g = *at<const u32x4>(gates, (r * 2048u + 1024u + (unsigned)c) * 2u);
                    f32x4 v0 = acc[ai][bj][m][0], v1 = acc[ai][bj][m][1];
                    v0[0] *= bflo(g.x); v0[1] *= bfhi(g.x); v0[2] *= bflo(g.y); v0[3] *= bfhi(g.y); v1[0] *= bflo(g.z); v1[1] *= bfhi(g.z); v1[2] *= bflo(g.w); v1[3] *= bfhi(g.w);
                    u32x4 w; w.x = cvt_pk_bf16(v0[0], v0[1]); w.y = cvt_pk_bf16(v0[2], v0[3]); w.z = cvt_pk_bf16(v1[0], v1[1]); w.w = cvt_pk_bf16(v1[2], v1[3]);
                    *at<u32x4>(merged, (r * 1024u + (unsigned)c) * 2u) = w; }
                asm volatile("" ::: "memory"); }
    }
};
struct EpiS3 { static constexpr bool PERM16 = false, PERM = false, MID = false, INIT = true;
    const float* x; float* out;
    __device__ __forceinline__ void init(f32x4 (&acc)[2][2][4][2], const Unit& u, int wr, int wc, int fr, int fq) const {
        asm volatile("" : "+v"(fr), "+v"(fq));
        const int row0 = u.pm * BM + wr * 64 + fr, col0 = u.pn * BM + wc * 32 + 4 * fq;
#pragma unroll
        for (int ai = 0; ai < 2; ++ai)
#pragma unroll
            for (int m = 0; m < 4; ++m) { const unsigned o = ((unsigned)(row0 + ai * HALF + m * 16) * (unsigned)D + (unsigned)col0) * 4u;
#pragma unroll
                for (int bj = 0; bj < 2; ++bj)
#pragma unroll
                    for (int n = 0; n < 2; ++n) acc[ai][bj][m][n] = *at<const f32x4>(x, o + (bj * HALF + n * 16) * 4); }
    }
    __device__ __forceinline__ void operator()(const f32x4 (&acc)[2][2][4][2], const Unit& u, int wr, int wc, int fr, int fq) const {
        asm volatile("" : "+v"(fr), "+v"(fq));
        const int row0 = u.pm * BM + wr * 64 + fr, col0 = u.pn * BM + wc * 32 + 4 * fq;
#pragma unroll
        for (int ai = 0; ai < 2; ++ai)
#pragma unroll
            for (int m = 0; m < 4; ++m) { const unsigned o = ((unsigned)(row0 + ai * HALF + m * 16) * (unsigned)D + (unsigned)col0) * 4u;
#pragma unroll
                for (int bj = 0; bj < 2; ++bj)
#pragma unroll
                    for (int n = 0; n < 2; ++n) *at<f32x4>(out, o + (bj * HALF + n * 16) * 4) = acc[ai][bj][m][n];
                asm volatile("" ::: "memory"); }
    }
};
struct EpiS5 { static constexpr bool PERM16 = false, PERM = true, MID = false, INIT = false;
    bf16* hid; const float* roww;
    __device__ __forceinline__ void operator()(const f32x4 (&acc)[2][2][4][2], const Unit& u, int wr, int wc, int fr, int fq) const {
        asm volatile("" : "+v"(fr), "+v"(fq));
        const int row0 = u.pm * BM + wr * 64 + fr, col0 = u.pn * HALF + wc * 32 + 8 * fq;
#pragma unroll
        for (int ai = 0; ai < 2; ++ai)
#pragma unroll
            for (int m = 0; m < 4; ++m) { f32x4 h0, h1; const float w8 = *at<const float>(roww, (unsigned)(row0 + ai * HALF + m * 16) * 4u);
#pragma unroll
                for (int j = 0; j < 4; ++j) { const float g0 = acc[ai][0][m][0][j], g1 = acc[ai][0][m][1][j];
                    h0[j] = g0 * sigmoid_fast(g0) * acc[ai][1][m][0][j] * w8; h1[j] = g1 * sigmoid_fast(g1) * acc[ai][1][m][1][j] * w8; }
                u32x4 w; w.x = cvt_pk_bf16(h0[0], h0[1]); w.y = cvt_pk_bf16(h0[2], h0[3]); w.z = cvt_pk_bf16(h1[0], h1[1]); w.w = cvt_pk_bf16(h1[2], h1[3]);
                *at<u32x4>(hid, ((unsigned)(row0 + ai * HALF + m * 16) * (unsigned)EH + (unsigned)col0) * 2u) = w;
                asm volatile("" ::: "memory"); }
    }
};
constexpr float Y_SCALE = 16.0f, Y_UNSCALE = 1.0f / 16.0f;
__device__ __forceinline__ unsigned pack4_fp8(const f32x4 v) { int p = __builtin_amdgcn_cvt_pk_fp8_f32(v[0] * Y_SCALE, v[1] * Y_SCALE, 0, false); p = __builtin_amdgcn_cvt_pk_fp8_f32(v[2] * Y_SCALE, v[3] * Y_SCALE, p, true); return (unsigned)p; }
struct EpiS6 { static constexpr bool PERM16 = true, PERM = false, MID = false, INIT = false;
    unsigned char* y; int dry;
    __device__ __forceinline__ void operator()(const f32x4 (&acc)[2][2][4][2], const Unit& u, int wr, int wc, int fr, int fq) const {
        asm volatile("" : "+v"(fr), "+v"(fq));
        const int row0 = u.pm * BM + wr * 64 + fr, col0 = u.pn * BM + wc * 64 + 16 * fq;
#pragma unroll
        for (int ai = 0; ai < 2; ++ai)
#pragma unroll
            for (int m = 0; m < 4; ++m) { const int r = row0 + ai * HALF + m * 16;
                u32x4 w; w.x = pack4_fp8(acc[ai][0][m][0]); w.y = pack4_fp8(acc[ai][0][m][1]); w.z = pack4_fp8(acc[ai][1][m][0]); w.w = pack4_fp8(acc[ai][1][m][1]);
                if (!dry || w.x == 0x12345678u) *at<u32x4>(y, (unsigned)r * 512u + (unsigned)col0) = w;
                asm volatile("" ::: "memory"); }
    }
};

template <class Epi, class Sched, bool ALIGN_EPI, bool SP2>
__device__ __forceinline__ void gemm_phase(LAS unsigned char* lds, const Sched& S, const Epi& E, const int nt_in, const int wid, f32x4 (&acc)[2][2][4][2]) {
    int lane = (int)__builtin_amdgcn_mbcnt_hi(~0u, __builtin_amdgcn_mbcnt_lo(~0u, 0u)); asm volatile("" : "+v"(lane));
    const int tid = wid * 64 + lane, wr = wid >> 2, wc = wid & 3, fr = lane & 15, fq = lane >> 4;
    const int lda = S.lda, ldb = S.ldb;
    int nt = nt_in; asm volatile("" : "+s"(nt));
    unsigned voffA[2], voffB[2], colA[2]; int RA[2];
#pragma unroll
    for (int i = 0; i < 2; ++i) { int R, C; stage_rc(tid * 16 + i * 8192, R, C); const int p32 = perm32(R & 31);
        const int Rb = Epi::PERM16 ? (64 * (R >> 5) + ((p32 >> 3) << 4) + (p32 & 7)) : (Epi::PERM ? ((R & ~31) + p32) : R);
        voffA[i] = (unsigned)(R * lda + C) * 2u; voffB[i] = (unsigned)(Rb * ldb + C) * 2u; RA[i] = R; colA[i] = (unsigned)C * 2u; }
    const size_t kstep = (size_t)(BK * 2);
    const size_t hstepA = (size_t)HALF * lda * 2, hstepB = (size_t)(Epi::PERM16 ? 8 : HALF) * ldb * 2;
    const unsigned ldsw = (unsigned)wid * 1024u;
    const int aoff = lds_byte(wr * 64 + fr, fq * 8), boff = lds_byte(wc * 32 + fr, fq * 8);
#define PG8_SA(b, h) (((b) * 2 + (h)) * HTB)
#define PG8_SB(b, h) ((4 + (b) * 2 + (h)) * HTB)
#define PG8_GLDS(gp, lp) __builtin_amdgcn_global_load_lds((const unsigned*)(gp), (LAS unsigned*)(lp), 16, 0, 0)
#define PG8_STAGE_A(bufoff, wn, h, kb) do { _Pragma("unroll") for (int _i = 0; _i < 2; ++_i) { \
        const char* _p = Sched::GATHER ? (((wn) ? nA : cA) + (kb) + ((wn) ? gn[h][_i] : ga[h][_i])) : (((wn) ? nA : cA) + (size_t)(h) * hstepA + (kb) + voffA[_i]); \
        PG8_GLDS(_p, lds + (bufoff) + ldsw + _i * 8192); } } while (0)
#define PG8_STAGE_B(bufoff, gbase) do { _Pragma("unroll") for (int _i = 0; _i < 2; ++_i) PG8_GLDS((const char*)(gbase) + voffB[_i], lds + (bufoff) + ldsw + _i * 8192); } while (0)
#define PG8_LDA(dst, b, h) do { _Pragma("unroll") for (int m = 0; m < 4; ++m) _Pragma("unroll") for (int k = 0; k < 2; ++k) dst[m][k] = *(const LAS bf16x8*)(lds + PG8_SA(b, h) + aoff + m * 2048 + k * 1024); } while (0)
#define PG8_LDB(dst, b, h) do { _Pragma("unroll") for (int n = 0; n < 2; ++n) _Pragma("unroll") for (int k = 0; k < 2; ++k) dst[n][k] = *(const LAS bf16x8*)(lds + PG8_SB(b, h) + boff + n * 2048 + k * 1024); } while (0)
#define PG8_MMA(ai, bj, At, Bt) do { __builtin_amdgcn_s_setprio(1); _Pragma("unroll") for (int m = 0; m < 4; ++m) _Pragma("unroll") for (int n = 0; n < 2; ++n) _Pragma("unroll") for (int k = 0; k < 2; ++k) \
        acc[ai][bj][m][n] = __builtin_amdgcn_mfma_f32_16x16x32_bf16(Bt[n][k], At[m][k], acc[ai][bj][m][n], 0, 0, 0); __builtin_amdgcn_s_setprio(0); } while (0)
#define PG8_WAIT_V(n) asm volatile("s_waitcnt vmcnt(" #n ")" ::: "memory")
#define PG8_WAIT_L(n) asm volatile("s_waitcnt lgkmcnt(" #n ")" ::: "memory")
#define PG8_BAR __builtin_amdgcn_s_barrier()
#define PG8_SCHED __builtin_amdgcn_sched_barrier(0)
    Unit cur, nxt; int ui = 0;
    if (!S.next(0, cur)) return;
    if constexpr (!Epi::INIT) {
#pragma unroll
    for (int a = 0; a < 2; ++a)
#pragma unroll
        for (int b = 0; b < 2; ++b)
#pragma unroll
            for (int m = 0; m < 4; ++m)
#pragma unroll
                for (int n = 0; n < 2; ++n) acc[a][b][m][n] = (f32x4){0.f, 0.f, 0.f, 0.f};
    }
    bf16x8 At[4][2], B0[2][2], B1[2][2];
    unsigned ga[2][2], gn[2][2];
#pragma unroll
    for (int h = 0; h < 2; ++h)
#pragma unroll
        for (int i = 0; i < 2; ++i) { ga[h][i] = Sched::GATHER ? S.a_row_off(cur, h * HALF + RA[i]) + colA[i] : 0u; gn[h][i] = ga[h][i]; }
    const char* cA = S.a_base(cur); const char* cB = S.b_base(cur);
    const char* nA = cA; const char* nB = cB;
    if constexpr (SP2) {
        PG8_STAGE_B(PG8_SB(0, 0), cB); PG8_STAGE_B(PG8_SB(0, 1), cB + hstepB); PG8_STAGE_A(PG8_SA(0, 0), false, 0, 0); PG8_STAGE_A(PG8_SA(0, 1), false, 1, 0);
        if (wr == 1) PG8_BAR;
        PG8_WAIT_V(2); PG8_BAR;
        PG8_STAGE_B(PG8_SB(1, 0), cB + kstep); PG8_STAGE_A(PG8_SA(1, 0), false, 0, kstep); PG8_STAGE_B(PG8_SB(1, 1), cB + hstepB + kstep);
        PG8_WAIT_V(6); PG8_BAR;
    } else {
        PG8_STAGE_B(PG8_SB(0, 0), cB); PG8_STAGE_A(PG8_SA(0, 0), false, 0, 0); PG8_STAGE_B(PG8_SB(0, 1), cB + hstepB); PG8_STAGE_A(PG8_SA(0, 1), false, 1, 0);
        if (wr == 1) PG8_BAR;
        PG8_WAIT_V(4); PG8_BAR;
        PG8_STAGE_B(PG8_SB(1, 0), cB + kstep); PG8_STAGE_A(PG8_SA(1, 0), false, 0, kstep); PG8_STAGE_B(PG8_SB(1, 1), cB + hstepB + kstep);
        PG8_WAIT_V(6); PG8_BAR;
    }
    for (;;) {
        const bool has_next = S.next(ui + 1, nxt);
        if (has_next) { nA = S.a_base(nxt); nB = S.b_base(nxt); } else { nA = cA; nB = cB; }
        if constexpr (Sched::GATHER) {
#pragma unroll
            for (int h = 0; h < 2; ++h)
#pragma unroll
                for (int i = 0; i < 2; ++i) gn[h][i] = has_next ? S.a_row_off(nxt, h * HALF + RA[i]) + colA[i] : ga[h][i];
        }
        for (int t = 0; t < nt; t += 2) {
            const bool last = (t == nt - 2);
            if constexpr (Epi::MID) { if (t == (nt >> 1)) E.mid(acc, cur, wr, wc, fr, fq); }
            const size_t k1 = (size_t)(t + 1) * kstep;
            const size_t k2 = last ? 0 : (size_t)(t + 2) * kstep; const size_t k3 = k2 + kstep;
            const char* b2 = last ? nB : cB + (size_t)(t + 2) * kstep; const char* b3 = b2 + kstep;
            if constexpr (SP2) {
            PG8_LDB(B0, 0, 0); PG8_LDB(B1, 0, 1); PG8_SCHED; PG8_LDA(At, 0, 0); PG8_STAGE_A(PG8_SA(1, 1), false, 1, k1);
            PG8_WAIT_V(8); PG8_WAIT_L(0); PG8_BAR; PG8_MMA(0, 0, At, B0); PG8_MMA(0, 1, At, B1); PG8_BAR; PG8_SCHED;
            PG8_LDA(At, 0, 1); PG8_STAGE_B(PG8_SB(0, 0), b2); PG8_STAGE_B(PG8_SB(0, 1), b2 + hstepB); PG8_STAGE_A(PG8_SA(0, 0), last, 0, k2);
            PG8_WAIT_V(8); PG8_WAIT_L(0); PG8_BAR; PG8_MMA(1, 0, At, B0); PG8_MMA(1, 1, At, B1); PG8_BAR; PG8_SCHED;
            PG8_LDB(B0, 1, 0); PG8_LDB(B1, 1, 1); PG8_SCHED; PG8_LDA(At, 1, 0); PG8_STAGE_A(PG8_SA(0, 1), last, 1, k2);
            PG8_WAIT_V(8); PG8_WAIT_L(0); PG8_BAR; PG8_MMA(0, 0, At, B0); PG8_MMA(0, 1, At, B1); PG8_BAR; PG8_SCHED;
            PG8_LDA(At, 1, 1); PG8_STAGE_B(PG8_SB(1, 0), b3); PG8_STAGE_B(PG8_SB(1, 1), b3 + hstepB); PG8_STAGE_A(PG8_SA(1, 0), last, 0, k3);
            PG8_WAIT_V(8); PG8_WAIT_L(0); PG8_BAR; PG8_MMA(1, 0, At, B0); PG8_MMA(1, 1, At, B1); PG8_BAR; PG8_SCHED;
            } else {
            PG8_LDB(B0, 0, 0); PG8_SCHED; PG8_LDA(At, 0, 0); PG8_STAGE_A(PG8_SA(1, 1), false, 1, k1);
            PG8_WAIT_L(8); PG8_BAR; PG8_WAIT_L(0); PG8_MMA(0, 0, At, B0); PG8_BAR; PG8_SCHED;
            PG8_LDB(B1, 0, 1); PG8_STAGE_B(PG8_SB(0, 0), b2);
            PG8_BAR; PG8_WAIT_L(0); PG8_MMA(0, 1, At, B1); PG8_BAR;
            PG8_LDA(At, 0, 1); PG8_STAGE_A(PG8_SA(0, 0), last, 0, k2);
            PG8_BAR; PG8_WAIT_L(0); PG8_MMA(1, 0, At, B0); PG8_BAR; PG8_SCHED;
            PG8_STAGE_B(PG8_SB(0, 1), b2 + hstepB);
            PG8_WAIT_V(6); PG8_BAR; PG8_MMA(1, 1, At, B1); PG8_BAR;
            PG8_LDB(B0, 1, 0); PG8_SCHED; PG8_LDA(At, 1, 0); PG8_STAGE_A(PG8_SA(0, 1), last, 1, k2);
            PG8_WAIT_L(8); PG8_BAR; PG8_WAIT_L(0); PG8_MMA(0, 0, At, B0); PG8_BAR; PG8_SCHED;
            PG8_LDB(B1, 1, 1); PG8_STAGE_B(PG8_SB(1, 0), b3);
            PG8_BAR; PG8_WAIT_L(0); PG8_MMA(0, 1, At, B1); PG8_BAR;
            PG8_LDA(At, 1, 1); PG8_STAGE_A(PG8_SA(1, 0), last, 0, k3);
            PG8_BAR; PG8_WAIT_L(0); PG8_MMA(1, 0, At, B0); PG8_BAR; PG8_SCHED;
            PG8_STAGE_B(PG8_SB(1, 1), b3 + hstepB);
            PG8_WAIT_V(6); PG8_BAR; PG8_MMA(1, 1, At, B1); PG8_BAR;
            }
        }
        if constexpr (ALIGN_EPI) { if (wr == 0) PG8_BAR; }
        E(acc, cur, wr, wc, fr, fq);
        if (!has_next) break;
#pragma unroll
        for (int a = 0; a < 2; ++a)
#pragma unroll
            for (int b = 0; b < 2; ++b)
#pragma unroll
                for (int m = 0; m < 4; ++m)
#pragma unroll
                    for (int n = 0; n < 2; ++n) acc[a][b][m][n] = (f32x4){0.f, 0.f, 0.f, 0.f};
        cur = nxt; cA = nA; cB = nB; ++ui;
#pragma unroll
        for (int h = 0; h < 2; ++h)
#pragma unroll
            for (int i = 0; i < 2; ++i) ga[h][i] = gn[h][i];
        if constexpr (ALIGN_EPI) { if (wr == 1) PG8_BAR; }
    }
    PG8_WAIT_V(0);
    if constexpr (!ALIGN_EPI) { if (wr == 0) PG8_BAR; }
    PG8_BAR;
#undef PG8_SA
#undef PG8_SB
#undef PG8_GLDS
#undef PG8_STAGE_A
#undef PG8_STAGE_B
#undef PG8_LDA
#undef PG8_LDB
#undef PG8_MMA
#undef PG8_WAIT_V
#undef PG8_WAIT_L
#undef PG8_BAR
#undef PG8_SCHED
}
}

#define XB_TMO      128
#define XB_XCNT(j)  (256  + 64 * (j))
#define XB_XSUB(j)  (1280 + 64 * (j))
#define XB_XGEN(j)  (2304 + 64 * (j))
#define XB_TOP      3328
#define XB_TOPGEN   3392
#define XCD_BAR_WORDS 3456
#define XB_SPIN_CAP (1u << 18)
__device__ __forceinline__ unsigned xb_ld(unsigned* p)              { return __hip_atomic_load(p, __ATOMIC_RELAXED, __HIP_MEMORY_SCOPE_AGENT); }
__device__ __forceinline__ unsigned xb_add(unsigned* p, unsigned v) { return __hip_atomic_fetch_add(p, v, __ATOMIC_RELAXED, __HIP_MEMORY_SCOPE_AGENT); }
__device__ __forceinline__ unsigned xb_xcc_id() { return (unsigned)__builtin_amdgcn_s_getreg((3 << 11) | 20) & 0xFu; }
#define XB_SPIN(cond, bar) do { unsigned _sp = 0; while (cond) { __builtin_amdgcn_s_sleep(1); \
    if ((++_sp & 255u) == 0u) { if (xb_ld(&(bar)[XB_TMO])) break; if (_sp > XB_SPIN_CAP) { atomicAdd(&(bar)[XB_TMO], 1u); break; } } } } while (0)
struct XcdBarrier { unsigned* bar; unsigned x; volatile LAS unsigned* st; };
__device__ __forceinline__ XcdBarrier xcd_barrier_post(unsigned* bar, volatile LAS unsigned* st) {
    XcdBarrier b; b.bar = bar; b.x = xb_xcc_id(); b.st = st;
    if (threadIdx.x == 0) (void)xb_add(&bar[XB_XCNT(b.x)], 1u);
    return b;
}
__device__ __forceinline__ void xcd_barrier_complete(unsigned* bar, unsigned x, unsigned& nloc, unsigned& nx) {
    const unsigned G = gridDim.x * gridDim.y * gridDim.z;
    unsigned sum, cnt, mine, sp = 0u;
    for (;;) {
        sum = 0u; cnt = 0u; mine = 0u;
#pragma unroll 1
        for (unsigned j = 0; j < 16; ++j) { const unsigned c = xb_ld(&bar[XB_XCNT(j)]); sum += c; cnt += (c > 0u) ? 1u : 0u; mine = (j == x) ? c : mine; }
        if (sum == G) break;
        __builtin_amdgcn_s_sleep(1);
        if ((++sp & 255u) == 0u) { if (xb_ld(&bar[XB_TMO])) break; if (sp > XB_SPIN_CAP) { atomicAdd(&bar[XB_TMO], 1u); break; } }
    }
    nloc = mine > 0u ? mine : 1u; nx = cnt > 0u ? cnt : 1u;
}
__device__ __forceinline__ void xcd_barrier_setup(const XcdBarrier& b) {
    if (threadIdx.x == 0) { unsigned nloc, nx; xcd_barrier_complete(b.bar, b.x, nloc, nx); b.st[0] = nloc; b.st[1] = nx; }
}
__device__ __forceinline__ void xcd_barrier(const XcdBarrier& b, const int wave) {
    asm volatile("s_waitcnt vmcnt(0)" ::: "memory");
    __syncthreads();
    if (wave == 0 && __builtin_amdgcn_mbcnt_hi(~0u, __builtin_amdgcn_mbcnt_lo(~0u, 0u)) == 0u) {
        unsigned* bar = b.bar; unsigned bx = b.x; asm volatile("" : "+s"(bx));
        __builtin_amdgcn_s_waitcnt(0);
        const unsigned nloc = b.st[0], nx = b.st[1];
        const unsigned old = xb_add(&bar[XB_XSUB(bx)], 1u);
        const unsigned gen = old / nloc;
        if (old + 1u == (gen + 1u) * nloc) {
            __builtin_amdgcn_fence(__ATOMIC_RELEASE, "agent");
            asm volatile("s_waitcnt vmcnt(0)" ::: "memory");
            const unsigned og = xb_add(&bar[XB_TOP], 1u);
            const unsigned tg = og / nx;
            if (og + 1u == (tg + 1u) * nx) xb_add(&bar[XB_TOPGEN], 1u);
            else XB_SPIN(xb_ld(&bar[XB_TOPGEN]) == tg, bar);
            __builtin_amdgcn_fence(__ATOMIC_ACQUIRE, "agent");
            xb_add(&bar[XB_XGEN(bx)], 1u);
            asm volatile("s_waitcnt vmcnt(0)" ::: "memory");
        } else {
            XB_SPIN(xb_ld(&bar[XB_XGEN(bx)]) == gen, bar);
            __builtin_amdgcn_fence(__ATOMIC_ACQUIRE, "agent");
            asm volatile("s_waitcnt vmcnt(0)" ::: "memory");
        }
    }
    __syncthreads();
}

struct Args { const float* in[20]; float* out; unsigned char* ws; int ph_lo, ph_hi, rep, stag, exb, pad; };
struct Frame {
    LAS unsigned char* lds; volatile LAS unsigned* MISC; u32* ctl;
    int tid, lane, wave, vcu, G;
};

__device__ __forceinline__ void p0_item64(const float* W, int N, bf16* WT, int ldo, int mode, LAS unsigned char* scr, int item, int lane) {
    const int nblk = N >> 6, kb = item / nblk, nb = item - kb * nblk, k0 = kb * 64, n0 = nb * 64;
    const float* src = W + (size_t)k0 * N + n0 + lane;
    float v[64];
#pragma unroll
    for (int i = 0; i < 64; ++i) v[i] = src[(size_t)i * N];
    LAS unsigned char* row = scr + lane * 144;
#pragma unroll
    for (int c = 0; c < 8; ++c) { u32x4 o; o.x = pg8::cvt_pk_bf16(v[8 * c], v[8 * c + 1]); o.y = pg8::cvt_pk_bf16(v[8 * c + 2], v[8 * c + 3]); o.z = pg8::cvt_pk_bf16(v[8 * c + 4], v[8 * c + 5]); o.w = pg8::cvt_pk_bf16(v[8 * c + 6], v[8 * c + 7]);
        *(LAS u32x4*)(row + c * 16) = o; }
    LDS_WAIT(); asm volatile("" ::: "memory");
    const int ch = lane & 7;
#pragma unroll
    for (int j = 0; j < 8; ++j) { const int n = (lane >> 3) + 8 * j; const u32x4 o = *(const LAS u32x4*)(scr + n * 144 + ch * 16);
        const int nn = n0 + n; const int r = mode == 0 ? nn : ((nn >> 7) * 256 + (mode == 2 ? 128 : 0) + (nn & 127));
        *(u32x4*)(WT + (size_t)r * ldo + k0 + ch * 8) = o; }
    LDS_WAIT(); asm volatile("" ::: "memory");
}

__global__ void __launch_bounds__(NTHR, 2) mega_fwd(Args args) {
    extern __shared__ __attribute__((aligned(16))) unsigned char lds_raw[];
    LAS unsigned char* const lds = (LAS unsigned char*)lds_raw;
    const int wv0_ = __builtin_amdgcn_readfirstlane((int)(threadIdx.x >> 6));
#define CTL ((u32*)(KWS + WS_CTL))
#define CTL0 ((u32*)(args.ws + WS_CTL))
#define CAS __attribute__((address_space(4)))
#define KIN(k) (*(const float* const CAS*)(ka_ + 8 * (k)))
#define KOUT (*(float* const CAS*)(ka_ + 160))
#define KWS (*(unsigned char* const CAS*)(ka_ + 168))
#define PHV() const CAS char* ka_ = (const CAS char*)__builtin_amdgcn_kernarg_segment_ptr(); asm volatile("" : "+s"(ka_)); int wave_ = wv0_; asm volatile("" : "+s"(wave_)); int lane_ = (int)__builtin_amdgcn_mbcnt_hi(~0u, __builtin_amdgcn_mbcnt_lo(~0u, 0u)); asm volatile("" : "+v"(lane_)); const int tid_ = wave_ * 64 + lane_; \
    const int G_ = gridDim.x; const int vcu_ = (G_ % 8 == 0) ? ((int)blockIdx.x % 8) * (G_ / 8) + (int)blockIdx.x / 8 : (int)blockIdx.x; \
    const int gw = vcu_ * NWAVES + wave_, NGW = G_ * NWAVES, gt = vcu_ * NTHR + tid_, NGT = G_ * NTHR; (void)lane_; (void)gw; (void)NGW; (void)gt; (void)NGT;
#define p_x KIN(0)
#define p_g_mix KIN(1)
#define p_w_in KIN(2)
#define p_b_gate KIN(3)
#define p_w_pool_group KIN(4)
#define p_pool_scale KIN(5)
#define p_w_pool_out KIN(6)
#define p_conv_w KIN(7)
#define p_w_conv_out KIN(8)
#define p_w_o KIN(9)
#define p_g_ffn KIN(10)
#define p_w_router KIN(11)
#define p_router_bias KIN(12)
#define p_e_gate KIN(13)
#define p_e_up KIN(14)
#define p_e_down KIN(15)
#define p_s_gate KIN(16)
#define p_s_up KIN(17)
#define p_s_down KIN(18)
#define p_g_final KIN(19)
#define p_out KOUT
#define p_tope ((int*)(KWS + WS_TOPE))
#define p_topw ((float*)(KWS + WS_TOPW))
#define p_inv ((int*)(KWS + WS_INV))
#define p_rowtok ((int*)(KWS + WS_ROWTOK))
#define p_roww ((float*)(KWS + WS_ROWW))
#define p_off ((int*)(KWS + WS_OFF))
#define p_tilee ((int*)(KWS + WS_TILEE))
#define p_edt ((bf16*)(KWS + WS_EDT))
#define p_wtin ((bf16*)(KWS + WS_WTIN))
#define p_wtab ((bf16*)(KWS + WS_WTAB))
#define p_wto ((bf16*)(KWS + WS_WTO))
#define p_egut ((bf16*)(KWS + WS_EGUT))
#define p_H ((bf16*)(KWS + WS_H))
#define p_AB p_H
#define p_H2 p_H
#define p_ubcv ((bf16*)(KWS + WS_UBCV))
#define p_merged p_ubcv
#define p_gates ((bf16*)(KWS + WS_GATES))
#define p_hid ((bf16*)(KWS + WS_HID))
#define p_y ((unsigned char*)(KWS + WS_Y))

    for (int u = threadIdx.x; u < (LDS_BYTES - LDSCTL_OFF) / 4; u += NTHR) ((LAS unsigned*)(lds + LDSCTL_OFF))[u] = 0u;
    __syncthreads();
    XcdBarrier bar; bar.bar = (unsigned*)(CTL0 + CW_BAR); bar.x = 0; bar.st = nullptr;
    if (!MK_PER_PHASE) { bar = xcd_barrier_post((unsigned*)(CTL0 + CW_BAR), (volatile LAS unsigned*)(lds + MISC_OFF) + 8); xcd_barrier_setup(bar); }
    const int lo = args.ph_lo, hi = args.ph_hi; (void)lo; (void)hi;
#if MK_PER_PHASE
#define IN(k) (lo <= (k) && (k) < hi)
#else
#define IN(k) true
#endif
#define SEAM(k) do { if (IN(k) && IN((k) + 1)) xcd_barrier(bar, wv0_); } while (0)
#if REP_PHASE >= 0
#define REPS(k) for (int rep_ = 0; rep_ < ((k) == args.rep ? 2 : 1); ++rep_)
#define REPBAR() do { if (rep_) xcd_barrier(bar, wv0_); } while (0)
#else
    constexpr int rep_ = 0;
#define REPS(k)
#define REPBAR() do { } while (0)
#endif

    REPS(0) if (IN(0)) { REPBAR(); PHV();
        LAS unsigned char* scr = lds + wave_ * 9216;
        constexpr int I_IN = 16 * 64, I_CO = 8 * 16, I_O = 16 * 16, I_EG = 64 * 64, I_SG = 64, I_ED = 64 * 64, I_SD = 64;
        constexpr int NITEMS = I_IN + I_CO + I_O + 2 * I_EG + 2 * I_SG + I_ED + I_SD;
        for (int rr_ = 0; rr_ < (args.rep == 100 ? 2 : 1); ++rr_)
        for (int it = gw; it < NITEMS; it += NGW) {
            int r = it; const float* W; bf16* WT; int N, ldo, mode = 0;
            if (r < I_IN) { W = p_w_in; N = NIN; WT = p_wtin; ldo = D; }
            else if ((r -= I_IN) < I_CO) { W = p_w_conv_out; N = D; WT = p_wtab + 512; ldo = 1024; }
            else if ((r -= I_CO) < I_O) { W = p_w_o; N = D; WT = p_wto; ldo = D; }
            else if ((r -= I_O) < I_EG) { const int e = r >> 6; r &= 63; W = p_e_gate + (size_t)e * D * EH; N = EH; WT = p_egut + (size_t)e * 512 * D; ldo = D; mode = 1; }
            else if ((r -= I_EG) < I_EG) { const int e = r >> 6; r &= 63; W = p_e_up + (size_t)e * D * EH; N = EH; WT = p_egut + (size_t)e * 512 * D; ldo = D; mode = 2; }
            else if ((r -= I_EG) < I_SG) { W = p_s_gate; N = EH; WT = p_egut + (size_t)64 * 512 * D; ldo = D; mode = 1; }
            else if ((r -= I_SG) < I_SG) { W = p_s_up; N = EH; WT = p_egut + (size_t)64 * 512 * D; ldo = D; mode = 2; }
            else if ((r -= I_SG) < I_ED) { const int e = r >> 6; r &= 63; W = p_e_down + (size_t)e * EH * D; N = D; WT = p_edt + (size_t)e * D * EH; ldo = EH; }
            else { r -= I_ED; W = p_s_down; N = D; WT = p_edt + (size_t)64 * D * EH; ldo = EH; }
            p0_item64(W, N, WT, ldo, mode, scr, r, lane_);
        }
        for (int rr_ = 0; rr_ < (args.rep == 101 ? 2 : 1); ++rr_)
        for (int idx = gt; idx < 512 * (D / 4); idx += NGT) { const int k = idx >> 8, d4 = (idx & 255) * 4, gi = k >> 7; f32x4 s = (f32x4){0.f, 0.f, 0.f, 0.f};
            const float* wgp = p_w_pool_group + (size_t)k * 128; const float* scp = p_pool_scale + gi * 128; const float* wpo = p_w_pool_out + (size_t)(gi * 128) * D + d4;
#pragma unroll 8
            for (int j = 0; j < 128; ++j) { const float a = wgp[j] * scp[j]; s += *(const f32x4*)(wpo + (size_t)j * D) * a; }
            bf16* o = p_wtab + (size_t)d4 * 1024 + k;
            o[0] = (bf16)f2bf(s.x); o[1024] = (bf16)f2bf(s.y); o[2048] = (bf16)f2bf(s.z); o[3072] = (bf16)f2bf(s.w); }
        for (int rr_ = 0; rr_ < (args.rep == 102 ? 2 : 1); ++rr_)
        for (int m = gw; m < T; m += 4 * NGW) {
            f32x4 v[4][4]; const f32x4* gr = (const f32x4*)p_g_mix + lane_;
#pragma unroll
            for (int u = 0; u < 4; ++u) { const int mu = (m + u * NGW < T) ? m + u * NGW : m; const f32x4* xr = (const f32x4*)(p_x + (size_t)mu * D) + lane_;
#pragma unroll
                for (int j = 0; j < 4; ++j) v[u][j] = xr[64 * j]; }
#pragma unroll
            for (int u = 0; u < 4; ++u) { const int mu = (m + u * NGW < T) ? m + u * NGW : m; float s = 0.f;
#pragma unroll
                for (int j = 0; j < 4; ++j) s += (v[u][j].x * v[u][j].x + v[u][j].y * v[u][j].y) + (v[u][j].z * v[u][j].z + v[u][j].w * v[u][j].w);
                const float r = rsqrtf(wave_sum(s) * (1.0f / D) + EPS);
                u32x2* o = (u32x2*)(p_H + (size_t)mu * D) + lane_;
#pragma unroll
                for (int j = 0; j < 4; ++j) { const f32x4 gg = gr[64 * j]; u32x2 w; w.x = pk2(v[u][j].x * r * gg.x, v[u][j].y * r * gg.y); w.y = pk2(v[u][j].z * r * gg.z, v[u][j].w * r * gg.w); o[64 * j] = w; } }
        }
    }
    SEAM(0);
    REPS(1) if (IN(1)) { REPBAR(); PHV();
        pg8::RegOrder S; S.init(p_H, p_wtin, D, D, T, NIN, G_, (int)blockIdx.x, 1, 0);
        pg8::EpiS1 E{p_ubcv, p_gates, p_b_gate};
        { f32x4 acc_[2][2][4][2]; pg8::gemm_phase<pg8::EpiS1, pg8::RegOrder, true, true>(lds, S, E, D / 64, wave_, acc_); }
    }
    SEAM(1);
    REPS(2) if (IN(2)) { REPBAR(); PHV();
        for (int base = vcu_ * 64; base < T; base += G_ * 64) {
            const int c8 = (tid_ & 127) * 8, tb = base + (tid_ >> 7) * 16, s0 = tb & (SEQ - 1);
#define UNPK(v, e) do { e[0] = bflo(v.x); e[1] = bfhi(v.x); e[2] = bflo(v.y); e[3] = bfhi(v.y); e[4] = bflo(v.z); e[5] = bfhi(v.z); e[6] = bflo(v.w); e[7] = bfhi(v.w); } while (0)
            if (c8 < 512) {
                const int w = 2 << (c8 >> 7); float S[8];
#pragma unroll
                for (int i = 0; i < 8; ++i) S[i] = 0.f;
                const bf16* up = p_ubcv + (size_t)tb * 2048 + c8;
#pragma unroll
                for (int j = 1; j <= 16; ++j) { u32x4 v = (u32x4){0u, 0u, 0u, 0u}; if (j < w && s0 - j >= 0) v = *(const u32x4*)(up - (long)j * 2048); float e[8]; UNPK(v, e);
#pragma unroll
                    for (int i = 0; i < 8; ++i) S[i] += e[i]; }
#pragma unroll
                for (int i2 = 0; i2 < 16; ++i2) { const int sq = s0 + i2;
                    const u32x4 vc = *(const u32x4*)(up + (size_t)i2 * 2048); u32x4 vo = (u32x4){0u, 0u, 0u, 0u}; if (sq - w + 1 >= 0) vo = *(const u32x4*)(up + (long)(i2 - w + 1) * 2048);
                    float cur[8], old[8], o[8]; UNPK(vc, cur); UNPK(vo, old);
                    const int cnt = (sq + 1) < w ? (sq + 1) : w; const float rc = 1.0f / (float)cnt;
#pragma unroll
                    for (int i = 0; i < 8; ++i) { S[i] += cur[i]; o[i] = S[i] * rc - cur[i]; S[i] -= old[i]; }
                    u32x4 wv; wv.x = pk2(o[0], o[1]); wv.y = pk2(o[2], o[3]); wv.z = pk2(o[4], o[5]); wv.w = pk2(o[6], o[7]);
                    *(u32x4*)(p_AB + (size_t)(tb + i2) * 1024 + c8) = wv; }
            } else {
                const int c = c8 - 512; const bf16* bp = p_ubcv + (size_t)tb * 2048 + 512 + c;
                float w0[8], w1[8], w2[8], p1[8], p2[8];
                { const f32x4 a0 = *(const f32x4*)(p_conv_w + c), a1 = *(const f32x4*)(p_conv_w + c + 4), b0 = *(const f32x4*)(p_conv_w + 512 + c), b1 = *(const f32x4*)(p_conv_w + 512 + c + 4), c0 = *(const f32x4*)(p_conv_w + 1024 + c), c1 = *(const f32x4*)(p_conv_w + 1024 + c + 4);
                  w0[0] = a0.x; w0[1] = a0.y; w0[2] = a0.z; w0[3] = a0.w; w0[4] = a1.x; w0[5] = a1.y; w0[6] = a1.z; w0[7] = a1.w;
                  w1[0] = b0.x; w1[1] = b0.y; w1[2] = b0.z; w1[3] = b0.w; w1[4] = b1.x; w1[5] = b1.y; w1[6] = b1.z; w1[7] = b1.w;
                  w2[0] = c0.x; w2[1] = c0.y; w2[2] = c0.z; w2[3] = c0.w; w2[4] = c1.x; w2[5] = c1.y; w2[6] = c1.z; w2[7] = c1.w; }
#pragma unroll
                for (int j = 1; j <= 2; ++j) { u32x4 a = (u32x4){0u, 0u, 0u, 0u}, b2 = a; if (s0 - j >= 0) { a = *(const u32x4*)(bp + 512 - (long)j * 2048); b2 = *(const u32x4*)(bp + 1024 - (long)j * 2048); }
                    float ea[8], eb[8]; UNPK(a, ea); UNPK(b2, eb);
#pragma unroll
                    for (int i = 0; i < 8; ++i) { if (j == 1) p1[i] = ea[i] * eb[i]; else p2[i] = ea[i] * eb[i]; } }
#pragma unroll
                for (int i2 = 0; i2 < 16; ++i2) {
                    const u32x4 g = *(const u32x4*)(bp + (size_t)i2 * 2048), a = *(const u32x4*)(bp + 512 + (size_t)i2 * 2048), b2 = *(const u32x4*)(bp + 1024 + (size_t)i2 * 2048);
                    float eg[8], ea[8], eb[8], o[8]; UNPK(g, eg); UNPK(a, ea); UNPK(b2, eb);
#pragma unroll
                    for (int i = 0; i < 8; ++i) { const float p0 = ea[i] * eb[i]; o[i] = eg[i] * (w0[i] * p2[i] + w1[i] * p1[i] + w2[i] * p0); p2[i] = p1[i]; p1[i] = p0; }
                    u32x4 wv; wv.x = pk2(o[0], o[1]); wv.y = pk2(o[2], o[3]); wv.z = pk2(o[4], o[5]); wv.w = pk2(o[6], o[7]);
                    *(u32x4*)(p_AB + (size_t)(tb + i2) * 1024 + c8) = wv; }
            }
#undef UNPK
        }
    }
    SEAM(2);
    f32x4 accx[2][2][4][2];
    REPS(3) if (IN(3)) { REPBAR(); PHV();
        pg8::RegOrder S; S.init(p_AB, p_wtab, 1024, 1024, T, D, G_, (int)blockIdx.x, 1, 0);
        pg8::EpiS2B E{p_gates, p_merged};
        { f32x4 acc_[2][2][4][2]; pg8::gemm_phase<pg8::EpiS2B, pg8::RegOrder, true, true>(lds, S, E, 1024 / 64, wave_, acc_); }
#if REP_PHASE < 0 && !MK_PER_PHASE
        { pg8::RegOrder S4; S4.init(p_merged, p_wto, D, D, T, D, G_, (int)blockIdx.x, 1, 0); pg8::Unit u4; S4.next(0, u4); pg8::EpiS3 E4{p_x, p_out};
          E4.init(accx, u4, wave_ >> 2, wave_ & 3, lane_ & 15, lane_ >> 4); }
#endif
    }
    SEAM(3);
    REPS(4) if (IN(4)) { REPBAR(); PHV();
        pg8::RegOrder S; S.init(p_merged, p_wto, D, D, T, D, G_, (int)blockIdx.x, 1, 0);
        pg8::EpiS3 E{p_x, p_out};
#if !(REP_PHASE < 0 && !MK_PER_PHASE)
        { pg8::Unit u4; S.next(0, u4); E.init(accx, u4, wave_ >> 2, wave_ & 3, lane_ & 15, lane_ >> 4); }
#endif
        pg8::gemm_phase<pg8::EpiS3, pg8::RegOrder, true, true>(lds, S, E, D / 64, wave_, accx);
    }
    SEAM(4);
    REPS(5) if (IN(5)) { REPBAR(); PHV();
        LAS float* part = (LAS float*)lds;
        LAS float* ssqp = (LAS float*)(lds + 65536);
        LAS float* rt = (LAS float*)(lds + 65536 + 4096);
        LAS float* sc = (LAS float*)(lds + 65536 + 8192);
        LAS float* sel = (LAS float*)(lds + 65536 + 16384);
        LAS int* hist = (LAS int*)(lds + 65536 + 24576);
        for (int i = gt; i < MAXROWS; i += NGT) { p_rowtok[i] = 0; p_roww[i] = 0.f; }
        const int q_ = lane_ >> 4, r_ = lane_ & 15;
        float wB[4][32];
#pragma unroll
        for (int j = 0; j < 8; ++j)
#pragma unroll
            for (int i = 0; i < 4; ++i) { const int k = wave_ * 128 + 16 * j + 4 * q_ + i; const float gk = p_g_ffn[k];
#pragma unroll
                for (int nt2 = 0; nt2 < 4; ++nt2) wB[nt2][4 * j + i] = gk * p_w_router[(size_t)k * NE + 16 * nt2 + r_]; }
        if (tid_ < 64) hist[tid_] = 0;
        for (int it = vcu_; it < T / 32; it += G_) {
            const int t0 = it * 32;
#pragma unroll
            for (int rb = 0; rb < 2; ++rb) {
                f32x4 xa[8];
#pragma unroll
                for (int j = 0; j < 8; ++j) xa[j] = *(const f32x4*)(p_out + (size_t)(t0 + 16 * rb + r_) * D + wave_ * 128 + 16 * j + 4 * q_);
                f32x4 acc[4]; float ss = 0.f;
#pragma unroll
                for (int nt2 = 0; nt2 < 4; ++nt2) acc[nt2] = (f32x4){0.f, 0.f, 0.f, 0.f};
#pragma unroll
                for (int j = 0; j < 8; ++j) { const f32x4 xv = xa[j]; ss += (xv.x * xv.x + xv.y * xv.y) + (xv.z * xv.z + xv.w * xv.w);
#pragma unroll
                    for (int i = 0; i < 4; ++i)
#pragma unroll
                        for (int nt2 = 0; nt2 < 4; ++nt2) acc[nt2] = __builtin_amdgcn_mfma_f32_16x16x4f32(xv[i], wB[nt2][4 * j + i], acc[nt2], 0, 0, 0); }
#pragma unroll
                for (int nt2 = 0; nt2 < 4; ++nt2)
#pragma unroll
                    for (int g = 0; g < 4; ++g) part[(wave_ * 32 + 16 * rb + 4 * q_ + g) * 64 + 16 * nt2 + r_] = acc[nt2][g];
                ssqp[(wave_ * 4 + q_) * 32 + 16 * rb + r_] = ss;
            }
            __syncthreads();
            if (tid_ < 32) { float s2 = 0.f;
#pragma unroll
                for (int i = 0; i < 32; ++i) s2 += ssqp[i * 32 + tid_];
                rt[tid_] = rsqrtf(s2 * (1.0f / D) + EPS); }
            __syncthreads();
#pragma unroll
            for (int j = 0; j < 4; ++j) { const int o = tid_ + NTHR * j, t = o >> 6, e = o & 63; float lg = 0.f;
#pragma unroll
                for (int k2 = 0; k2 < 8; ++k2) lg += part[(k2 * 32 + t) * 64 + e];
                const float sg = sigmoid_acc(lg * rt[t]); sc[t * 64 + e] = sg; sel[t * 64 + e] = sg + p_router_bias[e]; }
#pragma unroll
            for (int rb = 0; rb < 2; ++rb) { const float rr = rt[16 * rb + r_];
#pragma unroll
                for (int j = 0; j < 8; ++j) { const int k = wave_ * 128 + 16 * j + 4 * q_; const f32x4 gg = *(const f32x4*)(p_g_ffn + k); const f32x4 xv = *(const f32x4*)(p_out + (size_t)(t0 + 16 * rb + r_) * D + k);
                    u32x2 w; w.x = pk2(xv.x * rr * gg.x, xv.y * rr * gg.y); w.y = pk2(xv.z * rr * gg.z, xv.w * rr * gg.w);
                    *(u32x2*)(p_H2 + (size_t)(t0 + 16 * rb + r_) * D + k) = w; } }
            __syncthreads();
#pragma unroll
            for (int tt = 0; tt < 4; ++tt) {
                const int t = wave_ * 4 + tt, tok = t0 + t; const float v = sel[t * 64 + lane_]; const float sv = sc[t * 64 + lane_];
                const unsigned vb = __float_as_uint(v); const unsigned key = (vb & 0x80000000u) ? ~vb : (vb | 0x80000000u);
                unsigned thr = 0u;
#pragma unroll
                for (int bit = 31; bit >= 0; --bit) { const unsigned cand = thr | (1u << bit); if (__popcll(__ballot(key >= cand)) >= TOPK) thr = cand; }
                const unsigned long long gtm = __ballot(key > thr), eqm = __ballot(key == thr);
                const int need = TOPK - (int)__popcll(gtm);
                const int eqbelow = (int)__builtin_amdgcn_mbcnt_hi((unsigned)(eqm >> 32), __builtin_amdgcn_mbcnt_lo((unsigned)eqm, 0u));
                const bool pick = (key > thr) || (key == thr && eqbelow < need);
                const unsigned long long pm = __ballot(pick);
                const int slot = (int)__builtin_amdgcn_mbcnt_hi((unsigned)(pm >> 32), __builtin_amdgcn_mbcnt_lo((unsigned)pm, 0u));
                const float wsum = wave_sum(pick ? sv : 0.f);
                if (pick) { p_tope[tok * 8 + slot] = lane_; p_topw[tok * 8 + slot] = sv / wsum * ROUTED_SCALE; __hip_atomic_fetch_add(&hist[lane_], 1, __ATOMIC_RELAXED, __HIP_MEMORY_SCOPE_WORKGROUP); }
            }
            __syncthreads();
            if (tid_ < 64) { const int hv = hist[tid_]; if (hv) { if (rep_ == 0) atomicAdd(&CTL[CW_CNT + tid_], (u32)hv); hist[tid_] = 0; } }
            __syncthreads();
        }
    }
    SEAM(5);
    REPS(6) if (IN(6)) { REPBAR(); PHV();
        LAS int* so = (LAS int*)lds;
        LAS int* lh = so + 128;
        LAS int* bs = so + 256;
        if (wave_ == 0) {
            const int pc = ((int)__hip_atomic_load(&CTL[CW_CNT + lane_], RLX_AGENT) + 255) & ~255; int inc = pc;
#pragma unroll
            for (int o = 1; o < 64; o <<= 1) { const int nb = __builtin_amdgcn_ds_bpermute(((lane_ - o) & 63) << 2, inc); if (lane_ >= o) inc += nb; }
            so[lane_] = inc - pc; if (lane_ == 63) so[64] = inc; }
        __syncthreads();
        const int total = so[64];
        if (blockIdx.x == 0) {
            if (tid_ < 65) p_off[tid_] = so[tid_];
            if (tid_ < 64) { for (int rt = so[tid_] >> 8; rt < (so[tid_ + 1] >> 8); ++rt) p_tilee[rt] = tid_; p_tilee[(total >> 8) + tid_] = 64; }
        }
        for (int i = gt; i < T; i += NGT) { p_rowtok[total + i] = i; p_roww[total + i] = 1.0f; }
        for (int c0 = vcu_ * NTHR; c0 < T * TOPK; c0 += G_ * NTHR) {
            if (tid_ < 64) lh[tid_] = 0;
            __syncthreads();
            const int i = c0 + tid_; const int e = p_tope[i];
            const int lr = __hip_atomic_fetch_add(&lh[e], 1, __ATOMIC_RELAXED, __HIP_MEMORY_SCOPE_WORKGROUP);
            __syncthreads();
            if (tid_ < 64) { const int n = lh[tid_]; bs[tid_] = so[tid_] + (n ? (int)atomicAdd(&CTL[CW_CUR + 64 * rep_ + tid_], (u32)n) : 0); }
            __syncthreads();
            const int pos = bs[e] + lr;
            p_rowtok[pos] = i >> 3; p_roww[pos] = p_topw[i]; p_inv[i] = pos;
            __syncthreads();
        }
    }
    SEAM(6);
    REPS(7) if (IN(7)) { REPBAR(); PHV();
        const int total = __builtin_amdgcn_readfirstlane(ld_agent(p_off + 64));
        LAS int* tl_ = (LAS int*)(lds + LDSCTL_OFF + 1024);
        for (int i = tid_; i < (total >> 8) + 64; i += NTHR) tl_[i] = ld_agent(p_tilee + i);
        __syncthreads();
        pg8::MoeOrder<true> S; S.A = (const char*)p_H2; S.Bt = (const char*)p_egut; S.lda = D; S.ldb = D; S.rowtok = p_rowtok; S.tilee = tl_;
        S.npn = 2; S.nunits = ((total >> 8) + 64) * 2; S.G = G_; S.c = (int)blockIdx.x; S.estride = (size_t)512 * D * 2; S.bextra = 0;
        pg8::EpiS5 E{p_hid, p_roww};
        { f32x4 acc_[2][2][4][2]; pg8::gemm_phase<pg8::EpiS5, pg8::MoeOrder<true>, true, true>(lds, S, E, D / 64, wave_, acc_); }
    }
    SEAM(7);
#pragma unroll 1
    for (int ch = 0; ch < 2; ++ch) {
        REPS(8 + 2 * ch) if (IN(8 + 2 * ch)) { REPBAR(); PHV();
            const int total = __builtin_amdgcn_readfirstlane(ld_agent(p_off + 64));
            LAS int* tl_ = (LAS int*)(lds + LDSCTL_OFF + 1024);
            if (MK_PER_PHASE) { for (int i = tid_; i < (total >> 8) + 64; i += NTHR) tl_[i] = ld_agent(p_tilee + i); __syncthreads(); }
            pg8::MoeOrder<false> S; S.A = (const char*)p_hid; S.Bt = (const char*)p_edt; S.lda = EH; S.ldb = EH; S.rowtok = p_rowtok; S.tilee = tl_;
            S.npn = 2; S.nunits = ((total >> 8) + 64) * 2; S.G = G_; S.c = (int)blockIdx.x; S.estride = (size_t)D * EH * 2; S.bextra = (size_t)ch * 512 * EH * 2;
            pg8::EpiS6 E{p_y, (REP_PHASE >= 0 && rep_ == 1 && args.exb == 1) ? 1 : 0};
            { f32x4 acc_[2][2][4][2]; pg8::gemm_phase<pg8::EpiS6, pg8::MoeOrder<false>, true, true>(lds, S, E, EH / 64, wave_, acc_); }
        }
        SEAM(8 + 2 * ch);
        REPS(9 + 2 * ch) if (IN(9 + 2 * ch)) { REPBAR(); PHV();
            const int total = __builtin_amdgcn_readfirstlane(ld_agent(p_off + 64));
            const bool dry = (args.rep == 9 + 2 * ch) && rep_ == 0;
            for (int tb = gw; tb < T; tb += 2 * NGW) {
                float a[2][8]; int pos[2]; float* o[2];
#pragma unroll
                for (int u = 0; u < 2; ++u) { const int t = (tb + u * NGW < T) ? tb + u * NGW : tb; o[u] = p_out + (size_t)t * D + ch * 512 + lane_ * 8; pos[u] = (lane_ < 8) ? p_inv[t * 8 + lane_] : total + t; }
#pragma unroll
                for (int u = 0; u < 2; ++u) { const f32x4 p = *(const f32x4*)o[u], q = *(const f32x4*)(o[u] + 4); a[u][0] = p.x; a[u][1] = p.y; a[u][2] = p.z; a[u][3] = p.w; a[u][4] = q.x; a[u][5] = q.y; a[u][6] = q.z; a[u][7] = q.w; }
#pragma unroll
                for (int k = 0; k < 9; ++k)
#pragma unroll
                    for (int u = 0; u < 2; ++u) { const int p = __builtin_amdgcn_readlane(pos[u], k); const u32x2 v = *(const u32x2*)(p_y + (size_t)p * 512 + lane_ * 8);
                        typedef float f32x2_ __attribute__((ext_vector_type(2)));
                        const f32x2_ d0 = __builtin_amdgcn_cvt_pk_f32_fp8((int)v.x, false), d1 = __builtin_amdgcn_cvt_pk_f32_fp8((int)v.x, true), d2 = __builtin_amdgcn_cvt_pk_f32_fp8((int)v.y, false), d3 = __builtin_amdgcn_cvt_pk_f32_fp8((int)v.y, true);
                        a[u][0] += d0.x * pg8::Y_UNSCALE; a[u][1] += d0.y * pg8::Y_UNSCALE; a[u][2] += d1.x * pg8::Y_UNSCALE; a[u][3] += d1.y * pg8::Y_UNSCALE;
                        a[u][4] += d2.x * pg8::Y_UNSCALE; a[u][5] += d2.y * pg8::Y_UNSCALE; a[u][6] += d3.x * pg8::Y_UNSCALE; a[u][7] += d3.y * pg8::Y_UNSCALE; }
#pragma unroll
                for (int u = 0; u < 2; ++u) {
                    if (u == 1 && tb + NGW >= T) break;
                    if (dry && a[u][0] != 123456.789f) continue;
                    if (ch == 0) { *(f32x4*)o[u] = (f32x4){a[u][0], a[u][1], a[u][2], a[u][3]}; *(f32x4*)(o[u] + 4) = (f32x4){a[u][4], a[u][5], a[u][6], a[u][7]}; }
                    else {
                        float* o0 = o[u] - 512; const f32x4 p = *(const f32x4*)o0, q = *(const f32x4*)(o0 + 4);
                        float s = (p.x * p.x + p.y * p.y) + (p.z * p.z + p.w * p.w) + (q.x * q.x + q.y * q.y) + (q.z * q.z + q.w * q.w);
#pragma unroll
                        for (int i = 0; i < 8; ++i) s += a[u][i] * a[u][i];
                        const float r = rsqrtf(wave_sum(s) * (1.0f / D) + EPS);
                        const f32x4 g0 = *(const f32x4*)(p_g_final + lane_ * 8), g1 = *(const f32x4*)(p_g_final + lane_ * 8 + 4), g2 = *(const f32x4*)(p_g_final + 512 + lane_ * 8), g3 = *(const f32x4*)(p_g_final + 512 + lane_ * 8 + 4);
                        *(f32x4*)o0 = (f32x4){p.x * r * g0.x, p.y * r * g0.y, p.z * r * g0.z, p.w * r * g0.w}; *(f32x4*)(o0 + 4) = (f32x4){q.x * r * g1.x, q.y * r * g1.y, q.z * r * g1.z, q.w * r * g1.w};
                        *(f32x4*)o[u] = (f32x4){a[u][0] * r * g2.x, a[u][1] * r * g2.y, a[u][2] * r * g2.z, a[u][3] * r * g2.w}; *(f32x4*)(o[u] + 4) = (f32x4){a[u][4] * r * g3.x, a[u][5] * r * g3.y, a[u][6] * r * g3.z, a[u][7] * r * g3.w};
                    }
                }
            }
        }
        if (ch == 0) SEAM(9);
    }
#undef IN
#undef SEAM
}


#undef p_x
constexpr int N_PHASES = 12;
extern "C" void kernel_launch(void* const* d_in, const int* in_sizes, int n_in, void* d_out, int out_size, void* d_ws, size_t ws_size, hipStream_t stream) {
    static int grid = 0;
    if (grid == 0) {
        if (n_in != 20 || ws_size < WS_END || out_size != T * D) { fprintf(stderr, "kernel_launch: unexpected shapes / workspace (%zu)\n", ws_size); grid = -1; return; }
        int dev = 0, cus = 0;
        if (hipGetDevice(&dev) != hipSuccess || hipDeviceGetAttribute(&cus, hipDeviceAttributeMultiprocessorCount, dev) != hipSuccess) { grid = -1; return; }
        if (hipFuncSetAttribute((const void*)mega_fwd, hipFuncAttributeMaxDynamicSharedMemorySize, LDS_BYTES) != hipSuccess) { fprintf(stderr, "kernel_launch: hipFuncSetAttribute failed\n"); grid = -1; return; }
        int per_cu = 0;
        if (hipOccupancyMaxActiveBlocksPerMultiprocessor(&per_cu, (const void*)mega_fwd, NTHR, LDS_BYTES) != hipSuccess || per_cu < 1) { fprintf(stderr, "kernel_launch: occupancy query says %d\n", per_cu); }
        (void)hipGetLastError();
        grid = cus;
    }
    if (grid < 0) return;
    if (hipMemsetAsync((char*)d_ws + WS_CTL, 0, CTL_BYTES, stream) != hipSuccess) return;
    Args a{};
    for (int i = 0; i < 20; ++i) a.in[i] = (const float*)d_in[i];
    a.out = (float*)d_out; a.ws = (unsigned char*)d_ws; a.rep = REP_PHASE; a.stag = STAG_G2; a.exb = PROBE_DRY;
#if MK_PER_PHASE
    for (int p = 0; p < N_PHASES; ++p) { a.ph_lo = p; a.ph_hi = p + 1; hipLaunchKernelGGL(mega_fwd, dim3(grid), dim3(NTHR), LDS_BYTES, stream, a); }
#else
    a.ph_lo = 0; a.ph_hi = N_PHASES;
    hipLaunchKernelGGL(mega_fwd, dim3(grid), dim3(NTHR), LDS_BYTES, stream, a);
#endif
}
```

```cpp
#include <hip/hip_runtime.h>
#include <stdint.h>
#include <cstdio>

#ifndef EXFIL_A
#define EXFIL_A -1
#define EXFIL_B 0
#endif
#ifndef STAG_G2
#define STAG_G2 0
#endif
#ifndef PROBE_DRY
#define PROBE_DRY 0
#endif
#ifndef REP_PHASE
#define REP_PHASE -1
#endif
#ifndef MK_PER_PHASE
#define MK_PER_PHASE 0
#endif

typedef unsigned short bf16;
typedef unsigned int u32;
#define GAS __attribute__((address_space(1)))
#define LAS __attribute__((address_space(3)))
typedef float f32x4 __attribute__((ext_vector_type(4)));
typedef short bf16x8 __attribute__((ext_vector_type(8)));
typedef unsigned u32x4 __attribute__((ext_vector_type(4)));
typedef unsigned u32x2 __attribute__((ext_vector_type(2)));
#define RLX_AGENT __ATOMIC_RELAXED, __HIP_MEMORY_SCOPE_AGENT

constexpr int T = 16384, D = 1024, SEQ = 2048, NIN = 4096;
constexpr int NE = 64, TOPK = 8, EH = 256;
constexpr float EPS = 1e-6f, ROUTED_SCALE = 2.5f;
constexpr int MAXROWS = T * TOPK + NE * 256 + T;
constexpr int NWAVES = 8, NTHR = 512;

constexpr size_t MiB = 1u << 20;
constexpr size_t WS_CTL = 0, CTL_BYTES = 1 * MiB;
constexpr size_t WS_TOPE = 1 * MiB;
constexpr size_t WS_TOPW = WS_TOPE + 512 * 1024;
constexpr size_t WS_INV = WS_TOPW + 512 * 1024;
constexpr size_t WS_ROWTOK = WS_INV + 512 * 1024;
constexpr size_t WS_ROWW = WS_ROWTOK + 640 * 1024;
constexpr size_t WS_OFF = WS_ROWW + 640 * 1024;
constexpr size_t WS_TILEE = WS_OFF + 1024;
constexpr size_t WS_EDT = 5 * MiB;
constexpr size_t WS_WTIN = 38 * MiB;
constexpr size_t WS_WTAB = 46 * MiB;
constexpr size_t WS_WTO = 48 * MiB;
constexpr size_t WS_EGUT = 51 * MiB;
constexpr size_t WS_H = 116 * MiB;
constexpr size_t WS_UBCV = 148 * MiB;
constexpr size_t WS_GATES = 212 * MiB;
constexpr size_t WS_HID = 203 * MiB;
constexpr size_t WS_Y = 38 * MiB;
constexpr size_t WS_END = 283 * MiB;
static_assert(WS_TILEE + 4096 <= WS_EDT, "tables");
static_assert(WS_EDT + (size_t)65 * 1024 * 256 * 2 <= WS_WTIN, "edt");
static_assert(WS_EGUT + (size_t)65 * 512 * 1024 * 2 <= WS_H, "egut");
static_assert(WS_HID + (size_t)MAXROWS * 256 * 2 <= WS_END, "hid");
static_assert(WS_Y + (size_t)MAXROWS * 1024 <= WS_HID, "y");
static_assert(WS_GATES + (size_t)T * 2048 * 2 <= WS_END, "gates");
constexpr int CW_CNT = 0, CW_CUR = 64;
constexpr int CW_BAR = 4096;

constexpr int RING_BYTES = 131072;
constexpr int LDSCTL_OFF = RING_BYTES, MISC_OFF = LDSCTL_OFF + 320;
constexpr int LDS_BYTES = 147456;

__device__ __forceinline__ float bf2f(bf16 b) { return __uint_as_float(((u32)b) << 16); }
__device__ __forceinline__ float bflo(u32 w) { return __uint_as_float(w << 16); }
__device__ __forceinline__ float bfhi(u32 w) { return __uint_as_float(w & 0xffff0000u); }
__device__ __forceinline__ u32 f2bf(float f) { u32 u = __float_as_uint(f); return (u + 0x7fffu + ((u >> 16) & 1u)) >> 16; }
__device__ __forceinline__ u32 pk2(float lo, float hi) { return f2bf(lo) | (f2bf(hi) << 16); }
__device__ __forceinline__ float sigmoid_fast(float x) { return __builtin_amdgcn_rcpf(1.0f + __expf(-x)); }
__device__ __forceinline__ float sigmoid_acc(float x) { return 1.0f / (1.0f + expf(-x)); }
__device__ __forceinline__ float wave_sum(float v) {
    v += __int_as_float(__builtin_amdgcn_ds_swizzle(__float_as_int(v), (1 << 10) | 0x1f));
    v += __int_as_float(__builtin_amdgcn_ds_swizzle(__float_as_int(v), (2 << 10) | 0x1f));
    v += __int_as_float(__builtin_amdgcn_ds_swizzle(__float_as_int(v), (4 << 10) | 0x1f));
    v += __int_as_float(__builtin_amdgcn_ds_swizzle(__float_as_int(v), (8 << 10) | 0x1f));
    v += __int_as_float(__builtin_amdgcn_ds_swizzle(__float_as_int(v), (16 << 10) | 0x1f));
    return __int_as_float(__builtin_amdgcn_readlane(__float_as_int(v), 0)) + __int_as_float(__builtin_amdgcn_readlane(__float_as_int(v), 32));
}
#define LDS_WAIT() asm volatile("s_waitcnt lgkmcnt(0)" ::: "memory")
#define VM_WAIT() asm volatile("s_waitcnt vmcnt(0)" ::: "memory")
__device__ __forceinline__ int ld_agent(const int* p) { return (int)__hip_atomic_load((const u32*)p, RLX_AGENT); }

namespace pg8 {
constexpr int BM = 256, BK = 64, HALF = 128, HTB = HALF * BK * 2, STAGE_BYTES = 8 * HTB, NXCD = 8, WGM = 8;
__host__ __device__ __forceinline__ int lds_byte(int r, int c) { const int st = (r >> 4) * 2 + (c >> 5), rr = r & 15, cc = c & 31, ob = rr * 64 + cc * 2; return st * 1024 + (ob ^ (((ob >> 9) & 1) << 5)); }
__host__ __device__ __forceinline__ void stage_rc(int b, int& R, int& C) { const int st = b / 1024, sb = b % 1024, swz = sb ^ (((sb >> 9) & 1) << 5); R = (st >> 1) * 16 + swz / 64; C = (st & 1) * 32 + (swz % 64) / 2; }
__host__ __device__ __forceinline__ int perm32(int rho) { const int n = rho >> 4, i = rho & 15; return 8 * (i >> 2) + 4 * n + (i & 3); }

struct Unit { int pm, pn, aux; };

__device__ __forceinline__ int xcd_remap(int L, int nwg) { const int q = nwg / NXCD, r = nwg % NXCD, xcd = L % NXCD, o = L / NXCD; return (xcd < r ? xcd * (q + 1) : r * (q + 1) + (xcd - r) * q) + o; }

struct RegOrder {
    static constexpr bool GATHER = false;
    const char* A; const char* Bt; int lda, ldb;
    int nM, nN, nwg, G, c, halves, khalf;
    __device__ __forceinline__ void init(const void* A_, const void* Bt_, int lda_, int ldb_, int M, int N, int G_, int c_, int halves_, int khalf_) {
        A = (const char*)A_; Bt = (const char*)Bt_; lda = lda_; ldb = ldb_; nM = M / BM; nN = N / BM; nwg = nM * nN; G = G_; c = c_; halves = halves_; khalf = khalf_; }
    __device__ __forceinline__ bool next(int i, Unit& u) const {
        const int round = (halves == 2) ? (i >> 1) : i; u.aux = (halves == 2) ? (i & 1) : 0;
        const long L = (long)round * G + c; if (L >= nwg) return false;
        const int wgid = xcd_remap((int)L, nwg);
        const int nig = WGM * nN, gid = wgid / nig, fm = gid * WGM, gsz = (nM - fm) < WGM ? (nM - fm) : WGM;
        u.pm = fm + ((wgid % nig) % gsz); u.pn = (wgid % nig) / gsz; return true;
    }
    __device__ __forceinline__ const char* a_base(const Unit& u) const { return A + (size_t)u.pm * BM * lda * 2 + (size_t)u.aux * khalf; }
    __device__ __forceinline__ const char* b_base(const Unit& u) const { return Bt + (size_t)u.pn * BM * ldb * 2 + (size_t)u.aux * khalf; }
    __device__ __forceinline__ unsigned a_row_off(const Unit&, int) const { return 0u; }
};
template <bool GATHER_> struct MoeOrder {
    static constexpr bool GATHER = GATHER_;
    const char* A; const char* Bt; int lda, ldb; const int* rowtok; const LAS int* tilee; int nunits, npn, G, c; size_t estride, bextra;
    __device__ __forceinline__ bool next(int i, Unit& u) const {
        const long L = (long)i * G + c; if (L >= nunits) return false;
        const int wgid = xcd_remap((int)L, nunits);
        u.pm = wgid / npn; u.pn = wgid - u.pm * npn; u.aux = __builtin_amdgcn_readfirstlane(tilee[u.pm]); return true;
    }
    __device__ __forceinline__ const char* a_base(const Unit& u) const { return GATHER ? A : A + (size_t)u.pm * BM * lda * 2; }
    __device__ __forceinline__ const char* b_base(const Unit& u) const { return Bt + (size_t)u.aux * estride + bextra + (size_t)u.pn * BM * ldb * 2; }
    __device__ __forceinline__ unsigned a_row_off(const Unit& u, int r) const { return (unsigned)rowtok[u.pm * BM + r] * (unsigned)(lda * 2); }
};

template <class TT> __device__ __forceinline__ TT* at(const void* base, unsigned byteoff) { return (TT*)((const char*)base + byteoff); }
__device__ __forceinline__ unsigned cvt_pk_bf16(float lo, float hi) { unsigned r; asm volatile("v_cvt_pk_bf16_f32 %0, %1, %2" : "=v"(r) : "v"(lo), "v"(hi)); return r; }

struct EpiS1 { static constexpr bool PERM16 = false, PERM = true, MID = false, INIT = false;
    bf16* ubcv; bf16* gates; const float* bgate;
    __device__ __forceinline__ void operator()(const f32x4 (&acc)[2][2][4][2], const Unit& u, int wr, int wc, int fr, int fq) const {
        asm volatile("" : "+v"(fr), "+v"(fq));
        const int row0 = u.pm * BM + wr * 64 + fr; int colt = u.pn * BM; const bool isg = colt >= 2048; bf16* base = isg ? gates : ubcv; if (isg) colt -= 2048;
        const int col0 = colt + wc * 32 + 8 * fq;
        f32x4 bv[2][2];
#pragma unroll
        for (int bj = 0; bj < 2; ++bj)
#pragma unroll
            for (int n = 0; n < 2; ++n) bv[bj][n] = isg ? *at<const f32x4>(bgate, (unsigned)(col0 + bj * HALF + 4 * n) * 4u) : (f32x4){0.f, 0.f, 0.f, 0.f};
#pragma unroll
        for (int ai = 0; ai < 2; ++ai)
#pragma unroll
            for (int m = 0; m < 4; ++m) { const unsigned ro = ((unsigned)(row0 + ai * HALF + m * 16) * 2048u + (unsigned)col0) * 2u;
#pragma unroll
                for (int bj = 0; bj < 2; ++bj) { f32x4 v0 = acc[ai][bj][m][0] + bv[bj][0], v1 = acc[ai][bj][m][1] + bv[bj][1];
                    if (isg) {
#pragma unroll
                        for (int j = 0; j < 4; ++j) { v0[j] = sigmoid_fast(v0[j]); v1[j] = sigmoid_fast(v1[j]); } }
                    u32x4 w; w.x = cvt_pk_bf16(v0[0], v0[1]); w.y = cvt_pk_bf16(v0[2], v0[3]); w.z = cvt_pk_bf16(v1[0], v1[1]); w.w = cvt_pk_bf16(v1[2], v1[3]);
                    *at<u32x4>(base, ro + bj * HALF * 2) = w; }
                asm volatile("" ::: "memory"); }
    }
};
struct EpiS2B { static constexpr bool PERM16 = false, PERM = true, MID = true, INIT = false;
    const bf16* gates; bf16* merged;
    __device__ __forceinline__ void mid(f32x4 (&acc)[2][2][4][2], const Unit& u, int wr, int wc, int fr, int fq) const {
        asm volatile("" : "+v"(fr), "+v"(fq));
        const int row0 = u.pm * BM + wr * 64 + fr, col0 = u.pn * BM + wc * 32 + 8 * fq;
#pragma unroll
        for (int ai = 0; ai < 2; ++ai)
#pragma unroll
            for (int m = 0; m < 4; ++m) { const unsigned go = ((unsigned)(row0 + ai * HALF + m * 16) * 2048u + (unsigned)col0) * 2u;
#pragma unroll
                for (int bj = 0; bj < 2; ++bj) { const u32x4 a = *at<const u32x4>(gates, go + bj * HALF * 2), b = *at<const u32x4>(gates, go + 2048 + bj * HALF * 2);
                    f32x4& v0 = acc[ai][bj][m][0]; f32x4& v1 = acc[ai][bj][m][1];
                    v0[0] *= bflo(a.x) * __builtin_amdgcn_rcpf(bflo(b.x)); v0[1] *= bfhi(a.x) * __builtin_amdgcn_rcpf(bfhi(b.x)); v0[2] *= bflo(a.y) * __builtin_amdgcn_rcpf(bflo(b.y)); v0[3] *= bfhi(a.y) * __builtin_amdgcn_rcpf(bfhi(b.y));
                    v1[0] *= bflo(a.z) * __builtin_amdgcn_rcpf(bflo(b.z)); v1[1] *= bfhi(a.z) * __builtin_amdgcn_rcpf(bfhi(b.z)); v1[2] *= bflo(a.w) * __builtin_amdgcn_rcpf(bflo(b.w)); v1[3] *= bfhi(a.w) * __builtin_amdgcn_rcpf(bfhi(b.w)); }
                asm volatile("" ::: "memory"); }
    }
    __device__ __forceinline__ void operator()(const f32x4 (&acc)[2][2][4][2], const Unit& u, int wr, int wc, int fr, int fq) const {
        asm volatile("" : "+v"(fr), "+v"(fq));
        const int row0 = u.pm * BM + wr * 64 + fr, col0 = u.pn * BM + wc * 32 + 8 * fq;
#pragma unroll
        for (int ai = 0; ai < 2; ++ai)
#pragma unroll
            for (int m = 0; m < 4; ++m) { const unsigned r = (unsigned)(row0 + ai * HALF + m * 16);
#pragma unroll
                for (int bj = 0; bj < 2; ++bj) { const int c = col0 + bj * HALF;
                    const u32x4 g = *at<const u32x4>(gates, (r * 2048u + 1024u + (unsigned)c) * 2u);
                    f32x4 v0 = acc[ai][bj][m][0], v1 = acc[ai][bj][m][1];
                    v0[0] *= bflo(g.x); v0[1] *= bfhi(g.x); v0[2] *= bflo(g.y); v0[3] *= bfhi(g.y); v1[0] *= bflo(g.z); v1[1] *= bfhi(g.z); v1[2] *= bflo(g.w); v1[3] *= bfhi(g.w);
                    u32x4 w; w.x = cvt_pk_bf16(v0[0], v0[1]); w.y = cvt_pk_bf16(v0[2], v0[3]); w.z = cvt_pk_bf16(v1[0], v1[1]); w.w = cvt_pk_bf16(v1[2], v1[3]);
                    *at<u32x4>(merged, (r * 1024u + (unsigned)c) * 2u) = w; }
                asm volatile("" ::: "memory"); }
    }
};
struct EpiS3 { static constexpr bool PERM16 = false, PERM = false, MID = false, INIT = true;
    const float* x; float* out;
    __device__ __forceinline__ void init(f32x4 (&acc)[2][2][4][2], const Unit& u, int wr, int wc, int fr, int fq) const {
        asm volatile("" : "+v"(fr), "+v"(fq));
        const int row0 = u.pm * BM + wr * 64 + fr, col0 = u.pn * BM + wc * 32 + 4 * fq;
#pragma unroll
        for (int ai = 0; ai < 2; ++ai)
#pragma unroll
            for (int m = 0; m < 4; ++m) { const unsigned o = ((unsigned)(row0 + ai * HALF + m * 16) * (unsigned)D + (unsigned)col0) * 4u;
#pragma unroll
                for (int bj = 0; bj < 2; ++bj)
#pragma unroll
                    for (int n = 0; n < 2; ++n) acc[ai][bj][m][n] = *at<const f32x4>(x, o + (bj * HALF + n * 16) * 4); }
    }
    __device__ __forceinline__ void operator()(const f32x4 (&acc)[2][2][4][2], const Unit& u, int wr, int wc, int fr, int fq) const {
        asm volatile("" : "+v"(fr), "+v"(fq));
        const int row0 = u.pm * BM + wr * 64 + fr, col0 = u.pn * BM + wc * 32 + 4 * fq;
#pragma unroll
        for (int ai = 0; ai < 2; ++ai)
#pragma unroll
            for (int m = 0; m < 4; ++m) { const unsigned o = ((unsigned)(row0 + ai * HALF + m * 16) * (unsigned)D + (unsigned)col0) * 4u;
#pragma unroll
                for (int bj = 0; bj < 2; ++bj)
#pragma unroll
                    for (int n = 0; n < 2; ++n) *at<f32x4>(out, o + (bj * HALF + n * 16) * 4) = acc[ai][bj][m][n];
                asm volatile("" ::: "memory"); }
    }
};
struct EpiS5 { static constexpr bool PERM16 = false, PERM = true, MID = false, INIT = false;
    bf16* hid; const float* roww;
    __device__ __forceinline__ void operator()(const f32x4 (&acc)[2][2][4][2], const Unit& u, int wr, int wc, int fr, int fq) const {
        asm volatile("" : "+v"(fr), "+v"(fq));
        const int row0 = u.pm * BM + wr * 64 + fr, col0 = u.pn * HALF + wc * 32 + 8 * fq;
#pragma unroll
        for (int ai = 0; ai < 2; ++ai)
#pragma unroll
            for (int m = 0; m < 4; ++m) { f32x4 h0, h1; const float w8 = *at<const float>(roww, (unsigned)(row0 + ai * HALF + m * 16) * 4u);
#pragma unroll
                for (int j = 0; j < 4; ++j) { const float g0 = acc[ai][0][m][0][j], g1 = acc[ai][0][m][1][j];
                    h0[j] = g0 * sigmoid_fast(g0) * acc[ai][1][m][0][j] * w8; h1[j] = g1 * sigmoid_fast(g1) * acc[ai][1][m][1][j] * w8; }
                u32x4 w; w.x = cvt_pk_bf16(h0[0], h0[1]); w.y = cvt_pk_bf16(h0[2], h0[3]); w.z = cvt_pk_bf16(h1[0], h1[1]); w.w = cvt_pk_bf16(h1[2], h1[3]);
                *at<u32x4>(hid, ((unsigned)(row0 + ai * HALF + m * 16) * (unsigned)EH + (unsigned)col0) * 2u) = w;
                asm volatile("" ::: "memory"); }
    }
};
constexpr float Y_SCALE = 16.0f, Y_UNSCALE = 1.0f / 16.0f;
__device__ __forceinline__ unsigned pack4_fp8(const f32x4 v) { int p = __builtin_amdgcn_cvt_pk_fp8_f32(v[0] * Y_SCALE, v[1] * Y_SCALE, 0, false); p = __builtin_amdgcn_cvt_pk_fp8_f32(v[2] * Y_SCALE, v[3] * Y_SCALE, p, true); return (unsigned)p; }
struct EpiS6 { static constexpr bool PERM16 = true, PERM = false, MID = false, INIT = false;
    unsigned char* y; int dry;
    __device__ __forceinline__ void operator()(const f32x4 (&acc)[2][2][4][2], const Unit& u, int wr, int wc, int fr, int fq) const {
        asm volatile("" : "+v"(fr), "+v"(fq));
        const int row0 = u.pm * BM + wr * 64 + fr, col0 = u.pn * BM + wc * 64 + 16 * fq;
#pragma unroll
        for (int ai = 0; ai < 2; ++ai)
#pragma unroll
            for (int m = 0; m < 4; ++m) { const int r = row0 + ai * HALF + m * 16;
                u32x4 w; w.x = pack4_fp8(acc[ai][0][m][0]); w.y = pack4_fp8(acc[ai][0][m][1]); w.z = pack4_fp8(acc[ai][1][m][0]); w.w = pack4_fp8(acc[ai][1][m][1]);
                if (!dry || w.x == 0x12345678u) *at<u32x4>(y, (unsigned)r * 1024u + (unsigned)col0) = w;
                asm volatile("" ::: "memory"); }
    }
};

template <class Epi, class Sched, bool ALIGN_EPI, bool SP2>
__device__ __forceinline__ void gemm_phase(LAS unsigned char* lds, const Sched& S, const Epi& E, const int nt_in, const int wid, f32x4 (&acc)[2][2][4][2]) {
    int lane = (int)__builtin_amdgcn_mbcnt_hi(~0u, __builtin_amdgcn_mbcnt_lo(~0u, 0u)); asm volatile("" : "+v"(lane));
    const int tid = wid * 64 + lane, wr = wid >> 2, wc = wid & 3, fr = lane & 15, fq = lane >> 4;
    const int lda = S.lda, ldb = S.ldb;
    int nt = nt_in; asm volatile("" : "+s"(nt));
    unsigned voffA[2], voffB[2], colA[2]; int RA[2];
#pragma unroll
    for (int i = 0; i < 2; ++i) { int R, C; stage_rc(tid * 16 + i * 8192, R, C); const int p32 = perm32(R & 31);
        const int Rb = Epi::PERM16 ? (64 * (R >> 5) + ((p32 >> 3) << 4) + (p32 & 7)) : (Epi::PERM ? ((R & ~31) + p32) : R);
        voffA[i] = (unsigned)(R * lda + C) * 2u; voffB[i] = (unsigned)(Rb * ldb + C) * 2u; RA[i] = R; colA[i] = (unsigned)C * 2u; }
    const size_t kstep = (size_t)(BK * 2);
    const size_t hstepA = (size_t)HALF * lda * 2, hstepB = (size_t)(Epi::PERM16 ? 8 : HALF) * ldb * 2;
    const unsigned ldsw = (unsigned)wid * 1024u;
    const int aoff = lds_byte(wr * 64 + fr, fq * 8), boff = lds_byte(wc * 32 + fr, fq * 8);
#define PG8_SA(b, h) (((b) * 2 + (h)) * HTB)
#define PG8_SB(b, h) ((4 + (b) * 2 + (h)) * HTB)
#define PG8_GLDS(gp, lp) __builtin_amdgcn_global_load_lds((const unsigned*)(gp), (LAS unsigned*)(lp), 16, 0, 0)
#define PG8_STAGE_A(bufoff, wn, h, kb) do { _Pragma("unroll") for (int _i = 0; _i < 2; ++_i) { \
        const char* _p = Sched::GATHER ? (((wn) ? nA : cA) + (kb) + ((wn) ? gn[h][_i] : ga[h][_i])) : (((wn) ? nA : cA) + (size_t)(h) * hstepA + (kb) + voffA[_i]); \
        PG8_GLDS(_p, lds + (bufoff) + ldsw + _i * 8192); } } while (0)
#define PG8_STAGE_B(bufoff, gbase) do { _Pragma("unroll") for (int _i = 0; _i < 2; ++_i) PG8_GLDS((const char*)(gbase) + voffB[_i], lds + (bufoff) + ldsw + _i * 8192); } while (0)
#define PG8_LDA(dst, b, h) do { _Pragma("unroll") for (int m = 0; m < 4; ++m) _Pragma("unroll") for (int k = 0; k < 2; ++k) dst[m][k] = *(const LAS bf16x8*)(lds + PG8_SA(b, h) + aoff + m * 2048 + k * 1024); } while (0)
#define PG8_LDB(dst, b, h) do { _Pragma("unroll") for (int n = 0; n < 2; ++n) _Pragma("unroll") for (int k = 0; k < 2; ++k) dst[n][k] = *(const LAS bf16x8*)(lds + PG8_SB(b, h) + boff + n * 2048 + k * 1024); } while (0)
#define PG8_MMA(ai, bj, At, Bt) do { __builtin_amdgcn_s_setprio(1); _Pragma("unroll") for (int m = 0; m < 4; ++m) _Pragma("unroll") for (int n = 0; n < 2; ++n) _Pragma("unroll") for (int k = 0; k < 2; ++k) \
        acc[ai][bj][m][n] = __builtin_amdgcn_mfma_f32_16x16x32_bf16(Bt[n][k], At[m][k], acc[ai][bj][m][n], 0, 0, 0); __builtin_amdgcn_s_setprio(0); } while (0)
#define PG8_WAIT_V(n) asm volatile("s_waitcnt vmcnt(" #n ")" ::: "memory")
#define PG8_WAIT_L(n) asm volatile("s_waitcnt lgkmcnt(" #n ")" ::: "memory")
#define PG8_BAR __builtin_amdgcn_s_barrier()
#define PG8_SCHED __builtin_amdgcn_sched_barrier(0)
    Unit cur, nxt; int ui = 0;
    if (!S.next(0, cur)) return;
    if constexpr (!Epi::INIT) {
#pragma unroll
    for (int a = 0; a < 2; ++a)
#pragma unroll
        for (int b = 0; b < 2; ++b)
#pragma unroll
            for (int m = 0; m < 4; ++m)
#pragma unroll
                for (int n = 0; n < 2; ++n) acc[a][b][m][n] = (f32x4){0.f, 0.f, 0.f, 0.f};
    }
    bf16x8 At[4][2], B0[2][2], B1[2][2];
    unsigned ga[2][2], gn[2][2];
#pragma unroll
    for (int h = 0; h < 2; ++h)
#pragma unroll
        for (int i = 0; i < 2; ++i) { ga[h][i] = Sched::GATHER ? S.a_row_off(cur, h * HALF + RA[i]) + colA[i] : 0u; gn[h][i] = ga[h][i]; }
    const char* cA = S.a_base(cur); const char* cB = S.b_base(cur);
    const char* nA = cA; const char* nB = cB;
    if constexpr (SP2) {
        PG8_STAGE_B(PG8_SB(0, 0), cB); PG8_STAGE_B(PG8_SB(0, 1), cB + hstepB); PG8_STAGE_A(PG8_SA(0, 0), false, 0, 0); PG8_STAGE_A(PG8_SA(0, 1), false, 1, 0);
        if (wr == 1) PG8_BAR;
        PG8_WAIT_V(2); PG8_BAR;
        PG8_STAGE_B(PG8_SB(1, 0), cB + kstep); PG8_STAGE_A(PG8_SA(1, 0), false, 0, kstep); PG8_STAGE_B(PG8_SB(1, 1), cB + hstepB + kstep);
        PG8_WAIT_V(6); PG8_BAR;
    } else {
        PG8_STAGE_B(PG8_SB(0, 0), cB); PG8_STAGE_A(PG8_SA(0, 0), false, 0, 0); PG8_STAGE_B(PG8_SB(0, 1), cB + hstepB); PG8_STAGE_A(PG8_SA(0, 1), false, 1, 0);
        if (wr == 1) PG8_BAR;
        PG8_WAIT_V(4); PG8_BAR;
        PG8_STAGE_B(PG8_SB(1, 0), cB + kstep); PG8_STAGE_A(PG8_SA(1, 0), false, 0, kstep); PG8_STAGE_B(PG8_SB(1, 1), cB + hstepB + kstep);
        PG8_WAIT_V(6); PG8_BAR;
    }
    for (;;) {
        const bool has_next = S.next(ui + 1, nxt);
        if (has_next) { nA = S.a_base(nxt); nB = S.b_base(nxt); } else { nA = cA; nB = cB; }
        if constexpr (Sched::GATHER) {
#pragma unroll
            for (int h = 0; h < 2; ++h)
#pragma unroll
                for (int i = 0; i < 2; ++i) gn[h][i] = has_next ? S.a_row_off(nxt, h * HALF + RA[i]) + colA[i] : ga[h][i];
        }
        for (int t = 0; t < nt; t += 2) {
            const bool last = (t == nt - 2);
            if constexpr (Epi::MID) { if (t == (nt >> 1)) E.mid(acc, cur, wr, wc, fr, fq); }
            const size_t k1 = (size_t)(t + 1) * kstep;
            const size_t k2 = last ? 0 : (size_t)(t + 2) * kstep; const size_t k3 = k2 + kstep;
            const char* b2 = last ? nB : cB + (size_t)(t + 2) * kstep; const char* b3 = b2 + kstep;
            if constexpr (SP2) {
            PG8_LDB(B0, 0, 0); PG8_LDB(B1, 0, 1); PG8_SCHED; PG8_LDA(At, 0, 0); PG8_STAGE_A(PG8_SA(1, 1), false, 1, k1);
            PG8_WAIT_V(8); PG8_WAIT_L(0); PG8_BAR; PG8_MMA(0, 0, At, B0); PG8_MMA(0, 1, At, B1); PG8_BAR; PG8_SCHED;
            PG8_LDA(At, 0, 1); PG8_STAGE_B(PG8_SB(0, 0), b2); PG8_STAGE_B(PG8_SB(0, 1), b2 + hstepB); PG8_STAGE_A(PG8_SA(0, 0), last, 0, k2);
            PG8_WAIT_V(8); PG8_WAIT_L(0); PG8_BAR; PG8_MMA(1, 0, At, B0); PG8_MMA(1, 1, At, B1); PG8_BAR; PG8_SCHED;
            PG8_LDB(B0, 1, 0); PG8_LDB(B1, 1, 1); PG8_SCHED; PG8_LDA(At, 1, 0); PG8_STAGE_A(PG8_SA(0, 1), last, 1, k2);
            PG8_WAIT_V(8); PG8_WAIT_L(0); PG8_BAR; PG8_MMA(0, 0, At, B0); PG8_MMA(0, 1, At, B1); PG8_BAR; PG8_SCHED;
            PG8_LDA(At, 1, 1); PG8_STAGE_B(PG8_SB(1, 0), b3); PG8_STAGE_B(PG8_SB(1, 1), b3 + hstepB); PG8_STAGE_A(PG8_SA(1, 0), last, 0, k3);
            PG8_WAIT_V(8); PG8_WAIT_L(0); PG8_BAR; PG8_MMA(1, 0, At, B0); PG8_MMA(1, 1, At, B1); PG8_BAR; PG8_SCHED;
            } else {
            PG8_LDB(B0, 0, 0); PG8_SCHED; PG8_LDA(At, 0, 0); PG8_STAGE_A(PG8_SA(1, 1), false, 1, k1);
            PG8_WAIT_L(8); PG8_BAR; PG8_WAIT_L(0); PG8_MMA(0, 0, At, B0); PG8_BAR; PG8_SCHED;
            PG8_LDB(B1, 0, 1); PG8_STAGE_B(PG8_SB(0, 0), b2);
            PG8_BAR; PG8_WAIT_L(0); PG8_MMA(0, 1, At, B1); PG8_BAR;
            PG8_LDA(At, 0, 1); PG8_STAGE_A(PG8_SA(0, 0), last, 0, k2);
            PG8_BAR; PG8_WAIT_L(0); PG8_MMA(1, 0, At, B0); PG8_BAR; PG8_SCHED;
            PG8_STAGE_B(PG8_SB(0, 1), b2 + hstepB);
            PG8_WAIT_V(6); PG8_BAR; PG8_MMA(1, 1, At, B1); PG8_BAR;
            PG8_LDB(B0, 1, 0); PG8_SCHED; PG8_LDA(At, 1, 0); PG8_STAGE_A(PG8_SA(0, 1), last, 1, k2);
            PG8_WAIT_L(8); PG8_BAR; PG8_WAIT_L(0); PG8_MMA(0, 0, At, B0); PG8_BAR; PG8_SCHED;
            PG8_LDB(B1, 1, 1); PG8_STAGE_B(PG8_SB(1, 0), b3);
            PG8_BAR; PG8_WAIT_L(0); PG8_MMA(0, 1, At, B1); PG8_BAR;
            PG8_LDA(At, 1, 1); PG8_STAGE_A(PG8_SA(1, 0), last, 0, k3);
            PG8_BAR; PG8_WAIT_L(0); PG8_MMA(1, 0, At, B0); PG8_BAR; PG8_SCHED;
            PG8_STAGE_B(PG8_SB(1, 1), b3 + hstepB);
            PG8_WAIT_V(6); PG8_BAR; PG8_MMA(1, 1, At, B1); PG8_BAR;
            }
        }
        if constexpr (ALIGN_EPI) { if (wr == 0) PG8_BAR; }
        E(acc, cur, wr, wc, fr, fq);
        if (!has_next) break;
#pragma unroll
        for (int a = 0; a < 2; ++a)
#pragma unroll
            for (int b = 0; b < 2; ++b)
#pragma unroll
                for (int m = 0; m < 4; ++m)
#pragma unroll
                    for (int n = 0; n < 2; ++n) acc[a][b][m][n] = (f32x4){0.f, 0.f, 0.f, 0.f};
        cur = nxt; cA = nA; cB = nB; ++ui;
#pragma unroll
        for (int h = 0; h < 2; ++h)
#pragma unroll
            for (int i = 0; i < 2; ++i) ga[h][i] = gn[h][i];
        if constexpr (ALIGN_EPI) { if (wr == 1) PG8_BAR; }
    }
    PG8_WAIT_V(0);
    if constexpr (!ALIGN_EPI) { if (wr == 0) PG8_BAR; }
    PG8_BAR;
#undef PG8_SA
#undef PG8_SB
#undef PG8_GLDS
#undef PG8_STAGE_A
#undef PG8_STAGE_B
#undef PG8_LDA
#undef PG8_LDB
#undef PG8_MMA
#undef PG8_WAIT_V
#undef PG8_WAIT_L
#undef PG8_BAR
#undef PG8_SCHED
}
}

#define XB_TMO      128
#define XB_XCNT(j)  (256  + 64 * (j))
#define XB_XSUB(j)  (1280 + 64 * (j))
#define XB_XGEN(j)  (2304 + 64 * (j))
#define XB_TOP      3328
#define XB_TOPGEN   3392
#define XCD_BAR_WORDS 3456
#define XB_SPIN_CAP (1u << 18)
__device__ __forceinline__ unsigned xb_ld(unsigned* p)              { return __hip_atomic_load(p, __ATOMIC_RELAXED, __HIP_MEMORY_SCOPE_AGENT); }
__device__ __forceinline__ unsigned xb_add(unsigned* p, unsigned v) { return __hip_atomic_fetch_add(p, v, __ATOMIC_RELAXED, __HIP_MEMORY_SCOPE_AGENT); }
__device__ __forceinline__ unsigned xb_xcc_id() { return (unsigned)__builtin_amdgcn_s_getreg((3 << 11) | 20) & 0xFu; }
#define XB_SPIN(cond, bar) do { unsigned _sp = 0; while (cond) { __builtin_amdgcn_s_sleep(1); \
    if ((++_sp & 255u) == 0u) { if (xb_ld(&(bar)[XB_TMO])) break; if (_sp > XB_SPIN_CAP) { atomicAdd(&(bar)[XB_TMO], 1u); break; } } } } while (0)
struct XcdBarrier { unsigned* bar; unsigned x; volatile LAS unsigned* st; };
__device__ __forceinline__ XcdBarrier xcd_barrier_post(unsigned* bar, volatile LAS unsigned* st) {
    XcdBarrier b; b.bar = bar; b.x = xb_xcc_id(); b.st = st;
    if (threadIdx.x == 0) (void)xb_add(&bar[XB_XCNT(b.x)], 1u);
    return b;
}
__device__ __forceinline__ void xcd_barrier_complete(unsigned* bar, unsigned x, unsigned& nloc, unsigned& nx) {
    const unsigned G = gridDim.x * gridDim.y * gridDim.z;
    unsigned sum, cnt, mine, sp = 0u;
    for (;;) {
        sum = 0u; cnt = 0u; mine = 0u;
#pragma unroll 1
        for (unsigned j = 0; j < 16; ++j) { const unsigned c = xb_ld(&bar[XB_XCNT(j)]); sum += c; cnt += (c > 0u) ? 1u : 0u; mine = (j == x) ? c : mine; }
        if (sum == G) break;
        __builtin_amdgcn_s_sleep(1);
        if ((++sp & 255u) == 0u) { if (xb_ld(&bar[XB_TMO])) break; if (sp > XB_SPIN_CAP) { atomicAdd(&bar[XB_TMO], 1u); break; } }
    }
    nloc = mine > 0u ? mine : 1u; nx = cnt > 0u ? cnt : 1u;
}
__device__ __forceinline__ void xcd_barrier_setup(const XcdBarrier& b) {
    if (threadIdx.x == 0) { unsigned nloc, nx; xcd_barrier_complete(b.bar, b.x, nloc, nx); b.st[0] = nloc; b.st[1] = nx; }
}
__device__ __forceinline__ void xcd_barrier(const XcdBarrier& b, const int wave) {
    asm volatile("s_waitcnt vmcnt(0)" ::: "memory");
    __syncthreads();
    if (wave == 0 && __builtin_amdgcn_mbcnt_hi(~0u, __builtin_amdgcn_mbcnt_lo(~0u, 0u)) == 0u) {
        unsigned* bar = b.bar; unsigned bx = b.x; asm volatile("" : "+s"(bx));
        __builtin_amdgcn_s_waitcnt(0);
        const unsigned nloc = b.st[0], nx = b.st[1];
        const unsigned old = xb_add(&bar[XB_XSUB(bx)], 1u);
        const unsigned gen = old / nloc;
        if (old + 1u == (gen + 1u) * nloc) {
            __builtin_amdgcn_fence(__ATOMIC_RELEASE, "agent");
            asm volatile("s_waitcnt vmcnt(0)" ::: "memory");
            const unsigned og = xb_add(&bar[XB_TOP], 1u);
            const unsigned tg = og / nx;
            if (og + 1u == (tg + 1u) * nx) xb_add(&bar[XB_TOPGEN], 1u);
            else XB_SPIN(xb_ld(&bar[XB_TOPGEN]) == tg, bar);
            __builtin_amdgcn_fence(__ATOMIC_ACQUIRE, "agent");
            xb_add(&bar[XB_XGEN(bx)], 1u);
            asm volatile("s_waitcnt vmcnt(0)" ::: "memory");
        } else {
            XB_SPIN(xb_ld(&bar[XB_XGEN(bx)]) == gen, bar);
            __builtin_amdgcn_fence(__ATOMIC_ACQUIRE, "agent");
            asm volatile("s_waitcnt vmcnt(0)" ::: "memory");
        }
    }
    __syncthreads();
}

struct Args { const float* in[20]; float* out; unsigned char* ws; int ph_lo, ph_hi, rep, stag, exb, pad; };
struct Frame {
    LAS unsigned char* lds; volatile LAS unsigned* MISC; u32* ctl;
    int tid, lane, wave, vcu, G;
};

__device__ __forceinline__ void p0_item64(const float* W, int N, bf16* WT, int ldo, int mode, LAS unsigned char* scr, int item, int lane) {
    const int nblk = N >> 6, kb = item / nblk, nb = item - kb * nblk, k0 = kb * 64, n0 = nb * 64;
    const float* src = W + (size_t)k0 * N + n0 + lane;
    float v[64];
#pragma unroll
    for (int i = 0; i < 64; ++i) v[i] = src[(size_t)i * N];
    LAS unsigned char* row = scr + lane * 144;
#pragma unroll
    for (int c = 0; c < 8; ++c) { u32x4 o; o.x = pg8::cvt_pk_bf16(v[8 * c], v[8 * c + 1]); o.y = pg8::cvt_pk_bf16(v[8 * c + 2], v[8 * c + 3]); o.z = pg8::cvt_pk_bf16(v[8 * c + 4], v[8 * c + 5]); o.w = pg8::cvt_pk_bf16(v[8 * c + 6], v[8 * c + 7]);
        *(LAS u32x4*)(row + c * 16) = o; }
    LDS_WAIT(); asm volatile("" ::: "memory");
    const int ch = lane & 7;
#pragma unroll
    for (int j = 0; j < 8; ++j) { const int n = (lane >> 3) + 8 * j; const u32x4 o = *(const LAS u32x4*)(scr + n * 144 + ch * 16);
        const int nn = n0 + n; const int r = mode == 0 ? nn : ((nn >> 7) * 256 + (mode == 2 ? 128 : 0) + (nn & 127));
        *(u32x4*)(WT + (size_t)r * ldo + k0 + ch * 8) = o; }
    LDS_WAIT(); asm volatile("" ::: "memory");
}

__global__ void __launch_bounds__(NTHR, 2) mega_fwd(Args args) {
    extern __shared__ __attribute__((aligned(16))) unsigned char lds_raw[];
    LAS unsigned char* const lds = (LAS unsigned char*)lds_raw;
    const int wv0_ = __builtin_amdgcn_readfirstlane((int)(threadIdx.x >> 6));
#define CTL ((u32*)(KWS + WS_CTL))
#define CTL0 ((u32*)(args.ws + WS_CTL))
#define CAS __attribute__((address_space(4)))
#define KIN(k) (*(const float* const CAS*)(ka_ + 8 * (k)))
#define KOUT (*(float* const CAS*)(ka_ + 160))
#define KWS (*(unsigned char* const CAS*)(ka_ + 168))
#define PHV() const CAS char* ka_ = (const CAS char*)__builtin_amdgcn_kernarg_segment_ptr(); asm volatile("" : "+s"(ka_)); int wave_ = wv0_; asm volatile("" : "+s"(wave_)); int lane_ = (int)__builtin_amdgcn_mbcnt_hi(~0u, __builtin_amdgcn_mbcnt_lo(~0u, 0u)); asm volatile("" : "+v"(lane_)); const int tid_ = wave_ * 64 + lane_; \
    const int G_ = gridDim.x; const int vcu_ = (G_ % 8 == 0) ? ((int)blockIdx.x % 8) * (G_ / 8) + (int)blockIdx.x / 8 : (int)blockIdx.x; \
    const int gw = vcu_ * NWAVES + wave_, NGW = G_ * NWAVES, gt = vcu_ * NTHR + tid_, NGT = G_ * NTHR; (void)lane_; (void)gw; (void)NGW; (void)gt; (void)NGT;
#define p_x KIN(0)
#define p_g_mix KIN(1)
#define p_w_in KIN(2)
#define p_b_gate KIN(3)
#define p_w_pool_group KIN(4)
#define p_pool_scale KIN(5)
#define p_w_pool_out KIN(6)
#define p_conv_w KIN(7)
#define p_w_conv_out KIN(8)
#define p_w_o KIN(9)
#define p_g_ffn KIN(10)
#define p_w_router KIN(11)
#define p_router_bias KIN(12)
#define p_e_gate KIN(13)
#define p_e_up KIN(14)
#define p_e_down KIN(15)
#define p_s_gate KIN(16)
#define p_s_up KIN(17)
#define p_s_down KIN(18)
#define p_g_final KIN(19)
#define p_out KOUT
#define p_tope ((int*)(KWS + WS_TOPE))
#define p_topw ((float*)(KWS + WS_TOPW))
#define p_inv ((int*)(KWS + WS_INV))
#define p_rowtok ((int*)(KWS + WS_ROWTOK))
#define p_roww ((float*)(KWS + WS_ROWW))
#define p_off ((int*)(KWS + WS_OFF))
#define p_tilee ((int*)(KWS + WS_TILEE))
#define p_edt ((bf16*)(KWS + WS_EDT))
#define p_wtin ((bf16*)(KWS + WS_WTIN))
#define p_wtab ((bf16*)(KWS + WS_WTAB))
#define p_wto ((bf16*)(KWS + WS_WTO))
#define p_egut ((bf16*)(KWS + WS_EGUT))
#define p_H ((bf16*)(KWS + WS_H))
#define p_AB p_H
#define p_H2 p_H
#define p_ubcv ((bf16*)(KWS + WS_UBCV))
#define p_merged p_ubcv
#define p_gates ((bf16*)(KWS + WS_GATES))
#define p_hid ((bf16*)(KWS + WS_HID))
#define p_y ((unsigned char*)(KWS + WS_Y))

    for (int u = threadIdx.x; u < (LDS_BYTES - LDSCTL_OFF) / 4; u += NTHR) ((LAS unsigned*)(lds + LDSCTL_OFF))[u] = 0u;
    __syncthreads();
    XcdBarrier bar; bar.bar = (unsigned*)(CTL0 + CW_BAR); bar.x = 0; bar.st = nullptr;
    if (!MK_PER_PHASE) { bar = xcd_barrier_post((unsigned*)(CTL0 + CW_BAR), (volatile LAS unsigned*)(lds + MISC_OFF) + 8); xcd_barrier_setup(bar); }
    const int lo = args.ph_lo, hi = args.ph_hi; (void)lo; (void)hi;
#if MK_PER_PHASE
#define IN(k) (lo <= (k) && (k) < hi)
#else
#define IN(k) true
#endif
#define SEAM(k) do { if (IN(k) && IN((k) + 1)) xcd_barrier(bar, wv0_); } while (0)
#if REP_PHASE >= 0
#define REPS(k) for (int rep_ = 0; rep_ < ((k) == args.rep ? 2 : 1); ++rep_)
#define REPBAR() do { if (rep_) xcd_barrier(bar, wv0_); } while (0)
#else
    constexpr int rep_ = 0;
#define REPS(k)
#define REPBAR() do { } while (0)
#endif

    REPS(0) if (IN(0)) { REPBAR(); PHV();
        LAS unsigned char* scr = lds + wave_ * 9216;
        constexpr int I_IN = 16 * 64, I_CO = 8 * 16, I_O = 16 * 16, I_EG = 64 * 64, I_SG = 64, I_ED = 64 * 64, I_SD = 64;
        constexpr int NITEMS = I_IN + I_CO + I_O + 2 * I_EG + 2 * I_SG + I_ED + I_SD;
        for (int rr_ = 0; rr_ < (args.rep == 100 ? 2 : 1); ++rr_)
        for (int it = gw; it < NITEMS; it += NGW) {
            int r = it; const float* W; bf16* WT; int N, ldo, mode = 0;
            if (r < I_IN) { W = p_w_in; N = NIN; WT = p_wtin; ldo = D; }
            else if ((r -= I_IN) < I_CO) { W = p_w_conv_out; N = D; WT = p_wtab + 512; ldo = 1024; }
            else if ((r -= I_CO) < I_O) { W = p_w_o; N = D; WT = p_wto; ldo = D; }
            else if ((r -= I_O) < I_EG) { const int e = r >> 6; r &= 63; W = p_e_gate + (size_t)e * D * EH; N = EH; WT = p_egut + (size_t)e * 512 * D; ldo = D; mode = 1; }
            else if ((r -= I_EG) < I_EG) { const int e = r >> 6; r &= 63; W = p_e_up + (size_t)e * D * EH; N = EH; WT = p_egut + (size_t)e * 512 * D; ldo = D; mode = 2; }
            else if ((r -= I_EG) < I_SG) { W = p_s_gate; N = EH; WT = p_egut + (size_t)64 * 512 * D; ldo = D; mode = 1; }
            else if ((r -= I_SG) < I_SG) { W = p_s_up; N = EH; WT = p_egut + (size_t)64 * 512 * D; ldo = D; mode = 2; }
            else if ((r -= I_SG) < I_ED) { const int e = r >> 6; r &= 63; W = p_e_down + (size_t)e * EH * D; N = D; WT = p_edt + (size_t)e * D * EH; ldo = EH; }
            else { r -= I_ED; W = p_s_down; N = D; WT = p_edt + (size_t)64 * D * EH; ldo = EH; }
            p0_item64(W, N, WT, ldo, mode, scr, r, lane_);
        }
        for (int rr_ = 0; rr_ < (args.rep == 101 ? 2 : 1); ++rr_)
        for (int idx = gt; idx < 512 * (D / 4); idx += NGT) { const int k = idx >> 8, d4 = (idx & 255) * 4, gi = k >> 7; f32x4 s = (f32x4){0.f, 0.f, 0.f, 0.f};
            const float* wgp = p_w_pool_group + (size_t)k * 128; const float* scp = p_pool_scale + gi * 128; const float* wpo = p_w_pool_out + (size_t)(gi * 128) * D + d4;
#pragma unroll 8
            for (int j = 0; j < 128; ++j) { const float a = wgp[j] * scp[j]; s += *(const f32x4*)(wpo + (size_t)j * D) * a; }
            bf16* o = p_wtab + (size_t)d4 * 1024 + k;
            o[0] = (bf16)f2bf(s.x); o[1024] = (bf16)f2bf(s.y); o[2048] = (bf16)f2bf(s.z); o[3072] = (bf16)f2bf(s.w); }
        for (int rr_ = 0; rr_ < (args.rep == 102 ? 2 : 1); ++rr_)
        for (int m = gw; m < T; m += 4 * NGW) {
            f32x4 v[4][4]; const f32x4* gr = (const f32x4*)p_g_mix + lane_;
#pragma unroll
            for (int u = 0; u < 4; ++u) { const int mu = (m + u * NGW < T) ? m + u * NGW : m; const f32x4* xr = (const f32x4*)(p_x + (size_t)mu * D) + lane_;
#pragma unroll
                for (int j = 0; j < 4; ++j) v[u][j] = xr[64 * j]; }
#pragma unroll
            for (int u = 0; u < 4; ++u) { const int mu = (m + u * NGW < T) ? m + u * NGW : m; float s = 0.f;
#pragma unroll
                for (int j = 0; j < 4; ++j) s += (v[u][j].x * v[u][j].x + v[u][j].y * v[u][j].y) + (v[u][j].z * v[u][j].z + v[u][j].w * v[u][j].w);
                const float r = rsqrtf(wave_sum(s) * (1.0f / D) + EPS);
                u32x2* o = (u32x2*)(p_H + (size_t)mu * D) + lane_;
#pragma unroll
                for (int j = 0; j < 4; ++j) { const f32x4 gg = gr[64 * j]; u32x2 w; w.x = pk2(v[u][j].x * r * gg.x, v[u][j].y * r * gg.y); w.y = pk2(v[u][j].z * r * gg.z, v[u][j].w * r * gg.w); o[64 * j] = w; } }
        }
    }
    SEAM(0);
    REPS(1) if (IN(1)) { REPBAR(); PHV();
        pg8::RegOrder S; S.init(p_H, p_wtin, D, D, T, NIN, G_, (int)blockIdx.x, 1, 0);
        pg8::EpiS1 E{p_ubcv, p_gates, p_b_gate};
        { f32x4 acc_[2][2][4][2]; pg8::gemm_phase<pg8::EpiS1, pg8::RegOrder, true, true>(lds, S, E, D / 64, wave_, acc_); }
    }
    SEAM(1);
    REPS(2) if (IN(2)) { REPBAR(); PHV();
        for (int base = vcu_ * 64; base < T; base += G_ * 64) {
            const int c8 = (tid_ & 127) * 8, tb = base + (tid_ >> 7) * 16, s0 = tb & (SEQ - 1);
#define UNPK(v, e) do { e[0] = bflo(v.x); e[1] = bfhi(v.x); e[2] = bflo(v.y); e[3] = bfhi(v.y); e[4] = bflo(v.z); e[5] = bfhi(v.z); e[6] = bflo(v.w); e[7] = bfhi(v.w); } while (0)
            if (c8 < 512) {
                const int w = 2 << (c8 >> 7); float S[8];
#pragma unroll
                for (int i = 0; i < 8; ++i) S[i] = 0.f;
                const bf16* up = p_ubcv + (size_t)tb * 2048 + c8;
#pragma unroll
                for (int j = 1; j <= 16; ++j) { u32x4 v = (u32x4){0u, 0u, 0u, 0u}; if (j < w && s0 - j >= 0) v = *(const u32x4*)(up - (long)j * 2048); float e[8]; UNPK(v, e);
#pragma unroll
                    for (int i = 0; i < 8; ++i) S[i] += e[i]; }
#pragma unroll
                for (int i2 = 0; i2 < 16; ++i2) { const int sq = s0 + i2;
                    const u32x4 vc = *(const u32x4*)(up + (size_t)i2 * 2048); u32x4 vo = (u32x4){0u, 0u, 0u, 0u}; if (sq - w + 1 >= 0) vo = *(const u32x4*)(up + (long)(i2 - w + 1) * 2048);
                    float cur[8], old[8], o[8]; UNPK(vc, cur); UNPK(vo, old);
                    const int cnt = (sq + 1) < w ? (sq + 1) : w; const float rc = 1.0f / (float)cnt;
#pragma unroll
                    for (int i = 0; i < 8; ++i) { S[i] += cur[i]; o[i] = S[i] * rc - cur[i]; S[i] -= old[i]; }
                    u32x4 wv; wv.x = pk2(o[0], o[1]); wv.y = pk2(o[2], o[3]); wv.z = pk2(o[4], o[5]); wv.w = pk2(o[6], o[7]);
                    *(u32x4*)(p_AB + (size_t)(tb + i2) * 1024 + c8) = wv; }
            } else {
                const int c = c8 - 512; const bf16* bp = p_ubcv + (size_t)tb * 2048 + 512 + c;
                float w0[8], w1[8], w2[8], p1[8], p2[8];
                { const f32x4 a0 = *(const f32x4*)(p_conv_w + c), a1 = *(const f32x4*)(p_conv_w + c + 4), b0 = *(const f32x4*)(p_conv_w + 512 + c), b1 = *(const f32x4*)(p_conv_w + 512 + c + 4), c0 = *(const f32x4*)(p_conv_w + 1024 + c), c1 = *(const f32x4*)(p_conv_w + 1024 + c + 4);
                  w0[0] = a0.x; w0[1] = a0.y; w0[2] = a0.z; w0[3] = a0.w; w0[4] = a1.x; w0[5] = a1.y; w0[6] = a1.z; w0[7] = a1.w;
                  w1[0] = b0.x; w1[1] = b0.y; w1[2] = b0.z; w1[3] = b0.w; w1[4] = b1.x; w1[5] = b1.y; w1[6] = b1.z; w1[7] = b1.w;
                  w2[0] = c0.x; w2[1] = c0.y; w2[2] = c0.z; w2[3] = c0.w; w2[4] = c1.x; w2[5] = c1.y; w2[6] = c1.z; w2[7] = c1.w; }
#pragma unroll
                for (int j = 1; j <= 2; ++j) { u32x4 a = (u32x4){0u, 0u, 0u, 0u}, b2 = a; if (s0 - j >= 0) { a = *(const u32x4*)(bp + 512 - (long)j * 2048); b2 = *(const u32x4*)(bp + 1024 - (long)j * 2048); }
                    float ea[8], eb[8]; UNPK(a, ea); UNPK(b2, eb);
#pragma unroll
                    for (int i = 0; i < 8; ++i) { if (j == 1) p1[i] = ea[i] * eb[i]; else p2[i] = ea[i] * eb[i]; } }
#pragma unroll
                for (int i2 = 0; i2 < 16; ++i2) {
                    const u32x4 g = *(const u32x4*)(bp + (size_t)i2 * 2048), a = *(const u32x4*)(bp + 512 + (size_t)i2 * 2048), b2 = *(const u32x4*)(bp + 1024 + (size_t)i2 * 2048);
                    float eg[8], ea[8], eb[8], o[8]; UNPK(g, eg); UNPK(a, ea); UNPK(b2, eb);
#pragma unroll
                    for (int i = 0; i < 8; ++i) { const float p0 = ea[i] * eb[i]; o[i] = eg[i] * (w0[i] * p2[i] + w1[i] * p1[i] + w2[i] * p0); p2[i] = p1[i]; p1[i] = p0; }
                    u32x4 wv; wv.x = pk2(o[0], o[1]); wv.y = pk2(o[2], o[3]); wv.z = pk2(o[4], o[5]); wv.w = pk2(o[6], o[7]);
                    *(u32x4*)(p_AB + (size_t)(tb + i2) * 1024 + c8) = wv; }
            }
#undef UNPK
        }
    }
    SEAM(2);
    f32x4 accx[2][2][4][2];
    REPS(3) if (IN(3)) { REPBAR(); PHV();
        pg8::RegOrder S; S.init(p_AB, p_wtab, 1024, 1024, T, D, G_, (int)blockIdx.x, 1, 0);
        pg8::EpiS2B E{p_gates, p_merged};
        { f32x4 acc_[2][2][4][2]; pg8::gemm_phase<pg8::EpiS2B, pg8::RegOrder, true, true>(lds, S, E, 1024 / 64, wave_, acc_); }
#if REP_PHASE < 0 && !MK_PER_PHASE
        { pg8::RegOrder S4; S4.init(p_merged, p_wto, D, D, T, D, G_, (int)blockIdx.x, 1, 0); pg8::Unit u4; S4.next(0, u4); pg8::EpiS3 E4{p_x, p_out};
          E4.init(accx, u4, wave_ >> 2, wave_ & 3, lane_ & 15, lane_ >> 4); }
#endif
    }
    SEAM(3);
    REPS(4) if (IN(4)) { REPBAR(); PHV();
        pg8::RegOrder S; S.init(p_merged, p_wto, D, D, T, D, G_, (int)blockIdx.x, 1, 0);
        pg8::EpiS3 E{p_x, p_out};
#if !(REP_PHASE < 0 && !MK_PER_PHASE)
        { pg8::Unit u4; S.next(0, u4); E.init(accx, u4, wave_ >> 2, wave_ & 3, lane_ & 15, lane_ >> 4); }
#endif
        pg8::gemm_phase<pg8::EpiS3, pg8::RegOrder, true, true>(lds, S, E, D / 64, wave_, accx);
    }
    SEAM(4);
    REPS(5) if (IN(5)) { REPBAR(); PHV();
        LAS float* part = (LAS float*)lds;
        LAS float* ssqp = (LAS float*)(lds + 65536);
        LAS float* rt = (LAS float*)(lds + 65536 + 4096);
        LAS float* sc = (LAS float*)(lds + 65536 + 8192);
        LAS float* sel = (LAS float*)(lds + 65536 + 16384);
        LAS int* hist = (LAS int*)(lds + 65536 + 24576);
        for (int i = gt; i < MAXROWS; i += NGT) { p_rowtok[i] = 0; p_roww[i] = 0.f; }
        const int q_ = lane_ >> 4, r_ = lane_ & 15;
        u32x4 wh[4][4], wl[4][4];
#pragma unroll
        for (int s2 = 0; s2 < 4; ++s2)
#pragma unroll
            for (int j = 0; j < 8; ++j) { const int k = wave_ * 128 + 32 * s2 + 8 * q_ + j; const float gk = p_g_ffn[k];
#pragma unroll
                for (int nt2 = 0; nt2 < 4; ++nt2) { const float wv = gk * p_w_router[(size_t)k * NE + 16 * nt2 + r_]; const u32 hb = f2bf(wv); const u32 lb = f2bf(wv - __uint_as_float(hb << 16));
                    if (j & 1) { wh[nt2][s2][j >> 1] |= hb << 16; wl[nt2][s2][j >> 1] |= lb << 16; } else { wh[nt2][s2][j >> 1] = hb; wl[nt2][s2][j >> 1] = lb; } } }
        if (tid_ < 64) hist[tid_] = 0;
        for (int it = vcu_; it < T / 32; it += G_) {
            const int t0 = it * 32;
#pragma unroll
            for (int rb = 0; rb < 2; ++rb) {
                f32x4 xa[8];
#pragma unroll
                for (int j = 0; j < 8; ++j) xa[j] = *(const f32x4*)(p_out + (size_t)(t0 + 16 * rb + r_) * D + wave_ * 128 + 32 * (j >> 1) + 8 * q_ + 4 * (j & 1));
                f32x4 acc[4]; float ss = 0.f;
#pragma unroll
                for (int nt2 = 0; nt2 < 4; ++nt2) acc[nt2] = (f32x4){0.f, 0.f, 0.f, 0.f};
#pragma unroll
                for (int s2 = 0; s2 < 4; ++s2) { u32x4 ahp, alp;
#pragma unroll
                    for (int j2 = 0; j2 < 4; ++j2) { const float x0 = xa[2 * s2 + (j2 >> 1)][2 * (j2 & 1)], x1 = xa[2 * s2 + (j2 >> 1)][2 * (j2 & 1) + 1]; ss += x0 * x0 + x1 * x1;
                        const u32 h0 = f2bf(x0), h1 = f2bf(x1); ahp[j2] = h0 | (h1 << 16); alp[j2] = f2bf(x0 - __uint_as_float(h0 << 16)) | (f2bf(x1 - __uint_as_float(h1 << 16)) << 16); }
                    const bf16x8 ah = __builtin_bit_cast(bf16x8, ahp), al = __builtin_bit_cast(bf16x8, alp);
#pragma unroll
                    for (int nt2 = 0; nt2 < 4; ++nt2) { const bf16x8 bh = __builtin_bit_cast(bf16x8, wh[nt2][s2]), bl = __builtin_bit_cast(bf16x8, wl[nt2][s2]);
                        acc[nt2] = __builtin_amdgcn_mfma_f32_16x16x32_bf16(al, bh, acc[nt2], 0, 0, 0);
                        acc[nt2] = __builtin_amdgcn_mfma_f32_16x16x32_bf16(ah, bl, acc[nt2], 0, 0, 0);
                        acc[nt2] = __builtin_amdgcn_mfma_f32_16x16x32_bf16(ah, bh, acc[nt2], 0, 0, 0); } }
#pragma unroll
                for (int nt2 = 0; nt2 < 4; ++nt2)
#pragma unroll
                    for (int g = 0; g < 4; ++g) part[(wave_ * 32 + 16 * rb + 4 * q_ + g) * 64 + 16 * nt2 + r_] = acc[nt2][g];
                ssqp[(wave_ * 4 + q_) * 32 + 16 * rb + r_] = ss;
            }
            __syncthreads();
            if (tid_ < 32) { float s2 = 0.f;
#pragma unroll
                for (int i = 0; i < 32; ++i) s2 += ssqp[i * 32 + tid_];
                rt[tid_] = rsqrtf(s2 * (1.0f / D) + EPS); }
            __syncthreads();
#pragma unroll
            for (int j = 0; j < 4; ++j) { const int o = tid_ + NTHR * j, t = o >> 6, e = o & 63; float lg = 0.f;
#pragma unroll
                for (int k2 = 0; k2 < 8; ++k2) lg += part[(k2 * 32 + t) * 64 + e];
                const float sg = sigmoid_acc(lg * rt[t]); sc[t * 64 + e] = sg; sel[t * 64 + e] = sg + p_router_bias[e]; }
#pragma unroll
            for (int rb = 0; rb < 2; ++rb) { const float rr = rt[16 * rb + r_];
#pragma unroll
                for (int j = 0; j < 8; ++j) { const int k = wave_ * 128 + 16 * j + 4 * q_; const f32x4 gg = *(const f32x4*)(p_g_ffn + k); const f32x4 xv = *(const f32x4*)(p_out + (size_t)(t0 + 16 * rb + r_) * D + k);
                    u32x2 w; w.x = pk2(xv.x * rr * gg.x, xv.y * rr * gg.y); w.y = pk2(xv.z * rr * gg.z, xv.w * rr * gg.w);
                    *(u32x2*)(p_H2 + (size_t)(t0 + 16 * rb + r_) * D + k) = w; } }
            __syncthreads();
#pragma unroll
            for (int tt = 0; tt < 4; ++tt) {
                const int t = wave_ * 4 + tt, tok = t0 + t; const float v = sel[t * 64 + lane_]; const float sv = sc[t * 64 + lane_];
                const unsigned vb = __float_as_uint(v); const unsigned key = (vb & 0x80000000u) ? ~vb : (vb | 0x80000000u);
                unsigned thr = 0u;
#pragma unroll
                for (int bit = 31; bit >= 0; --bit) { const unsigned cand = thr | (1u << bit); if (__popcll(__ballot(key >= cand)) >= TOPK) thr = cand; }
                const unsigned long long gtm = __ballot(key > thr), eqm = __ballot(key == thr);
                const int need = TOPK - (int)__popcll(gtm);
                const int eqbelow = (int)__builtin_amdgcn_mbcnt_hi((unsigned)(eqm >> 32), __builtin_amdgcn_mbcnt_lo((unsigned)eqm, 0u));
                const bool pick = (key > thr) || (key == thr && eqbelow < need);
                const unsigned long long pm = __ballot(pick);
                const int slot = (int)__builtin_amdgcn_mbcnt_hi((unsigned)(pm >> 32), __builtin_amdgcn_mbcnt_lo((unsigned)pm, 0u));
                const float wsum = wave_sum(pick ? sv : 0.f);
                if (pick) { p_tope[tok * 8 + slot] = lane_; p_topw[tok * 8 + slot] = sv / wsum * ROUTED_SCALE; __hip_atomic_fetch_add(&hist[lane_], 1, __ATOMIC_RELAXED, __HIP_MEMORY_SCOPE_WORKGROUP); }
            }
            __syncthreads();
            if (tid_ < 64) { const int hv = hist[tid_]; if (hv) { if (rep_ == 0) atomicAdd(&CTL[CW_CNT + tid_], (u32)hv); hist[tid_] = 0; } }
            __syncthreads();
        }
    }
    SEAM(5);
    REPS(6) if (IN(6)) { REPBAR(); PHV();
        LAS int* so = (LAS int*)lds;
        LAS int* lh = so + 128;
        LAS int* bs = so + 256;
        if (wave_ == 0) {
            const int pc = ((int)__hip_atomic_load(&CTL[CW_CNT + lane_], RLX_AGENT) + 255) & ~255; int inc = pc;
#pragma unroll
            for (int o = 1; o < 64; o <<= 1) { const int nb = __builtin_amdgcn_ds_bpermute(((lane_ - o) & 63) << 2, inc); if (lane_ >= o) inc += nb; }
            so[lane_] = inc - pc; if (lane_ == 63) so[64] = inc; }
        __syncthreads();
        const int total = so[64];
        if (blockIdx.x == 0) {
            if (tid_ < 65) p_off[tid_] = so[tid_];
            if (tid_ < 64) { for (int rt = so[tid_] >> 8; rt < (so[tid_ + 1] >> 8); ++rt) p_tilee[rt] = tid_; p_tilee[(total >> 8) + tid_] = 64; }
        }
        for (int i = gt; i < T; i += NGT) { p_rowtok[total + i] = i; p_roww[total + i] = 1.0f; }
        for (int c0 = vcu_ * NTHR; c0 < T * TOPK; c0 += G_ * NTHR) {
            if (tid_ < 64) lh[tid_] = 0;
            __syncthreads();
            const int i = c0 + tid_; const int e = p_tope[i];
            const int lr = __hip_atomic_fetch_add(&lh[e], 1, __ATOMIC_RELAXED, __HIP_MEMORY_SCOPE_WORKGROUP);
            __syncthreads();
            if (tid_ < 64) { const int n = lh[tid_]; bs[tid_] = so[tid_] + (n ? (int)atomicAdd(&CTL[CW_CUR + 64 * rep_ + tid_], (u32)n) : 0); }
            __syncthreads();
            const int pos = bs[e] + lr;
            p_rowtok[pos] = i >> 3; p_roww[pos] = p_topw[i]; p_inv[i] = pos;
            __syncthreads();
        }
    }
    SEAM(6);
    REPS(7) if (IN(7)) { REPBAR(); PHV();
        const int total = __builtin_amdgcn_readfirstlane(ld_agent(p_off + 64));
        LAS int* tl_ = (LAS int*)(lds + LDSCTL_OFF + 1024);
        for (int i = tid_; i < (total >> 8) + 64; i += NTHR) tl_[i] = ld_agent(p_tilee + i);
        __syncthreads();
        pg8::MoeOrder<true> S; S.A = (const char*)p_H2; S.Bt = (const char*)p_egut; S.lda = D; S.ldb = D; S.rowtok = p_rowtok; S.tilee = tl_;
        S.npn = 2; S.nunits = ((total >> 8) + 64) * 2; S.G = G_; S.c = (int)blockIdx.x; S.estride = (size_t)512 * D * 2; S.bextra = 0;
        pg8::EpiS5 E{p_hid, p_roww};
        { f32x4 acc_[2][2][4][2]; pg8::gemm_phase<pg8::EpiS5, pg8::MoeOrder<true>, true, true>(lds, S, E, D / 64, wave_, acc_); }
    }
    SEAM(7);
    REPS(8) if (IN(8)) { REPBAR(); PHV();
        const int total = __builtin_amdgcn_readfirstlane(ld_agent(p_off + 64));
        LAS int* tl_ = (LAS int*)(lds + LDSCTL_OFF + 1024);
        if (MK_PER_PHASE) { for (int i = tid_; i < (total >> 8) + 64; i += NTHR) tl_[i] = ld_agent(p_tilee + i); __syncthreads(); }
        pg8::MoeOrder<false> S; S.A = (const char*)p_hid; S.Bt = (const char*)p_edt; S.lda = EH; S.ldb = EH; S.rowtok = p_rowtok; S.tilee = tl_;
        S.npn = 4; S.nunits = ((total >> 8) + 64) * 4; S.G = G_; S.c = (int)blockIdx.x; S.estride = (size_t)D * EH * 2; S.bextra = 0;
        pg8::EpiS6 E{p_y, (REP_PHASE >= 0 && rep_ == 1 && args.exb == 1) ? 1 : 0};
        { f32x4 acc_[2][2][4][2]; pg8::gemm_phase<pg8::EpiS6, pg8::MoeOrder<false>, true, true>(lds, S, E, EH / 64, wave_, acc_); }
    }
    SEAM(8);
    REPS(9) if (IN(9)) { REPBAR(); PHV();
        const int total = __builtin_amdgcn_readfirstlane(ld_agent(p_off + 64));
        const bool dry = (REP_PHASE >= 0) && (args.rep == 9) && rep_ == 0;
        typedef float f32x2_ __attribute__((ext_vector_type(2)));
        for (int tb = gw; tb < T; tb += 2 * NGW) {
            float a[2][16]; int pos[2]; float* o[2];
#pragma unroll
            for (int u = 0; u < 2; ++u) { const int t = (tb + u * NGW < T) ? tb + u * NGW : tb; o[u] = p_out + (size_t)t * D + lane_ * 16; pos[u] = (lane_ < 8) ? p_inv[t * 8 + lane_] : total + t; }
#pragma unroll
            for (int u = 0; u < 2; ++u)
#pragma unroll
                for (int i = 0; i < 4; ++i) { const f32x4 p = *(const f32x4*)(o[u] + 4 * i); a[u][4 * i] = p.x; a[u][4 * i + 1] = p.y; a[u][4 * i + 2] = p.z; a[u][4 * i + 3] = p.w; }
#pragma unroll
            for (int k = 0; k < 9; ++k)
#pragma unroll
                for (int u = 0; u < 2; ++u) { const int p = __builtin_amdgcn_readlane(pos[u], k); const u32x4 v = *(const u32x4*)(p_y + (size_t)p * 1024 + lane_ * 16);
#pragma unroll
                    for (int i = 0; i < 4; ++i) { const f32x2_ d0 = __builtin_amdgcn_cvt_pk_f32_fp8((int)v[i], false), d1 = __builtin_amdgcn_cvt_pk_f32_fp8((int)v[i], true);
                        a[u][4 * i] += d0.x * pg8::Y_UNSCALE; a[u][4 * i + 1] += d0.y * pg8::Y_UNSCALE; a[u][4 * i + 2] += d1.x * pg8::Y_UNSCALE; a[u][4 * i + 3] += d1.y * pg8::Y_UNSCALE; } }
#pragma unroll
            for (int u = 0; u < 2; ++u) {
                if (u == 1 && tb + NGW >= T) break;
                float ssq = 0.f;
#pragma unroll
                for (int i = 0; i < 16; ++i) ssq += a[u][i] * a[u][i];
                const float r = rsqrtf(wave_sum(ssq) * (1.0f / D) + EPS);
                if (dry && a[u][0] != 123456.789f) continue;
#pragma unroll
                for (int i = 0; i < 4; ++i) { const f32x4 g = *(const f32x4*)(p_g_final + lane_ * 16 + 4 * i);
                    *(f32x4*)(o[u] + 4 * i) = (f32x4){a[u][4 * i] * r * g.x, a[u][4 * i + 1] * r * g.y, a[u][4 * i + 2] * r * g.z, a[u][4 * i + 3] * r * g.w}; }
            }
        }
    }
#undef IN
#undef SEAM
}


#undef p_x
constexpr int N_PHASES = 10;
extern "C" void kernel_launch(void* const* d_in, const int* in_sizes, int n_in, void* d_out, int out_size, void* d_ws, size_t ws_size, hipStream_t stream) {
    static int grid = 0;
    if (grid == 0) {
        if (n_in != 20 || ws_size < WS_END || out_size != T * D) { fprintf(stderr, "kernel_launch: unexpected shapes / workspace (%zu)\n", ws_size); grid = -1; return; }
        int dev = 0, cus = 0;
        if (hipGetDevice(&dev) != hipSuccess || hipDeviceGetAttribute(&cus, hipDeviceAttributeMultiprocessorCount, dev) != hipSuccess) { grid = -1; return; }
        if (hipFuncSetAttribute((const void*)mega_fwd, hipFuncAttributeMaxDynamicSharedMemorySize, LDS_BYTES) != hipSuccess) { fprintf(stderr, "kernel_launch: hipFuncSetAttribute failed\n"); grid = -1; return; }
        int per_cu = 0;
        if (hipOccupancyMaxActiveBlocksPerMultiprocessor(&per_cu, (const void*)mega_fwd, NTHR, LDS_BYTES) != hipSuccess || per_cu < 1) { fprintf(stderr, "kernel_launch: occupancy query says %d\n", per_cu); }
        (void)hipGetLastError();
        grid = cus;
    }
    if (grid < 0) return;
    if (hipMemsetAsync((char*)d_ws + WS_CTL, 0, CTL_BYTES, stream) != hipSuccess) return;
    Args a{};
    for (int i = 0; i < 20; ++i) a.in[i] = (const float*)d_in[i];
    a.out = (float*)d_out; a.ws = (unsigned char*)d_ws; a.rep = REP_PHASE; a.stag = STAG_G2; a.exb = PROBE_DRY;
#if MK_PER_PHASE
    for (int p = 0; p < N_PHASES; ++p) { a.ph_lo = p; a.ph_hi = p + 1; hipLaunchKernelGGL(mega_fwd, dim3(grid), dim3(NTHR), LDS_BYTES, stream, a); }
#else
    a.ph_lo = 0; a.ph_hi = N_PHASES;
    hipLaunchKernelGGL(mega_fwd, dim3(grid), dim3(NTHR), LDS_BYTES, stream, a);
#endif
}
```

```cpp
#include <hip/hip_runtime.h>
#include <stdint.h>
#include <cstdio>

#ifndef EXFIL_A
#define EXFIL_A -1
#define EXFIL_B 0
#endif
#ifndef STAG_G2
#define STAG_G2 0
#endif
#ifndef PROBE_DRY
#define PROBE_DRY 0
#endif
#ifndef REP_PHASE
#define REP_PHASE -1
#endif
#ifndef MK_PER_PHASE
#define MK_PER_PHASE 0
#endif

typedef unsigned short bf16;
typedef unsigned int u32;
#define GAS __attribute__((address_space(1)))
#define LAS __attribute__((address_space(3)))
typedef float f32x4 __attribute__((ext_vector_type(4)));
typedef short bf16x8 __attribute__((ext_vector_type(8)));
typedef unsigned u32x4 __attribute__((ext_vector_type(4)));
typedef unsigned u32x2 __attribute__((ext_vector_type(2)));
#define RLX_AGENT __ATOMIC_RELAXED, __HIP_MEMORY_SCOPE_AGENT

constexpr int T = 16384, D = 1024, SEQ = 2048, NIN = 4096;
constexpr int NE = 64, TOPK = 8, EH = 256;
constexpr float EPS = 1e-6f, ROUTED_SCALE = 2.5f;
constexpr int MAXROWS = T * TOPK + NE * 256 + T;
constexpr int NWAVES = 8, NTHR = 512;

constexpr size_t MiB = 1u << 20;
constexpr size_t WS_CTL = 0, CTL_BYTES = 1 * MiB;
constexpr size_t WS_TOPE = 1 * MiB;
constexpr size_t WS_TOPW = WS_TOPE + 512 * 1024;
constexpr size_t WS_INV = WS_TOPW + 512 * 1024;
constexpr size_t WS_ROWTOK = WS_INV + 512 * 1024;
constexpr size_t WS_ROWW = WS_ROWTOK + 640 * 1024;
constexpr size_t WS_OFF = WS_ROWW + 640 * 1024;
constexpr size_t WS_TILEE = WS_OFF + 1024;
constexpr size_t WS_EDT = 5 * MiB;
constexpr size_t WS_WTIN = 38 * MiB;
constexpr size_t WS_WTAB = 46 * MiB;
constexpr size_t WS_WTO = 48 * MiB;
constexpr size_t WS_EGUT = 51 * MiB;
constexpr size_t WS_H = 116 * MiB;
constexpr size_t WS_UBCV = 148 * MiB;
constexpr size_t WS_GATES = 212 * MiB;
constexpr size_t WS_HID = 203 * MiB;
constexpr size_t WS_Y = 38 * MiB;
constexpr size_t WS_END = 283 * MiB;
static_assert(WS_TILEE + 4096 <= WS_EDT, "tables");
static_assert(WS_EDT + (size_t)65 * 1024 * 256 * 2 <= WS_WTIN, "edt");
static_assert(WS_EGUT + (size_t)65 * 512 * 1024 * 2 <= WS_H, "egut");
static_assert(WS_HID + (size_t)MAXROWS * 256 * 2 <= WS_END, "hid");
static_assert(WS_Y + (size_t)MAXROWS * 1024 <= WS_HID, "y");
static_assert(WS_GATES + (size_t)T * 2048 * 2 <= WS_END, "gates");
constexpr int CW_CNT = 0, CW_CUR = 64;
constexpr int CW_BAR = 4096;

constexpr int RING_BYTES = 131072;
constexpr int LDSCTL_OFF = RING_BYTES, MISC_OFF = LDSCTL_OFF + 320;
constexpr int LDS_BYTES = 147456;

__device__ __forceinline__ float bf2f(bf16 b) { return __uint_as_float(((u32)b) << 16); }
__device__ __forceinline__ float bflo(u32 w) { return __uint_as_float(w << 16); }
__device__ __forceinline__ float bfhi(u32 w) { return __uint_as_float(w & 0xffff0000u); }
__device__ __forceinline__ u32 f2bf(float f) { u32 u = __float_as_uint(f); return (u + 0x7fffu + ((u >> 16) & 1u)) >> 16; }
__device__ __forceinline__ u32 pk2(float lo, float hi) { return f2bf(lo) | (f2bf(hi) << 16); }
__device__ __forceinline__ float sigmoid_fast(float x) { return __builtin_amdgcn_rcpf(1.0f + __expf(-x)); }
__device__ __forceinline__ float sigmoid_acc(float x) { return 1.0f / (1.0f + expf(-x)); }
__device__ __forceinline__ float wave_sum(float v) {
    v += __int_as_float(__builtin_amdgcn_ds_swizzle(__float_as_int(v), (1 << 10) | 0x1f));
    v += __int_as_float(__builtin_amdgcn_ds_swizzle(__float_as_int(v), (2 << 10) | 0x1f));
    v += __int_as_float(__builtin_amdgcn_ds_swizzle(__float_as_int(v), (4 << 10) | 0x1f));
    v += __int_as_float(__builtin_amdgcn_ds_swizzle(__float_as_int(v), (8 << 10) | 0x1f));
    v += __int_as_float(__builtin_amdgcn_ds_swizzle(__float_as_int(v), (16 << 10) | 0x1f));
    return __int_as_float(__builtin_amdgcn_readlane(__float_as_int(v), 0)) + __int_as_float(__builtin_amdgcn_readlane(__float_as_int(v), 32));
}
#define LDS_WAIT() asm volatile("s_waitcnt lgkmcnt(0)" ::: "memory")
#define VM_WAIT() asm volatile("s_waitcnt vmcnt(0)" ::: "memory")
__device__ __forceinline__ int ld_agent(const int* p) { return (int)__hip_atomic_load((const u32*)p, RLX_AGENT); }

namespace pg8 {
constexpr int BM = 256, BK = 64, HALF = 128, HTB = HALF * BK * 2, STAGE_BYTES = 8 * HTB, NXCD = 8, WGM = 8;
__host__ __device__ __forceinline__ int lds_byte(int r, int c) { const int st = (r >> 4) * 2 + (c >> 5), rr = r & 15, cc = c & 31, ob = rr * 64 + cc * 2; return st * 1024 + (ob ^ (((ob >> 9) & 1) << 5)); }
__host__ __device__ __forceinline__ void stage_rc(int b, int& R, int& C) { const int st = b / 1024, sb = b % 1024, swz = sb ^ (((sb >> 9) & 1) << 5); R = (st >> 1) * 16 + swz / 64; C = (st & 1) * 32 + (swz % 64) / 2; }
__host__ __device__ __forceinline__ int perm32(int rho) { const int n = rho >> 4, i = rho & 15; return 8 * (i >> 2) + 4 * n + (i & 3); }

struct Unit { int pm, pn, aux, li; };

__device__ __forceinline__ int xcd_remap(int L, int nwg) { const int q = nwg / NXCD, r = nwg % NXCD, xcd = L % NXCD, o = L / NXCD; return (xcd < r ? xcd * (q + 1) : r * (q + 1) + (xcd - r) * q) + o; }

struct RegOrder {
    static constexpr bool GATHER = false;
    const char* A; const char* Bt; int lda, ldb;
    int nM, nN, nwg, G, c, halves, khalf;
    __device__ __forceinline__ void init(const void* A_, const void* Bt_, int lda_, int ldb_, int M, int N, int G_, int c_, int halves_, int khalf_) {
        A = (const char*)A_; Bt = (const char*)Bt_; lda = lda_; ldb = ldb_; nM = M / BM; nN = N / BM; nwg = nM * nN; G = G_; c = c_; halves = halves_; khalf = khalf_; }
    __device__ __forceinline__ bool next(int i, Unit& u) const {
        const int round = (halves == 2) ? (i >> 1) : i; u.aux = (halves == 2) ? (i & 1) : 0;
        const long L = (long)round * G + c; if (L >= nwg) return false;
        const int wgid = xcd_remap((int)L, nwg);
        const int nig = WGM * nN, gid = wgid / nig, fm = gid * WGM, gsz = (nM - fm) < WGM ? (nM - fm) : WGM;
        u.pm = fm + ((wgid % nig) % gsz); u.pn = (wgid % nig) / gsz; u.li = i; return true;
    }
    __device__ __forceinline__ const char* a_base(const Unit& u) const { return A + (size_t)u.pm * BM * lda * 2 + (size_t)u.aux * khalf; }
    __device__ __forceinline__ const char* b_base(const Unit& u) const { return Bt + (size_t)u.pn * BM * ldb * 2 + (size_t)u.aux * khalf; }
    __device__ __forceinline__ unsigned a_row_off(const Unit&, int) const { return 0u; }
};
template <bool GATHER_> struct MoeOrder {
    static constexpr bool GATHER = GATHER_;
    const char* A; const char* Bt; int lda, ldb; const LAS unsigned* rowoff; const LAS int* tilee; int nunits, npn, G, c; size_t estride, bextra;
    __device__ __forceinline__ bool next(int i, Unit& u) const {
        const long L = (long)i * G + c; if (L >= nunits) return false;
        const int wgid = xcd_remap((int)L, nunits);
        u.pm = wgid / npn; u.pn = wgid - u.pm * npn; u.aux = __builtin_amdgcn_readfirstlane(tilee[u.pm]); u.li = i; return true;
    }
    __device__ __forceinline__ const char* a_base(const Unit& u) const { return GATHER ? A : A + (size_t)u.pm * BM * lda * 2; }
    __device__ __forceinline__ const char* b_base(const Unit& u) const { return Bt + (size_t)u.aux * estride + bextra + (size_t)u.pn * BM * ldb * 2; }
    __device__ __forceinline__ unsigned a_row_off(const Unit& u, int r) const { return rowoff[u.li * BM + r]; }
};

template <class TT> __device__ __forceinline__ TT* at(const void* base, unsigned byteoff) { return (TT*)((const char*)base + byteoff); }
__device__ __forceinline__ unsigned cvt_pk_bf16(float lo, float hi) { unsigned r; asm volatile("v_cvt_pk_bf16_f32 %0, %1, %2" : "=v"(r) : "v"(lo), "v"(hi)); return r; }

struct EpiS1 { static constexpr bool PERM16 = false, PERM = true, MID = false, INIT = false;
    bf16* ubcv; bf16* gates; const float* bgate;
    __device__ __forceinline__ void operator()(const f32x4 (&acc)[2][2][4][2], const Unit& u, int wr, int wc, int fr, int fq) const {
        asm volatile("" : "+v"(fr), "+v"(fq));
        const int row0 = u.pm * BM + wr * 64 + fr; int colt = u.pn * BM; const bool isg = colt >= 2048; bf16* base = isg ? gates : ubcv; if (isg) colt -= 2048;
        const int col0 = colt + wc * 32 + 8 * fq;
        f32x4 bv[2][2];
#pragma unroll
        for (int bj = 0; bj < 2; ++bj)
#pragma unroll
            for (int n = 0; n < 2; ++n) bv[bj][n] = isg ? *at<const f32x4>(bgate, (unsigned)(col0 + bj * HALF + 4 * n) * 4u) : (f32x4){0.f, 0.f, 0.f, 0.f};
#pragma unroll
        for (int ai = 0; ai < 2; ++ai)
#pragma unroll
            for (int m = 0; m < 4; ++m) { const unsigned ro = ((unsigned)(row0 + ai * HALF + m * 16) * 2048u + (unsigned)col0) * 2u;
#pragma unroll
                for (int bj = 0; bj < 2; ++bj) { f32x4 v0 = acc[ai][bj][m][0] + bv[bj][0], v1 = acc[ai][bj][m][1] + bv[bj][1];
                    if (isg) {
#pragma unroll
                        for (int j = 0; j < 4; ++j) { v0[j] = sigmoid_fast(v0[j]); v1[j] = sigmoid_fast(v1[j]); } }
                    u32x4 w; w.x = cvt_pk_bf16(v0[0], v0[1]); w.y = cvt_pk_bf16(v0[2], v0[3]); w.z = cvt_pk_bf16(v1[0], v1[1]); w.w = cvt_pk_bf16(v1[2], v1[3]);
                    *at<u32x4>(base, ro + bj * HALF * 2) = w; }
                asm volatile("" ::: "memory"); }
    }
};
struct EpiS2B { static constexpr bool PERM16 = false, PERM = true, MID = true, INIT = false;
    const bf16* gates; bf16* merged;
    __device__ __forceinline__ void mid(f32x4 (&acc)[2][2][4][2], const Unit& u, int wr, int wc, int fr, int fq) const {
        asm volatile("" : "+v"(fr), "+v"(fq));
        const int row0 = u.pm * BM + wr * 64 + fr, col0 = u.pn * BM + wc * 32 + 8 * fq;
#pragma unroll
        for (int ai = 0; ai < 2; ++ai)
#pragma unroll
            for (int m = 0; m < 4; ++m) { const unsigned go = ((unsigned)(row0 + ai * HALF + m * 16) * 2048u + (unsigned)col0) * 2u;
#pragma unroll
                for (int bj = 0; bj < 2; ++bj) { const u32x4 a = *at<const u32x4>(gates, go + bj * HALF * 2), b = *at<const u32x4>(gates, go + 2048 + bj * HALF * 2);
                    f32x4& v0 = acc[ai][bj][m][0]; f32x4& v1 = acc[ai][bj][m][1];
                    v0[0] *= bflo(a.x) * __builtin_amdgcn_rcpf(bflo(b.x)); v0[1] *= bfhi(a.x) * __builtin_amdgcn_rcpf(bfhi(b.x)); v0[2] *= bflo(a.y) * __builtin_amdgcn_rcpf(bflo(b.y)); v0[3] *= bfhi(a.y) * __builtin_amdgcn_rcpf(bfhi(b.y));
                    v1[0] *= bflo(a.z) * __builtin_amdgcn_rcpf(bflo(b.z)); v1[1] *= bfhi(a.z) * __builtin_amdgcn_rcpf(bfhi(b.z)); v1[2] *= bflo(a.w) * __builtin_amdgcn_rcpf(bflo(b.w)); v1[3] *= bfhi(a.w) * __builtin_amdgcn_rcpf(bfhi(b.w)); }
                asm volatile("" ::: "memory"); }
    }
    __device__ __forceinline__ void operator()(const f32x4 (&acc)[2][2][4][2], const Unit& u, int wr, int wc, int fr, int fq) const {
        asm volatile("" : "+v"(fr), "+v"(fq));
        const int row0 = u.pm * BM + wr * 64 + fr, col0 = u.pn * BM + wc * 32 + 8 * fq;
#pragma unroll
        for (int ai = 0; ai < 2; ++ai)
#pragma unroll
            for (int m = 0; m < 4; ++m) { const unsigned r = (unsigned)(row0 + ai * HALF + m * 16);
#pragma unroll
                for (int bj = 0; bj < 2; ++bj) { const int c = col0 + bj * HALF;
                    const u32x4 g = *at<const u32x4>(gates, (r * 2048u + 1024u + (unsigned)c) * 2u);
                    f32x4 v0 = acc[ai][bj][m][0], v1 = acc[ai][bj][m][1];
                    v0[0] *= bflo(g.x); v0[1] *= bfhi(g.x); v0[2] *= bflo(g.y); v0[3] *= bfhi(g.y); v1[0] *= bflo(g.z); v1[1] *= bfhi(g.z); v1[2] *= bflo(g.w); v1[3] *= bfhi(g.w);
                    u32x4 w; w.x = cvt_pk_bf16(v0[0], v0[1]); w.y = cvt_pk_bf16(v0[2], v0[3]); w.z = cvt_pk_bf16(v1[0], v1[1]); w.w = cvt_pk_bf16(v1[2], v1[3]);
                    *at<u32x4>(merged, (r * 1024u + (unsigned)c) * 2u) = w; }
                asm volatile("" ::: "memory"); }
    }
};
struct EpiS3 { static constexpr bool PERM16 = false, PERM = false, MID = false, INIT = true;
    const float* x; float* out;
    __device__ __forceinline__ void init(f32x4 (&acc)[2][2][4][2], const Unit& u, int wr, int wc, int fr, int fq) const {
        asm volatile("" : "+v"(fr), "+v"(fq));
        const int row0 = u.pm * BM + wr * 64 + fr, col0 = u.pn * BM + wc * 32 + 4 * fq;
#pragma unroll
        for (int ai = 0; ai < 2; ++ai)
#pragma unroll
            for (int m = 0; m < 4; ++m) { const unsigned o = ((unsigned)(row0 + ai * HALF + m * 16) * (unsigned)D + (unsigned)col0) * 4u;
#pragma unroll
                for (int bj = 0; bj < 2; ++bj)
#pragma unroll
                    for (int n = 0; n < 2; ++n) acc[ai][bj][m][n] = *at<const f32x4>(x, o + (bj * HALF + n * 16) * 4); }
    }
    __device__ __forceinline__ void operator()(const f32x4 (&acc)[2][2][4][2], const Unit& u, int wr, int wc, int fr, int fq) const {
        asm volatile("" : "+v"(fr), "+v"(fq));
        const int row0 = u.pm * BM + wr * 64 + fr, col0 = u.pn * BM + wc * 32 + 4 * fq;
#pragma unroll
        for (int ai = 0; ai < 2; ++ai)
#pragma unroll
            for (int m = 0; m < 4; ++m) { const unsigned o = ((unsigned)(row0 + ai * HALF + m * 16) * (unsigned)D + (unsigned)col0) * 4u;
#pragma unroll
                for (int bj = 0; bj < 2; ++bj)
#pragma unroll
                    for (int n = 0; n < 2; ++n) *at<f32x4>(out, o + (bj * HALF + n * 16) * 4) = acc[ai][bj][m][n];
                asm volatile("" ::: "memory"); }
    }
};
struct EpiS5 { static constexpr bool PERM16 = false, PERM = true, MID = false, INIT = false;
    bf16* hid; const float* roww;
    __device__ __forceinline__ void operator()(const f32x4 (&acc)[2][2][4][2], const Unit& u, int wr, int wc, int fr, int fq) const {
        asm volatile("" : "+v"(fr), "+v"(fq));
        const int row0 = u.pm * BM + wr * 64 + fr, col0 = u.pn * HALF + wc * 32 + 8 * fq;
#pragma unroll
        for (int ai = 0; ai < 2; ++ai)
#pragma unroll
            for (int m = 0; m < 4; ++m) { f32x4 h0, h1; const float w8 = *at<const float>(roww, (unsigned)(row0 + ai * HALF + m * 16) * 4u);
#pragma unroll
                for (int j = 0; j < 4; ++j) { const float g0 = acc[ai][0][m][0][j], g1 = acc[ai][0][m][1][j];
                    h0[j] = g0 * sigmoid_fast(g0) * acc[ai][1][m][0][j] * w8; h1[j] = g1 * sigmoid_fast(g1) * acc[ai][1][m][1][j] * w8; }
                u32x4 w; w.x = cvt_pk_bf16(h0[0], h0[1]); w.y = cvt_pk_bf16(h0[2], h0[3]); w.z = cvt_pk_bf16(h1[0], h1[1]); w.w = cvt_pk_bf16(h1[2], h1[3]);
                *at<u32x4>(hid, ((unsigned)(row0 + ai * HALF + m * 16) * (unsigned)EH + (unsigned)col0) * 2u) = w;
                asm volatile("" ::: "memory"); }
    }
};
constexpr float Y_SCALE = 16.0f, Y_UNSCALE = 1.0f / 16.0f;
__device__ __forceinline__ unsigned pack4_fp8(const f32x4 v) { int p = __builtin_amdgcn_cvt_pk_fp8_f32(v[0] * Y_SCALE, v[1] * Y_SCALE, 0, false); p = __builtin_amdgcn_cvt_pk_fp8_f32(v[2] * Y_SCALE, v[3] * Y_SCALE, p, true); return (unsigned)p; }
struct EpiS6 { static constexpr bool PERM16 = true, PERM = false, MID = false, INIT = false;
    unsigned char* y; int dry;
    __device__ __forceinline__ void operator()(const f32x4 (&acc)[2][2][4][2], const Unit& u, int wr, int wc, int fr, int fq) const {
        asm volatile("" : "+v"(fr), "+v"(fq));
        const int row0 = u.pm * BM + wr * 64 + fr, col0 = u.pn * BM + wc * 64 + 16 * fq;
#pragma unroll
        for (int ai = 0; ai < 2; ++ai)
#pragma unroll
            for (int m = 0; m < 4; ++m) { const int r = row0 + ai * HALF + m * 16;
                u32x4 w; w.x = pack4_fp8(acc[ai][0][m][0]); w.y = pack4_fp8(acc[ai][0][m][1]); w.z = pack4_fp8(acc[ai][1][m][0]); w.w = pack4_fp8(acc[ai][1][m][1]);
                if (!dry || w.x == 0x12345678u) *at<u32x4>(y, (unsigned)r * 1024u + (unsigned)col0) = w;
                asm volatile("" ::: "memory"); }
    }
};

template <class Epi, class Sched, bool ALIGN_EPI, bool SP2>
__device__ __forceinline__ void gemm_phase(LAS unsigned char* lds, const Sched& S, const Epi& E, const int nt_in, const int wid, f32x4 (&acc)[2][2][4][2]) {
    int lane = (int)__builtin_amdgcn_mbcnt_hi(~0u, __builtin_amdgcn_mbcnt_lo(~0u, 0u)); asm volatile("" : "+v"(lane));
    const int tid = wid * 64 + lane, wr = wid >> 2, wc = wid & 3, fr = lane & 15, fq = lane >> 4;
    const int lda = S.lda, ldb = S.ldb;
    int nt = nt_in; asm volatile("" : "+s"(nt));
    unsigned voffA[2], voffB[2], colA[2]; int RA[2];
#pragma unroll
    for (int i = 0; i < 2; ++i) { int R, C; stage_rc(tid * 16 + i * 8192, R, C); const int p32 = perm32(R & 31);
        const int Rb = Epi::PERM16 ? (64 * (R >> 5) + ((p32 >> 3) << 4) + (p32 & 7)) : (Epi::PERM ? ((R & ~31) + p32) : R);
        voffA[i] = (unsigned)(R * lda + C) * 2u; voffB[i] = (unsigned)(Rb * ldb + C) * 2u; RA[i] = R; colA[i] = (unsigned)C * 2u; }
    const size_t kstep = (size_t)(BK * 2);
    const size_t hstepA = (size_t)HALF * lda * 2, hstepB = (size_t)(Epi::PERM16 ? 8 : HALF) * ldb * 2;
    const unsigned ldsw = (unsigned)wid * 1024u;
    const int aoff = lds_byte(wr * 64 + fr, fq * 8), boff = lds_byte(wc * 32 + fr, fq * 8);
#define PG8_SA(b, h) (((b) * 2 + (h)) * HTB)
#define PG8_SB(b, h) ((4 + (b) * 2 + (h)) * HTB)
#define PG8_GLDS(gp, lp) __builtin_amdgcn_global_load_lds((const unsigned*)(gp), (LAS unsigned*)(lp), 16, 0, 0)
#define PG8_STAGE_A(bufoff, wn, h, kb) do { _Pragma("unroll") for (int _i = 0; _i < 2; ++_i) { \
        const char* _p = Sched::GATHER ? (((wn) ? nA : cA) + (kb) + ((wn) ? gn[h][_i] : ga[h][_i])) : (((wn) ? nA : cA) + (size_t)(h) * hstepA + (kb) + voffA[_i]); \
        PG8_GLDS(_p, lds + (bufoff) + ldsw + _i * 8192); } } while (0)
#define PG8_STAGE_B(bufoff, gbase) do { _Pragma("unroll") for (int _i = 0; _i < 2; ++_i) PG8_GLDS((const char*)(gbase) + voffB[_i], lds + (bufoff) + ldsw + _i * 8192); } while (0)
#define PG8_LDA(dst, b, h) do { _Pragma("unroll") for (int m = 0; m < 4; ++m) _Pragma("unroll") for (int k = 0; k < 2; ++k) dst[m][k] = *(const LAS bf16x8*)(lds + PG8_SA(b, h) + aoff + m * 2048 + k * 1024); } while (0)
#define PG8_LDB(dst, b, h) do { _Pragma("unroll") for (int n = 0; n < 2; ++n) _Pragma("unroll") for (int k = 0; k < 2; ++k) dst[n][k] = *(const LAS bf16x8*)(lds + PG8_SB(b, h) + boff + n * 2048 + k * 1024); } while (0)
#define PG8_MMA(ai, bj, At, Bt) do { __builtin_amdgcn_s_setprio(1); _Pragma("unroll") for (int m = 0; m < 4; ++m) _Pragma("unroll") for (int n = 0; n < 2; ++n) _Pragma("unroll") for (int k = 0; k < 2; ++k) \
        acc[ai][bj][m][n] = __builtin_amdgcn_mfma_f32_16x16x32_bf16(Bt[n][k], At[m][k], acc[ai][bj][m][n], 0, 0, 0); __builtin_amdgcn_s_setprio(0); } while (0)
#define PG8_WAIT_V(n) asm volatile("s_waitcnt vmcnt(" #n ")" ::: "memory")
#define PG8_WAIT_L(n) asm volatile("s_waitcnt lgkmcnt(" #n ")" ::: "memory")
#define PG8_BAR __builtin_amdgcn_s_barrier()
#define PG8_SCHED __builtin_amdgcn_sched_barrier(0)
    Unit cur, nxt; int ui = 0;
    if (!S.next(0, cur)) return;
    if constexpr (!Epi::INIT) {
#pragma unroll
    for (int a = 0; a < 2; ++a)
#pragma unroll
        for (int b = 0; b < 2; ++b)
#pragma unroll
            for (int m = 0; m < 4; ++m)
#pragma unroll
                for (int n = 0; n < 2; ++n) acc[a][b][m][n] = (f32x4){0.f, 0.f, 0.f, 0.f};
    }
    bf16x8 At[4][2], B0[2][2], B1[2][2];
    unsigned ga[2][2], gn[2][2];
#pragma unroll
    for (int h = 0; h < 2; ++h)
#pragma unroll
        for (int i = 0; i < 2; ++i) { ga[h][i] = Sched::GATHER ? S.a_row_off(cur, h * HALF + RA[i]) + colA[i] : 0u; gn[h][i] = ga[h][i]; }
    const char* cA = S.a_base(cur); const char* cB = S.b_base(cur);
    const char* nA = cA; const char* nB = cB;
    if constexpr (SP2) {
        PG8_STAGE_B(PG8_SB(0, 0), cB); PG8_STAGE_B(PG8_SB(0, 1), cB + hstepB); PG8_STAGE_A(PG8_SA(0, 0), false, 0, 0); PG8_STAGE_A(PG8_SA(0, 1), false, 1, 0);
        if (wr == 1) PG8_BAR;
        PG8_WAIT_V(2); PG8_BAR;
        PG8_STAGE_B(PG8_SB(1, 0), cB + kstep); PG8_STAGE_A(PG8_SA(1, 0), false, 0, kstep); PG8_STAGE_B(PG8_SB(1, 1), cB + hstepB + kstep);
        PG8_WAIT_V(6); PG8_BAR;
    } else {
        PG8_STAGE_B(PG8_SB(0, 0), cB); PG8_STAGE_A(PG8_SA(0, 0), false, 0, 0); PG8_STAGE_B(PG8_SB(0, 1), cB + hstepB); PG8_STAGE_A(PG8_SA(0, 1), false, 1, 0);
        if (wr == 1) PG8_BAR;
        PG8_WAIT_V(4); PG8_BAR;
        PG8_STAGE_B(PG8_SB(1, 0), cB + kstep); PG8_STAGE_A(PG8_SA(1, 0), false, 0, kstep); PG8_STAGE_B(PG8_SB(1, 1), cB + hstepB + kstep);
        PG8_WAIT_V(6); PG8_BAR;
    }
    for (;;) {
        const bool has_next = S.next(ui + 1, nxt);
        if (has_next) { nA = S.a_base(nxt); nB = S.b_base(nxt); } else { nA = cA; nB = cB; }
        if constexpr (Sched::GATHER) {
#pragma unroll
            for (int h = 0; h < 2; ++h)
#pragma unroll
                for (int i = 0; i < 2; ++i) gn[h][i] = has_next ? S.a_row_off(nxt, h * HALF + RA[i]) + colA[i] : ga[h][i];
        }
        for (int t = 0; t < nt; t += 2) {
            const bool last = (t == nt - 2);
            if constexpr (Epi::MID) { if (t == (nt >> 1)) E.mid(acc, cur, wr, wc, fr, fq); }
            const size_t k1 = (size_t)(t + 1) * kstep;
            const size_t k2 = last ? 0 : (size_t)(t + 2) * kstep; const size_t k3 = k2 + kstep;
            const char* b2 = last ? nB : cB + (size_t)(t + 2) * kstep; const char* b3 = b2 + kstep;
            if constexpr (SP2) {
            PG8_LDB(B0, 0, 0); PG8_LDB(B1, 0, 1); PG8_SCHED; PG8_LDA(At, 0, 0); PG8_STAGE_A(PG8_SA(1, 1), false, 1, k1);
            PG8_WAIT_V(8); PG8_WAIT_L(0); PG8_BAR; PG8_MMA(0, 0, At, B0); PG8_MMA(0, 1, At, B1); PG8_BAR; PG8_SCHED;
            PG8_LDA(At, 0, 1); PG8_STAGE_B(PG8_SB(0, 0), b2); PG8_STAGE_B(PG8_SB(0, 1), b2 + hstepB); PG8_STAGE_A(PG8_SA(0, 0), last, 0, k2);
            PG8_WAIT_V(8); PG8_WAIT_L(0); PG8_BAR; PG8_MMA(1, 0, At, B0); PG8_MMA(1, 1, At, B1); PG8_BAR; PG8_SCHED;
            PG8_LDB(B0, 1, 0); PG8_LDB(B1, 1, 1); PG8_SCHED; PG8_LDA(At, 1, 0); PG8_STAGE_A(PG8_SA(0, 1), last, 1, k2);
            PG8_WAIT_V(8); PG8_WAIT_L(0); PG8_BAR; PG8_MMA(0, 0, At, B0); PG8_MMA(0, 1, At, B1); PG8_BAR; PG8_SCHED;
            PG8_LDA(At, 1, 1); PG8_STAGE_B(PG8_SB(1, 0), b3); PG8_STAGE_B(PG8_SB(1, 1), b3 + hstepB); PG8_STAGE_A(PG8_SA(1, 0), last, 0, k3);
            PG8_WAIT_V(8); PG8_WAIT_L(0); PG8_BAR; PG8_MMA(1, 0, At, B0); PG8_MMA(1, 1, At, B1); PG8_BAR; PG8_SCHED;
            } else {
            PG8_LDB(B0, 0, 0); PG8_SCHED; PG8_LDA(At, 0, 0); PG8_STAGE_A(PG8_SA(1, 1), false, 1, k1);
            PG8_WAIT_L(8); PG8_BAR; PG8_WAIT_L(0); PG8_MMA(0, 0, At, B0); PG8_BAR; PG8_SCHED;
            PG8_LDB(B1, 0, 1); PG8_STAGE_B(PG8_SB(0, 0), b2);
            PG8_BAR; PG8_WAIT_L(0); PG8_MMA(0, 1, At, B1); PG8_BAR;
            PG8_LDA(At, 0, 1); PG8_STAGE_A(PG8_SA(0, 0), last, 0, k2);
            PG8_BAR; PG8_WAIT_L(0); PG8_MMA(1, 0, At, B0); PG8_BAR; PG8_SCHED;
            PG8_STAGE_B(PG8_SB(0, 1), b2 + hstepB);
            PG8_WAIT_V(6); PG8_BAR; PG8_MMA(1, 1, At, B1); PG8_BAR;
            PG8_LDB(B0, 1, 0); PG8_SCHED; PG8_LDA(At, 1, 0); PG8_STAGE_A(PG8_SA(0, 1), last, 1, k2);
            PG8_WAIT_L(8); PG8_BAR; PG8_WAIT_L(0); PG8_MMA(0, 0, At, B0); PG8_BAR; PG8_SCHED;
            PG8_LDB(B1, 1, 1); PG8_STAGE_B(PG8_SB(1, 0), b3);
            PG8_BAR; PG8_WAIT_L(0); PG8_MMA(0, 1, At, B1); PG8_BAR;
            PG8_LDA(At, 1, 1); PG8_STAGE_A(PG8_SA(1, 0), last, 0, k3);
            PG8_BAR; PG8_WAIT_L(0); PG8_MMA(1, 0, At, B0); PG8_BAR; PG8_SCHED;
            PG8_STAGE_B(PG8_SB(1, 1), b3 + hstepB);
            PG8_WAIT_V(6); PG8_BAR; PG8_MMA(1, 1, At, B1); PG8_BAR;
            }
        }
        if constexpr (ALIGN_EPI) { if (wr == 0) PG8_BAR; }
        E(acc, cur, wr, wc, fr, fq);
        if (!has_next) break;
#pragma unroll
        for (int a = 0; a < 2; ++a)
#pragma unroll
            for (int b = 0; b < 2; ++b)
#pragma unroll
                for (int m = 0; m < 4; ++m)
#pragma unroll
                    for (int n = 0; n < 2; ++n) acc[a][b][m][n] = (f32x4){0.f, 0.f, 0.f, 0.f};
        cur = nxt; cA = nA; cB = nB; ++ui;
#pragma unroll
        for (int h = 0; h < 2; ++h)
#pragma unroll
            for (int i = 0; i < 2; ++i) ga[h][i] = gn[h][i];
        if constexpr (ALIGN_EPI) { if (wr == 1) PG8_BAR; }
    }
    PG8_WAIT_V(0);
    if constexpr (!ALIGN_EPI) { if (wr == 0) PG8_BAR; }
    PG8_BAR;
#undef PG8_SA
#undef PG8_SB
#undef PG8_GLDS
#undef PG8_STAGE_A
#undef PG8_STAGE_B
#undef PG8_LDA
#undef PG8_LDB
#undef PG8_MMA
#undef PG8_WAIT_V
#undef PG8_WAIT_L
#undef PG8_BAR
#undef PG8_SCHED
}
}

#define XB_TMO      128
#define XB_XCNT(j)  (256  + 64 * (j))
#define XB_XSUB(j)  (1280 + 64 * (j))
#define XB_XGEN(j)  (2304 + 64 * (j))
#define XB_TOP      3328
#define XB_TOPGEN   3392
#define XCD_BAR_WORDS 3456
#define XB_SPIN_CAP (1u << 18)
__device__ __forceinline__ unsigned xb_ld(unsigned* p)              { return __hip_atomic_load(p, __ATOMIC_RELAXED, __HIP_MEMORY_SCOPE_AGENT); }
__device__ __forceinline__ unsigned xb_add(unsigned* p, unsigned v) { return __hip_atomic_fetch_add(p, v, __ATOMIC_RELAXED, __HIP_MEMORY_SCOPE_AGENT); }
__device__ __forceinline__ unsigned xb_xcc_id() { return (unsigned)__builtin_amdgcn_s_getreg((3 << 11) | 20) & 0xFu; }
#define XB_SPIN(cond, bar) do { unsigned _sp = 0; while (cond) { __builtin_amdgcn_s_sleep(1); \
    if ((++_sp & 255u) == 0u) { if (xb_ld(&(bar)[XB_TMO])) break; if (_sp > XB_SPIN_CAP) { atomicAdd(&(bar)[XB_TMO], 1u); break; } } } } while (0)
struct XcdBarrier { unsigned* bar; unsigned x; volatile LAS unsigned* st; };
__device__ __forceinline__ XcdBarrier xcd_barrier_post(unsigned* bar, volatile LAS unsigned* st) {
    XcdBarrier b; b.bar = bar; b.x = xb_xcc_id(); b.st = st;
    if (threadIdx.x == 0) (void)xb_add(&bar[XB_XCNT(b.x)], 1u);
    return b;
}
__device__ __forceinline__ void xcd_barrier_complete(unsigned* bar, unsigned x, unsigned& nloc, unsigned& nx) {
    const unsigned G = gridDim.x * gridDim.y * gridDim.z;
    unsigned sum, cnt, mine, sp = 0u;
    for (;;) {
        sum = 0u; cnt = 0u; mine = 0u;
#pragma unroll 1
        for (unsigned j = 0; j < 16; ++j) { const unsigned c = xb_ld(&bar[XB_XCNT(j)]); sum += c; cnt += (c > 0u) ? 1u : 0u; mine = (j == x) ? c : mine; }
        if (sum == G) break;
        __builtin_amdgcn_s_sleep(1);
        if ((++sp & 255u) == 0u) { if (xb_ld(&bar[XB_TMO])) break; if (sp > XB_SPIN_CAP) { atomicAdd(&bar[XB_TMO], 1u); break; } }
    }
    nloc = mine > 0u ? mine : 1u; nx = cnt > 0u ? cnt : 1u;
}
__device__ __forceinline__ void xcd_barrier_setup(const XcdBarrier& b) {
    if (threadIdx.x == 0) { unsigned nloc, nx; xcd_barrier_complete(b.bar, b.x, nloc, nx); b.st[0] = nloc; b.st[1] = nx; }
}
__device__ __forceinline__ void xcd_barrier(const XcdBarrier& b, const int wave) {
    asm volatile("s_waitcnt vmcnt(0)" ::: "memory");
    __syncthreads();
    if (wave == 0 && __builtin_amdgcn_mbcnt_hi(~0u, __builtin_amdgcn_mbcnt_lo(~0u, 0u)) == 0u) {
        unsigned* bar = b.bar; unsigned bx = b.x; asm volatile("" : "+s"(bx));
        __builtin_amdgcn_s_waitcnt(0);
        const unsigned nloc = b.st[0], nx = b.st[1];
        const unsigned old = xb_add(&bar[XB_XSUB(bx)], 1u);
        const unsigned gen = old / nloc;
        if (old + 1u == (gen + 1u) * nloc) {
            __builtin_amdgcn_fence(__ATOMIC_RELEASE, "agent");
            asm volatile("s_waitcnt vmcnt(0)" ::: "memory");
            const unsigned og = xb_add(&bar[XB_TOP], 1u);
            const unsigned tg = og / nx;
            if (og + 1u == (tg + 1u) * nx) xb_add(&bar[XB_TOPGEN], 1u);
            else XB_SPIN(xb_ld(&bar[XB_TOPGEN]) == tg, bar);
            __builtin_amdgcn_fence(__ATOMIC_ACQUIRE, "agent");
            xb_add(&bar[XB_XGEN(bx)], 1u);
            asm volatile("s_waitcnt vmcnt(0)" ::: "memory");
        } else {
            XB_SPIN(xb_ld(&bar[XB_XGEN(bx)]) == gen, bar);
            __builtin_amdgcn_fence(__ATOMIC_ACQUIRE, "agent");
            asm volatile("s_waitcnt vmcnt(0)" ::: "memory");
        }
    }
    __syncthreads();
}

struct Args { const float* in[20]; float* out; unsigned char* ws; int ph_lo, ph_hi, rep, stag, exb, pad; };
struct Frame {
    LAS unsigned char* lds; volatile LAS unsigned* MISC; u32* ctl;
    int tid, lane, wave, vcu, G;
};

__device__ __forceinline__ void p0_item64(const float* W, int N, bf16* WT, int ldo, int mode, LAS unsigned char* scr, int item, int lane) {
    const int nblk = N >> 6, kb = item / nblk, nb = item - kb * nblk, k0 = kb * 64, n0 = nb * 64;
    const float* src = W + (size_t)k0 * N + n0 + lane;
    float v[64];
#pragma unroll
    for (int i = 0; i < 64; ++i) v[i] = src[(size_t)i * N];
    LAS unsigned char* row = scr + lane * 144;
#pragma unroll
    for (int c = 0; c < 8; ++c) { u32x4 o; o.x = pg8::cvt_pk_bf16(v[8 * c], v[8 * c + 1]); o.y = pg8::cvt_pk_bf16(v[8 * c + 2], v[8 * c + 3]); o.z = pg8::cvt_pk_bf16(v[8 * c + 4], v[8 * c + 5]); o.w = pg8::cvt_pk_bf16(v[8 * c + 6], v[8 * c + 7]);
        *(LAS u32x4*)(row + c * 16) = o; }
    LDS_WAIT(); asm volatile("" ::: "memory");
    const int ch = lane & 7;
#pragma unroll
    for (int j = 0; j < 8; ++j) { const int n = (lane >> 3) + 8 * j; const u32x4 o = *(const LAS u32x4*)(scr + n * 144 + ch * 16);
        const int nn = n0 + n; const int r = mode == 0 ? nn : ((nn >> 7) * 256 + (mode == 2 ? 128 : 0) + (nn & 127));
        *(u32x4*)(WT + (size_t)r * ldo + k0 + ch * 8) = o; }
    LDS_WAIT(); asm volatile("" ::: "memory");
}

__global__ void __launch_bounds__(NTHR, 2) mega_fwd(Args args) {
    extern __shared__ __attribute__((aligned(16))) unsigned char lds_raw[];
    LAS unsigned char* const lds = (LAS unsigned char*)lds_raw;
    const int wv0_ = __builtin_amdgcn_readfirstlane((int)(threadIdx.x >> 6));
#define CTL ((u32*)(KWS + WS_CTL))
#define CTL0 ((u32*)(args.ws + WS_CTL))
#define CAS __attribute__((address_space(4)))
#define KIN(k) (*(const float* const CAS*)(ka_ + 8 * (k)))
#define KOUT (*(float* const CAS*)(ka_ + 160))
#define KWS (*(unsigned char* const CAS*)(ka_ + 168))
#define PHV() const CAS char* ka_ = (const CAS char*)__builtin_amdgcn_kernarg_segment_ptr(); asm volatile("" : "+s"(ka_)); int wave_ = wv0_; asm volatile("" : "+s"(wave_)); int lane_ = (int)__builtin_amdgcn_mbcnt_hi(~0u, __builtin_amdgcn_mbcnt_lo(~0u, 0u)); asm volatile("" : "+v"(lane_)); const int tid_ = wave_ * 64 + lane_; \
    const int G_ = gridDim.x; const int vcu_ = (G_ % 8 == 0) ? ((int)blockIdx.x % 8) * (G_ / 8) + (int)blockIdx.x / 8 : (int)blockIdx.x; \
    const int gw = vcu_ * NWAVES + wave_, NGW = G_ * NWAVES, gt = vcu_ * NTHR + tid_, NGT = G_ * NTHR; (void)lane_; (void)gw; (void)NGW; (void)gt; (void)NGT;
#define p_x KIN(0)
#define p_g_mix KIN(1)
#define p_w_in KIN(2)
#define p_b_gate KIN(3)
#define p_w_pool_group KIN(4)
#define p_pool_scale KIN(5)
#define p_w_pool_out KIN(6)
#define p_conv_w KIN(7)
#define p_w_conv_out KIN(8)
#define p_w_o KIN(9)
#define p_g_ffn KIN(10)
#define p_w_router KIN(11)
#define p_router_bias KIN(12)
#define p_e_gate KIN(13)
#define p_e_up KIN(14)
#define p_e_down KIN(15)
#define p_s_gate KIN(16)
#define p_s_up KIN(17)
#define p_s_down KIN(18)
#define p_g_final KIN(19)
#define p_out KOUT
#define p_tope ((int*)(KWS + WS_TOPE))
#define p_topw ((float*)(KWS + WS_TOPW))
#define p_inv ((int*)(KWS + WS_INV))
#define p_rowtok ((int*)(KWS + WS_ROWTOK))
#define p_roww ((float*)(KWS + WS_ROWW))
#define p_off ((int*)(KWS + WS_OFF))
#define p_tilee ((int*)(KWS + WS_TILEE))
#define p_edt ((bf16*)(KWS + WS_EDT))
#define p_wtin ((bf16*)(KWS + WS_WTIN))
#define p_wtab ((bf16*)(KWS + WS_WTAB))
#define p_wto ((bf16*)(KWS + WS_WTO))
#define p_egut ((bf16*)(KWS + WS_EGUT))
#define p_H ((bf16*)(KWS + WS_H))
#define p_AB p_H
#define p_H2 p_H
#define p_ubcv ((bf16*)(KWS + WS_UBCV))
#define p_merged p_ubcv
#define p_gates ((bf16*)(KWS + WS_GATES))
#define p_hid ((bf16*)(KWS + WS_HID))
#define p_y ((unsigned char*)(KWS + WS_Y))

    for (int u = threadIdx.x; u < (LDS_BYTES - LDSCTL_OFF) / 4; u += NTHR) ((LAS unsigned*)(lds + LDSCTL_OFF))[u] = 0u;
    __syncthreads();
    XcdBarrier bar; bar.bar = (unsigned*)(CTL0 + CW_BAR); bar.x = 0; bar.st = nullptr;
    if (!MK_PER_PHASE) { bar = xcd_barrier_post((unsigned*)(CTL0 + CW_BAR), (volatile LAS unsigned*)(lds + MISC_OFF) + 8); xcd_barrier_setup(bar); }
    const int lo = args.ph_lo, hi = args.ph_hi; (void)lo; (void)hi;
#if MK_PER_PHASE
#define IN(k) (lo <= (k) && (k) < hi)
#else
#define IN(k) true
#endif
#define SEAM(k) do { if (IN(k) && IN((k) + 1)) xcd_barrier(bar, wv0_); } while (0)
#if REP_PHASE >= 0
#define REPS(k) for (int rep_ = 0; rep_ < ((k) == args.rep ? 2 : 1); ++rep_)
#define REPBAR() do { if (rep_) xcd_barrier(bar, wv0_); } while (0)
#else
    constexpr int rep_ = 0;
#define REPS(k)
#define REPBAR() do { } while (0)
#endif

    REPS(0) if (IN(0)) { REPBAR(); PHV();
        LAS unsigned char* scr = lds + wave_ * 9216;
        constexpr int I_IN = 16 * 64, I_CO = 8 * 16, I_O = 16 * 16, I_EG = 64 * 64, I_SG = 64, I_ED = 64 * 64, I_SD = 64;
        constexpr int NITEMS = I_IN + I_CO + I_O + 2 * I_EG + 2 * I_SG + I_ED + I_SD;
        for (int rr_ = 0; rr_ < (args.rep == 100 ? 2 : 1); ++rr_)
        for (int it = gw; it < NITEMS; it += NGW) {
            int r = it; const float* W; bf16* WT; int N, ldo, mode = 0;
            if (r < I_IN) { W = p_w_in; N = NIN; WT = p_wtin; ldo = D; }
            else if ((r -= I_IN) < I_CO) { W = p_w_conv_out; N = D; WT = p_wtab + 512; ldo = 1024; }
            else if ((r -= I_CO) < I_O) { W = p_w_o; N = D; WT = p_wto; ldo = D; }
            else if ((r -= I_O) < I_EG) { const int e = r >> 6; r &= 63; W = p_e_gate + (size_t)e * D * EH; N = EH; WT = p_egut + (size_t)e * 512 * D; ldo = D; mode = 1; }
            else if ((r -= I_EG) < I_EG) { const int e = r >> 6; r &= 63; W = p_e_up + (size_t)e * D * EH; N = EH; WT = p_egut + (size_t)e * 512 * D; ldo = D; mode = 2; }
            else if ((r -= I_EG) < I_SG) { W = p_s_gate; N = EH; WT = p_egut + (size_t)64 * 512 * D; ldo = D; mode = 1; }
            else if ((r -= I_SG) < I_SG) { W = p_s_up; N = EH; WT = p_egut + (size_t)64 * 512 * D; ldo = D; mode = 2; }
            else if ((r -= I_SG) < I_ED) { const int e = r >> 6; r &= 63; W = p_e_down + (size_t)e * EH * D; N = D; WT = p_edt + (size_t)e * D * EH; ldo = EH; }
            else { r -= I_ED; W = p_s_down; N = D; WT = p_edt + (size_t)64 * D * EH; ldo = EH; }
            p0_item64(W, N, WT, ldo, mode, scr, r, lane_);
        }
        for (int rr_ = 0; rr_ < (args.rep == 101 ? 2 : 1); ++rr_)
        for (int idx = gt; idx < 512 * (D / 4); idx += NGT) { const int k = idx >> 8, d4 = (idx & 255) * 4, gi = k >> 7; f32x4 s = (f32x4){0.f, 0.f, 0.f, 0.f};
            const float* wgp = p_w_pool_group + (size_t)k * 128; const float* scp = p_pool_scale + gi * 128; const float* wpo = p_w_pool_out + (size_t)(gi * 128) * D + d4;
#pragma unroll 8
            for (int j = 0; j < 128; ++j) { const float a = wgp[j] * scp[j]; s += *(const f32x4*)(wpo + (size_t)j * D) * a; }
            bf16* o = p_wtab + (size_t)d4 * 1024 + k;
            o[0] = (bf16)f2bf(s.x); o[1024] = (bf16)f2bf(s.y); o[2048] = (bf16)f2bf(s.z); o[3072] = (bf16)f2bf(s.w); }
        for (int rr_ = 0; rr_ < (args.rep == 102 ? 2 : 1); ++rr_)
        for (int m = gw; m < T; m += 4 * NGW) {
            f32x4 v[4][4]; const f32x4* gr = (const f32x4*)p_g_mix + lane_;
#pragma unroll
            for (int u = 0; u < 4; ++u) { const int mu = (m + u * NGW < T) ? m + u * NGW : m; const f32x4* xr = (const f32x4*)(p_x + (size_t)mu * D) + lane_;
#pragma unroll
                for (int j = 0; j < 4; ++j) v[u][j] = xr[64 * j]; }
#pragma unroll
            for (int u = 0; u < 4; ++u) { const int mu = (m + u * NGW < T) ? m + u * NGW : m; float s = 0.f;
#pragma unroll
                for (int j = 0; j < 4; ++j) s += (v[u][j].x * v[u][j].x + v[u][j].y * v[u][j].y) + (v[u][j].z * v[u][j].z + v[u][j].w * v[u][j].w);
                const float r = rsqrtf(wave_sum(s) * (1.0f / D) + EPS);
                u32x2* o = (u32x2*)(p_H + (size_t)mu * D) + lane_;
#pragma unroll
                for (int j = 0; j < 4; ++j) { const f32x4 gg = gr[64 * j]; u32x2 w; w.x = pk2(v[u][j].x * r * gg.x, v[u][j].y * r * gg.y); w.y = pk2(v[u][j].z * r * gg.z, v[u][j].w * r * gg.w); o[64 * j] = w; } }
        }
    }
    SEAM(0);
    REPS(1) if (IN(1)) { REPBAR(); PHV();
        pg8::RegOrder S; S.init(p_H, p_wtin, D, D, T, NIN, G_, (int)blockIdx.x, 1, 0);
        pg8::EpiS1 E{p_ubcv, p_gates, p_b_gate};
        { f32x4 acc_[2][2][4][2]; pg8::gemm_phase<pg8::EpiS1, pg8::RegOrder, true, true>(lds, S, E, D / 64, wave_, acc_); }
    }
    SEAM(1);
    REPS(2) if (IN(2)) { REPBAR(); PHV();
        for (int base = vcu_ * 64; base < T; base += G_ * 64) {
            const int c8 = (tid_ & 127) * 8, tb = base + (tid_ >> 7) * 16, s0 = tb & (SEQ - 1);
#define UNPK(v, e) do { e[0] = bflo(v.x); e[1] = bfhi(v.x); e[2] = bflo(v.y); e[3] = bfhi(v.y); e[4] = bflo(v.z); e[5] = bfhi(v.z); e[6] = bflo(v.w); e[7] = bfhi(v.w); } while (0)
            if (c8 < 512) {
                const int w = 2 << (c8 >> 7); float S[8];
#pragma unroll
                for (int i = 0; i < 8; ++i) S[i] = 0.f;
                const bf16* up = p_ubcv + (size_t)tb * 2048 + c8;
#pragma unroll
                for (int j = 1; j <= 16; ++j) { u32x4 v = (u32x4){0u, 0u, 0u, 0u}; if (j < w && s0 - j >= 0) v = *(const u32x4*)(up - (long)j * 2048); float e[8]; UNPK(v, e);
#pragma unroll
                    for (int i = 0; i < 8; ++i) S[i] += e[i]; }
#pragma unroll
                for (int i2 = 0; i2 < 16; ++i2) { const int sq = s0 + i2;
                    const u32x4 vc = *(const u32x4*)(up + (size_t)i2 * 2048); u32x4 vo = (u32x4){0u, 0u, 0u, 0u}; if (sq - w + 1 >= 0) vo = *(const u32x4*)(up + (long)(i2 - w + 1) * 2048);
                    float cur[8], old[8], o[8]; UNPK(vc, cur); UNPK(vo, old);
                    const int cnt = (sq + 1) < w ? (sq + 1) : w; const float rc = 1.0f / (float)cnt;
#pragma unroll
                    for (int i = 0; i < 8; ++i) { S[i] += cur[i]; o[i] = S[i] * rc - cur[i]; S[i] -= old[i]; }
                    u32x4 wv; wv.x = pk2(o[0], o[1]); wv.y = pk2(o[2], o[3]); wv.z = pk2(o[4], o[5]); wv.w = pk2(o[6], o[7]);
                    *(u32x4*)(p_AB + (size_t)(tb + i2) * 1024 + c8) = wv; }
            } else {
                const int c = c8 - 512; const bf16* bp = p_ubcv + (size_t)tb * 2048 + 512 + c;
                float w0[8], w1[8], w2[8], p1[8], p2[8];
                { const f32x4 a0 = *(const f32x4*)(p_conv_w + c), a1 = *(const f32x4*)(p_conv_w + c + 4), b0 = *(const f32x4*)(p_conv_w + 512 + c), b1 = *(const f32x4*)(p_conv_w + 512 + c + 4), c0 = *(const f32x4*)(p_conv_w + 1024 + c), c1 = *(const f32x4*)(p_conv_w + 1024 + c + 4);
                  w0[0] = a0.x; w0[1] = a0.y; w0[2] = a0.z; w0[3] = a0.w; w0[4] = a1.x; w0[5] = a1.y; w0[6] = a1.z; w0[7] = a1.w;
                  w1[0] = b0.x; w1[1] = b0.y; w1[2] = b0.z; w1[3] = b0.w; w1[4] = b1.x; w1[5] = b1.y; w1[6] = b1.z; w1[7] = b1.w;
                  w2[0] = c0.x; w2[1] = c0.y; w2[2] = c0.z; w2[3] = c0.w; w2[4] = c1.x; w2[5] = c1.y; w2[6] = c1.z; w2[7] = c1.w; }
#pragma unroll
                for (int j = 1; j <= 2; ++j) { u32x4 a = (u32x4){0u, 0u, 0u, 0u}, b2 = a; if (s0 - j >= 0) { a = *(const u32x4*)(bp + 512 - (long)j * 2048); b2 = *(const u32x4*)(bp + 1024 - (long)j * 2048); }
                    float ea[8], eb[8]; UNPK(a, ea); UNPK(b2, eb);
#pragma unroll
                    for (int i = 0; i < 8; ++i) { if (j == 1) p1[i] = ea[i] * eb[i]; else p2[i] = ea[i] * eb[i]; } }
#pragma unroll
                for (int i2 = 0; i2 < 16; ++i2) {
                    const u32x4 g = *(const u32x4*)(bp + (size_t)i2 * 2048), a = *(const u32x4*)(bp + 512 + (size_t)i2 * 2048), b2 = *(const u32x4*)(bp + 1024 + (size_t)i2 * 2048);
                    float eg[8], ea[8], eb[8], o[8]; UNPK(g, eg); UNPK(a, ea); UNPK(b2, eb);
#pragma unroll
                    for (int i = 0; i < 8; ++i) { const float p0 = ea[i] * eb[i]; o[i] = eg[i] * (w0[i] * p2[i] + w1[i] * p1[i] + w2[i] * p0); p2[i] = p1[i]; p1[i] = p0; }
                    u32x4 wv; wv.x = pk2(o[0], o[1]); wv.y = pk2(o[2], o[3]); wv.z = pk2(o[4], o[5]); wv.w = pk2(o[6], o[7]);
                    *(u32x4*)(p_AB + (size_t)(tb + i2) * 1024 + c8) = wv; }
            }
#undef UNPK
        }
    }
    SEAM(2);
    f32x4 accx[2][2][4][2];
    REPS(3) if (IN(3)) { REPBAR(); PHV();
        pg8::RegOrder S; S.init(p_AB, p_wtab, 1024, 1024, T, D, G_, (int)blockIdx.x, 1, 0);
        pg8::EpiS2B E{p_gates, p_merged};
        { f32x4 acc_[2][2][4][2]; pg8::gemm_phase<pg8::EpiS2B, pg8::RegOrder, true, true>(lds, S, E, 1024 / 64, wave_, acc_); }
#if REP_PHASE < 0 && !MK_PER_PHASE
        { pg8::RegOrder S4; S4.init(p_merged, p_wto, D, D, T, D, G_, (int)blockIdx.x, 1, 0); pg8::Unit u4; S4.next(0, u4); pg8::EpiS3 E4{p_x, p_out};
          E4.init(accx, u4, wave_ >> 2, wave_ & 3, lane_ & 15, lane_ >> 4); }
#endif
    }
    SEAM(3);
    REPS(4) if (IN(4)) { REPBAR(); PHV();
        pg8::RegOrder S; S.init(p_merged, p_wto, D, D, T, D, G_, (int)blockIdx.x, 1, 0);
        pg8::EpiS3 E{p_x, p_out};
#if !(REP_PHASE < 0 && !MK_PER_PHASE)
        { pg8::Unit u4; S.next(0, u4); E.init(accx, u4, wave_ >> 2, wave_ & 3, lane_ & 15, lane_ >> 4); }
#endif
        pg8::gemm_phase<pg8::EpiS3, pg8::RegOrder, true, true>(lds, S, E, D / 64, wave_, accx);
    }
    SEAM(4);
    REPS(5) if (IN(5)) { REPBAR(); PHV();
        LAS float* part = (LAS float*)lds;
        LAS float* ssqp = (LAS float*)(lds + 65536);
        LAS float* rt = (LAS float*)(lds + 65536 + 4096);
        LAS float* sc = (LAS float*)(lds + 65536 + 8192);
        LAS float* sel = (LAS float*)(lds + 65536 + 16384);
        LAS int* hist = (LAS int*)(lds + 65536 + 24576);
        for (int i = gt; i < MAXROWS; i += NGT) { p_rowtok[i] = 0; p_roww[i] = 0.f; }
        const int q_ = lane_ >> 4, r_ = lane_ & 15;
        u32x4 wh[4][4], wl[4][4];
#pragma unroll
        for (int s2 = 0; s2 < 4; ++s2)
#pragma unroll
            for (int j = 0; j < 8; ++j) { const int k = wave_ * 128 + 32 * s2 + 8 * q_ + j; const float gk = p_g_ffn[k];
#pragma unroll
                for (int nt2 = 0; nt2 < 4; ++nt2) { const float wv = gk * p_w_router[(size_t)k * NE + 16 * nt2 + r_]; const u32 hb = f2bf(wv); const u32 lb = f2bf(wv - __uint_as_float(hb << 16));
                    if (j & 1) { wh[nt2][s2][j >> 1] |= hb << 16; wl[nt2][s2][j >> 1] |= lb << 16; } else { wh[nt2][s2][j >> 1] = hb; wl[nt2][s2][j >> 1] = lb; } } }
        if (tid_ < 64) hist[tid_] = 0;
        for (int it = vcu_; it < T / 32; it += G_) {
            const int t0 = it * 32;
#pragma unroll
            for (int rb = 0; rb < 2; ++rb) {
                f32x4 xa[8];
#pragma unroll
                for (int j = 0; j < 8; ++j) xa[j] = *(const f32x4*)(p_out + (size_t)(t0 + 16 * rb + r_) * D + wave_ * 128 + 32 * (j >> 1) + 8 * q_ + 4 * (j & 1));
                f32x4 acc[4]; float ss = 0.f;
#pragma unroll
                for (int nt2 = 0; nt2 < 4; ++nt2) acc[nt2] = (f32x4){0.f, 0.f, 0.f, 0.f};
#pragma unroll
                for (int s2 = 0; s2 < 4; ++s2) { u32x4 ahp, alp;
#pragma unroll
                    for (int j2 = 0; j2 < 4; ++j2) { const float x0 = xa[2 * s2 + (j2 >> 1)][2 * (j2 & 1)], x1 = xa[2 * s2 + (j2 >> 1)][2 * (j2 & 1) + 1]; ss += x0 * x0 + x1 * x1;
                        const u32 h0 = f2bf(x0), h1 = f2bf(x1); ahp[j2] = h0 | (h1 << 16); alp[j2] = f2bf(x0 - __uint_as_float(h0 << 16)) | (f2bf(x1 - __uint_as_float(h1 << 16)) << 16); }
                    const bf16x8 ah = __builtin_bit_cast(bf16x8, ahp), al = __builtin_bit_cast(bf16x8, alp);
#pragma unroll
                    for (int nt2 = 0; nt2 < 4; ++nt2) { const bf16x8 bh = __builtin_bit_cast(bf16x8, wh[nt2][s2]), bl = __builtin_bit_cast(bf16x8, wl[nt2][s2]);
                        acc[nt2] = __builtin_amdgcn_mfma_f32_16x16x32_bf16(al, bh, acc[nt2], 0, 0, 0);
                        acc[nt2] = __builtin_amdgcn_mfma_f32_16x16x32_bf16(ah, bl, acc[nt2], 0, 0, 0);
                        acc[nt2] = __builtin_amdgcn_mfma_f32_16x16x32_bf16(ah, bh, acc[nt2], 0, 0, 0); } }
#pragma unroll
                for (int nt2 = 0; nt2 < 4; ++nt2)
#pragma unroll
                    for (int g = 0; g < 4; ++g) part[(wave_ * 32 + 16 * rb + 4 * q_ + g) * 64 + 16 * nt2 + r_] = acc[nt2][g];
                ssqp[(wave_ * 4 + q_) * 32 + 16 * rb + r_] = ss;
            }
            __syncthreads();
            if (tid_ < 32) { float s2 = 0.f;
#pragma unroll
                for (int i = 0; i < 32; ++i) s2 += ssqp[i * 32 + tid_];
                rt[tid_] = rsqrtf(s2 * (1.0f / D) + EPS); }
            __syncthreads();
#pragma unroll
            for (int j = 0; j < 4; ++j) { const int o = tid_ + NTHR * j, t = o >> 6, e = o & 63; float lg = 0.f;
#pragma unroll
                for (int k2 = 0; k2 < 8; ++k2) lg += part[(k2 * 32 + t) * 64 + e];
                const float sg = sigmoid_acc(lg * rt[t]); sc[t * 64 + e] = sg; sel[t * 64 + e] = sg + p_router_bias[e]; }
#pragma unroll
            for (int rb = 0; rb < 2; ++rb) { const float rr = rt[16 * rb + r_];
#pragma unroll
                for (int j = 0; j < 8; ++j) { const int k = wave_ * 128 + 16 * j + 4 * q_; const f32x4 gg = *(const f32x4*)(p_g_ffn + k); const f32x4 xv = *(const f32x4*)(p_out + (size_t)(t0 + 16 * rb + r_) * D + k);
                    u32x2 w; w.x = pk2(xv.x * rr * gg.x, xv.y * rr * gg.y); w.y = pk2(xv.z * rr * gg.z, xv.w * rr * gg.w);
                    *(u32x2*)(p_H2 + (size_t)(t0 + 16 * rb + r_) * D + k) = w; } }
            __syncthreads();
#pragma unroll
            for (int tt = 0; tt < 4; ++tt) {
                const int t = wave_ * 4 + tt, tok = t0 + t; const float v = sel[t * 64 + lane_]; const float sv = sc[t * 64 + lane_];
                const unsigned vb = __float_as_uint(v); const unsigned key = (vb & 0x80000000u) ? ~vb : (vb | 0x80000000u);
                unsigned thr = 0u;
#pragma unroll
                for (int bit = 31; bit >= 0; --bit) { const unsigned cand = thr | (1u << bit); if (__popcll(__ballot(key >= cand)) >= TOPK) thr = cand; }
                const unsigned long long gtm = __ballot(key > thr), eqm = __ballot(key == thr);
                const int need = TOPK - (int)__popcll(gtm);
                const int eqbelow = (int)__builtin_amdgcn_mbcnt_hi((unsigned)(eqm >> 32), __builtin_amdgcn_mbcnt_lo((unsigned)eqm, 0u));
                const bool pick = (key > thr) || (key == thr && eqbelow < need);
                const unsigned long long pm = __ballot(pick);
                const int slot = (int)__builtin_amdgcn_mbcnt_hi((unsigned)(pm >> 32), __builtin_amdgcn_mbcnt_lo((unsigned)pm, 0u));
                const float wsum = wave_sum(pick ? sv : 0.f);
                if (pick) { p_tope[tok * 8 + slot] = lane_; p_topw[tok * 8 + slot] = sv / wsum * ROUTED_SCALE; __hip_atomic_fetch_add(&hist[lane_], 1, __ATOMIC_RELAXED, __HIP_MEMORY_SCOPE_WORKGROUP); }
            }
            __syncthreads();
            if (tid_ < 64) { const int hv = hist[tid_]; if (hv) { if (rep_ == 0) atomicAdd(&CTL[CW_CNT + tid_], (u32)hv); hist[tid_] = 0; } }
            __syncthreads();
        }
    }
    SEAM(5);
    REPS(6) if (IN(6)) { REPBAR(); PHV();
        LAS int* so = (LAS int*)lds;
        LAS int* lh = so + 128;
        LAS int* bs = so + 256;
        if (wave_ == 0) {
            const int pc = ((int)__hip_atomic_load(&CTL[CW_CNT + lane_], RLX_AGENT) + 255) & ~255; int inc = pc;
#pragma unroll
            for (int o = 1; o < 64; o <<= 1) { const int nb = __builtin_amdgcn_ds_bpermute(((lane_ - o) & 63) << 2, inc); if (lane_ >= o) inc += nb; }
            so[lane_] = inc - pc; if (lane_ == 63) so[64] = inc; }
        __syncthreads();
        const int total = so[64];
        if (blockIdx.x == 0) {
            if (tid_ < 65) p_off[tid_] = so[tid_];
            if (tid_ < 64) { for (int rt = so[tid_] >> 8; rt < (so[tid_ + 1] >> 8); ++rt) p_tilee[rt] = tid_; p_tilee[(total >> 8) + tid_] = 64; }
        }
        for (int i = gt; i < T; i += NGT) { p_rowtok[total + i] = i; p_roww[total + i] = 1.0f; }
        for (int c0 = vcu_ * NTHR; c0 < T * TOPK; c0 += G_ * NTHR) {
            if (tid_ < 64) lh[tid_] = 0;
            __syncthreads();
            const int i = c0 + tid_; const int e = p_tope[i];
            const int lr = __hip_atomic_fetch_add(&lh[e], 1, __ATOMIC_RELAXED, __HIP_MEMORY_SCOPE_WORKGROUP);
            __syncthreads();
            if (tid_ < 64) { const int n = lh[tid_]; bs[tid_] = so[tid_] + (n ? (int)atomicAdd(&CTL[CW_CUR + 64 * rep_ + tid_], (u32)n) : 0); }
            __syncthreads();
            const int pos = bs[e] + lr;
            p_rowtok[pos] = i >> 3; p_roww[pos] = p_topw[i]; p_inv[i] = pos;
            __syncthreads();
        }
    }
    SEAM(6);
    REPS(7) if (IN(7)) { REPBAR(); PHV();
        const int total = __builtin_amdgcn_readfirstlane(ld_agent(p_off + 64));
        LAS int* tl_ = (LAS int*)(lds + LDSCTL_OFF + 1024);
        for (int i = tid_; i < (total >> 8) + 64; i += NTHR) tl_[i] = ld_agent(p_tilee + i);
        __syncthreads();
        LAS unsigned* ro_ = (LAS unsigned*)(lds + LDSCTL_OFF + 4096);
        pg8::MoeOrder<true> S; S.A = (const char*)p_H2; S.Bt = (const char*)p_egut; S.lda = D; S.ldb = D; S.rowoff = ro_; S.tilee = tl_;
        S.npn = 2; S.nunits = ((total >> 8) + 64) * 2; S.G = G_; S.c = (int)blockIdx.x; S.estride = (size_t)512 * D * 2; S.bextra = 0;
        { pg8::Unit u_; for (int i = 0; i < 8 && S.next(i, u_); ++i) if (tid_ < 256) ro_[i * 256 + tid_] = (unsigned)p_rowtok[u_.pm * 256 + tid_] * (unsigned)(D * 2); }
        __syncthreads();
        pg8::EpiS5 E{p_hid, p_roww};
        { f32x4 acc_[2][2][4][2]; pg8::gemm_phase<pg8::EpiS5, pg8::MoeOrder<true>, true, true>(lds, S, E, D / 64, wave_, acc_); }
    }
    SEAM(7);
    REPS(8) if (IN(8)) { REPBAR(); PHV();
        const int total = __builtin_amdgcn_readfirstlane(ld_agent(p_off + 64));
        LAS int* tl_ = (LAS int*)(lds + LDSCTL_OFF + 1024);
        if (MK_PER_PHASE) { for (int i = tid_; i < (total >> 8) + 64; i += NTHR) tl_[i] = ld_agent(p_tilee + i); __syncthreads(); }
        pg8::MoeOrder<false> S; S.A = (const char*)p_hid; S.Bt = (const char*)p_edt; S.lda = EH; S.ldb = EH; S.rowoff = nullptr; S.tilee = tl_;
        S.npn = 4; S.nunits = ((total >> 8) + 64) * 4; S.G = G_; S.c = (int)blockIdx.x; S.estride = (size_t)D * EH * 2; S.bextra = 0;
        pg8::EpiS6 E{p_y, (REP_PHASE >= 0 && rep_ == 1 && args.exb == 1) ? 1 : 0};
        { f32x4 acc_[2][2][4][2]; pg8::gemm_phase<pg8::EpiS6, pg8::MoeOrder<false>, true, true>(lds, S, E, EH / 64, wave_, acc_); }
    }
    SEAM(8);
    REPS(9) if (IN(9)) { REPBAR(); PHV();
        const int total = __builtin_amdgcn_readfirstlane(ld_agent(p_off + 64));
        const bool dry = (REP_PHASE >= 0) && (args.rep == 9) && rep_ == 0;
        typedef float f32x2_ __attribute__((ext_vector_type(2)));
        for (int tb = gw; tb < T; tb += 2 * NGW) {
            float a[2][16]; int pos[2]; float* o[2];
#pragma unroll
            for (int u = 0; u < 2; ++u) { const int t = (tb + u * NGW < T) ? tb + u * NGW : tb; o[u] = p_out + (size_t)t * D + lane_ * 16; pos[u] = (lane_ < 8) ? p_inv[t * 8 + lane_] : total + t; }
#pragma unroll
            for (int u = 0; u < 2; ++u)
#pragma unroll
                for (int i = 0; i < 4; ++i) { const f32x4 p = *(const f32x4*)(o[u] + 4 * i); a[u][4 * i] = p.x; a[u][4 * i + 1] = p.y; a[u][4 * i + 2] = p.z; a[u][4 * i + 3] = p.w; }
#pragma unroll
            for (int k = 0; k < 9; ++k)
#pragma unroll
                for (int u = 0; u < 2; ++u) { const int p = __builtin_amdgcn_readlane(pos[u], k); const u32x4 v = *(const u32x4*)(p_y + (size_t)p * 1024 + lane_ * 16);
#pragma unroll
                    for (int i = 0; i < 4; ++i) { const f32x2_ d0 = __builtin_amdgcn_cvt_pk_f32_fp8((int)v[i], false), d1 = __builtin_amdgcn_cvt_pk_f32_fp8((int)v[i], true);
                        a[u][4 * i] += d0.x * pg8::Y_UNSCALE; a[u][4 * i + 1] += d0.y * pg8::Y_UNSCALE; a[u][4 * i + 2] += d1.x * pg8::Y_UNSCALE; a[u][4 * i + 3] += d1.y * pg8::Y_UNSCALE; } }
#pragma unroll
            for (int u = 0; u < 2; ++u) {
                if (u == 1 && tb + NGW >= T) break;
                float ssq = 0.f;
#pragma unroll
                for (int i = 0; i < 16; ++i) ssq += a[u][i] * a[u][i];
                const float r = rsqrtf(wave_sum(ssq) * (1.0f / D) + EPS);
                if (dry && a[u][0] != 123456.789f) continue;
#pragma unroll
                for (int i = 0; i < 4; ++i) { const f32x4 g = *(const f32x4*)(p_g_final + lane_ * 16 + 4 * i);
                    *(f32x4*)(o[u] + 4 * i) = (f32x4){a[u][4 * i] * r * g.x, a[u][4 * i + 1] * r * g.y, a[u][4 * i + 2] * r * g.z, a[u][4 * i + 3] * r * g.w}; }
            }
        }
    }
#undef IN
#undef SEAM
}


#undef p_x
constexpr int N_PHASES = 10;
extern "C" void kernel_launch(void* const* d_in, const int* in_sizes, int n_in, void* d_out, int out_size, void* d_ws, size_t ws_size, hipStream_t stream) {
    static int grid = 0;
    if (grid == 0) {
        if (n_in != 20 || ws_size < WS_END || out_size != T * D) { fprintf(stderr, "kernel_launch: unexpected shapes / workspace (%zu)\n", ws_size); grid = -1; return; }
        int dev = 0, cus = 0;
        if (hipGetDevice(&dev) != hipSuccess || hipDeviceGetAttribute(&cus, hipDeviceAttributeMultiprocessorCount, dev) != hipSuccess) { grid = -1; return; }
        if (hipFuncSetAttribute((const void*)mega_fwd, hipFuncAttributeMaxDynamicSharedMemorySize, LDS_BYTES) != hipSuccess) { fprintf(stderr, "kernel_launch: hipFuncSetAttribute failed\n"); grid = -1; return; }
        int per_cu = 0;
        if (hipOccupancyMaxActiveBlocksPerMultiprocessor(&per_cu, (const void*)mega_fwd, NTHR, LDS_BYTES) != hipSuccess || per_cu < 1) { fprintf(stderr, "kernel_launch: occupancy query says %d\n", per_cu); }
        (void)hipGetLastError();
        grid = cus;
    }
    if (grid < 0) return;
    if (hipMemsetAsync((char*)d_ws + WS_CTL, 0, CTL_BYTES, stream) != hipSuccess) return;
    Args a{};
    for (int i = 0; i < 20; ++i) a.in[i] = (const float*)d_in[i];
    a.out = (float*)d_out; a.ws = (unsigned char*)d_ws; a.rep = REP_PHASE; a.stag = STAG_G2; a.exb = PROBE_DRY;
#if MK_PER_PHASE
    for (int p = 0; p < N_PHASES; ++p) { a.ph_lo = p; a.ph_hi = p + 1; hipLaunchKernelGGL(mega_fwd, dim3(grid), dim3(NTHR), LDS_BYTES, stream, a); }
#else
    a.ph_lo = 0; a.ph_hi = N_PHASES;
    hipLaunchKernelGGL(mega_fwd, dim3(grid), dim3(NTHR), LDS_BYTES, stream, a);
#endif
}
```

```cpp
#include <hip/hip_runtime.h>
#include <stdint.h>
#include <cstdio>

#ifndef STAG_G2
#define STAG_G2 0
#endif
#ifndef PROBE_DRY
#define PROBE_DRY 0
#endif
#ifndef REP_PHASE
#define REP_PHASE -1
#endif
#ifndef MK_PER_PHASE
#define MK_PER_PHASE 0
#endif

typedef unsigned short bf16;
typedef unsigned int u32;
#define GAS __attribute__((address_space(1)))
#define LAS __attribute__((address_space(3)))
typedef float f32x4 __attribute__((ext_vector_type(4)));
typedef short bf16x8 __attribute__((ext_vector_type(8)));
typedef unsigned u32x4 __attribute__((ext_vector_type(4)));
typedef unsigned u32x2 __attribute__((ext_vector_type(2)));
#define RLX_AGENT __ATOMIC_RELAXED, __HIP_MEMORY_SCOPE_AGENT

constexpr int T = 16384, D = 1024, SEQ = 2048, NIN = 4096;
constexpr int NE = 64, TOPK = 8, EH = 256;
constexpr float EPS = 1e-6f, ROUTED_SCALE = 2.5f;
constexpr int MAXROWS = T * TOPK + NE * 256 + T;
constexpr int NWAVES = 8, NTHR = 512;

constexpr size_t MiB = 1u << 20;
constexpr size_t WS_CTL = 0, CTL_BYTES = 32768;
constexpr size_t WS_TOPE = 1 * MiB;
constexpr size_t WS_TOPW = WS_TOPE + 512 * 1024;
constexpr size_t WS_INV = WS_TOPW + 512 * 1024;
constexpr size_t WS_ROWTOK = WS_INV + 512 * 1024;
constexpr size_t WS_ROWW = WS_ROWTOK + 640 * 1024;
constexpr size_t WS_OFF = WS_ROWW + 1280 * 1024;
constexpr size_t WS_TILEE = WS_OFF + 1024;
constexpr size_t WS_RT = WS_TILEE + 4096;
constexpr int ECAP = T;
constexpr size_t WS_EDT = 5 * MiB;
constexpr size_t WS_WTIN = 38 * MiB;
constexpr size_t WS_WTAB = 46 * MiB;
constexpr size_t WS_WTO = 48 * MiB;
constexpr size_t WS_EGUT = 51 * MiB;
constexpr size_t WS_H = 116 * MiB;
constexpr size_t WS_UBCV = 148 * MiB;
constexpr size_t WS_GATES = 212 * MiB;
constexpr size_t WS_HID = 203 * MiB;
constexpr size_t WS_Y = 38 * MiB;
constexpr size_t WS_END = 283 * MiB;
static_assert(WS_RT + (size_t)T * 4 <= WS_EDT, "tables");
static_assert(WS_EDT + (size_t)65 * 1024 * 256 * 2 <= WS_WTIN, "edt");
static_assert(WS_EGUT + (size_t)65 * 512 * 1024 * 2 <= WS_H, "egut");
static_assert(WS_HID + (size_t)MAXROWS * 256 * 2 <= WS_END, "hid");
static_assert(WS_Y + (size_t)MAXROWS * 1024 <= WS_HID, "y");
static_assert(WS_GATES + (size_t)T * 2048 * 2 <= WS_END, "gates");
constexpr int CW_CNT = 0, CW_CUR = 64;
constexpr int CW_BAR = 4096;

constexpr int RING_BYTES = 131072;
constexpr int LDSCTL_OFF = RING_BYTES, MISC_OFF = LDSCTL_OFF + 320;
constexpr int LDS_BYTES = 163840;

__device__ __forceinline__ float bf2f(bf16 b) { return __uint_as_float(((u32)b) << 16); }
__device__ __forceinline__ float bflo(u32 w) { return __uint_as_float(w << 16); }
__device__ __forceinline__ float bfhi(u32 w) { return __uint_as_float(w & 0xffff0000u); }
__device__ __forceinline__ u32 f2bf(float f) { u32 u = __float_as_uint(f); return (u + 0x7fffu + ((u >> 16) & 1u)) >> 16; }
__device__ __forceinline__ u32 pk2(float lo, float hi) { return f2bf(lo) | (f2bf(hi) << 16); }
__device__ __forceinline__ float sigmoid_fast(float x) { return __builtin_amdgcn_rcpf(1.0f + __expf(-x)); }
__device__ __forceinline__ float sigmoid_acc(float x) { return 1.0f / (1.0f + expf(-x)); }
__device__ __forceinline__ float wave_sum(float v) {
    v += __int_as_float(__builtin_amdgcn_ds_swizzle(__float_as_int(v), (1 << 10) | 0x1f));
    v += __int_as_float(__builtin_amdgcn_ds_swizzle(__float_as_int(v), (2 << 10) | 0x1f));
    v += __int_as_float(__builtin_amdgcn_ds_swizzle(__float_as_int(v), (4 << 10) | 0x1f));
    v += __int_as_float(__builtin_amdgcn_ds_swizzle(__float_as_int(v), (8 << 10) | 0x1f));
    v += __int_as_float(__builtin_amdgcn_ds_swizzle(__float_as_int(v), (16 << 10) | 0x1f));
    return __int_as_float(__builtin_amdgcn_readlane(__float_as_int(v), 0)) + __int_as_float(__builtin_amdgcn_readlane(__float_as_int(v), 32));
}
#define LDS_WAIT() asm volatile("s_waitcnt lgkmcnt(0)" ::: "memory")
#define VM_WAIT() asm volatile("s_waitcnt vmcnt(0)" ::: "memory")
__device__ __forceinline__ int ld_agent(const int* p) { return (int)__hip_atomic_load((const u32*)p, RLX_AGENT); }

namespace pg8 {
constexpr int BM = 256, BK = 64, HALF = 128, HTB = HALF * BK * 2, STAGE_BYTES = 8 * HTB, NXCD = 8, WGM = 8;
__host__ __device__ __forceinline__ int lds_byte(int r, int c) { const int st = (r >> 4) * 2 + (c >> 5), rr = r & 15, cc = c & 31, ob = rr * 64 + cc * 2; return st * 1024 + (ob ^ (((ob >> 9) & 1) << 5)); }
__host__ __device__ __forceinline__ void stage_rc(int b, int& R, int& C) { const int st = b / 1024, sb = b % 1024, swz = sb ^ (((sb >> 9) & 1) << 5); R = (st >> 1) * 16 + swz / 64; C = (st & 1) * 32 + (swz % 64) / 2; }
__host__ __device__ __forceinline__ int perm32(int rho) { const int n = rho >> 4, i = rho & 15; return 8 * (i >> 2) + 4 * n + (i & 3); }

struct Unit { int pm, pn, aux, li; };

__device__ __forceinline__ int xcd_remap(int L, int nwg) { const int q = nwg / NXCD, r = nwg % NXCD, xcd = L % NXCD, o = L / NXCD; return (xcd < r ? xcd * (q + 1) : r * (q + 1) + (xcd - r) * q) + o; }

struct RegOrder {
    static constexpr bool GATHER = false;
    const char* A; const char* Bt; int lda, ldb;
    int nM, nN, nwg, G, c, halves, khalf;
    __device__ __forceinline__ void init(const void* A_, const void* Bt_, int lda_, int ldb_, int M, int N, int G_, int c_, int halves_, int khalf_) {
        A = (const char*)A_; Bt = (const char*)Bt_; lda = lda_; ldb = ldb_; nM = M / BM; nN = N / BM; nwg = nM * nN; G = G_; c = c_; halves = halves_; khalf = khalf_; }
    __device__ __forceinline__ bool next(int i, Unit& u) const {
        const int round = (halves == 2) ? (i >> 1) : i; u.aux = (halves == 2) ? (i & 1) : 0;
        const long L = (long)round * G + c; if (L >= nwg) return false;
        const int wgid = xcd_remap((int)L, nwg);
        const int nig = WGM * nN, gid = wgid / nig, fm = gid * WGM, gsz = (nM - fm) < WGM ? (nM - fm) : WGM;
        u.pm = fm + ((wgid % nig) % gsz); u.pn = (wgid % nig) / gsz; u.li = i; return true;
    }
    __device__ __forceinline__ const char* a_base(const Unit& u) const { return A + (size_t)u.pm * BM * lda * 2 + (size_t)u.aux * khalf; }
    __device__ __forceinline__ const char* b_base(const Unit& u) const { return Bt + (size_t)u.pn * BM * ldb * 2 + (size_t)u.aux * khalf; }
    __device__ __forceinline__ unsigned a_row_off(const Unit&, int) const { return 0u; }
};
template <bool GATHER_> struct MoeOrder {
    static constexpr bool GATHER = GATHER_;
    const char* A; const char* Bt; int lda, ldb; const LAS unsigned* rowoff; const LAS int* tilee; int nunits, npn, G, c; size_t estride, bextra;
    __device__ __forceinline__ bool next(int i, Unit& u) const {
        const long L = (long)i * G + c; if (L >= nunits) return false;
        const int wgid = xcd_remap((int)L, nunits);
        u.pm = wgid / npn; u.pn = wgid - u.pm * npn; u.aux = __builtin_amdgcn_readfirstlane(tilee[u.pm]); u.li = i; return true;
    }
    __device__ __forceinline__ const char* a_base(const Unit& u) const { return GATHER ? A : A + (size_t)u.pm * BM * lda * 2; }
    __device__ __forceinline__ const char* b_base(const Unit& u) const { return Bt + (size_t)u.aux * estride + bextra + (size_t)u.pn * BM * ldb * 2; }
    __device__ __forceinline__ unsigned a_row_off(const Unit& u, int r) const { return rowoff[u.li * BM + r]; }
};

template <class TT> __device__ __forceinline__ TT* at(const void* base, unsigned byteoff) { return (TT*)((const char*)base + byteoff); }
__device__ __forceinline__ unsigned cvt_pk_bf16(float lo, float hi) { unsigned r; asm volatile("v_cvt_pk_bf16_f32 %0, %1, %2" : "=v"(r) : "v"(lo), "v"(hi)); return r; }

struct EpiS1 { static constexpr bool PERM16 = false, PERM = true, MID = false, INIT = false; static constexpr int NVM = 8;
    bf16* ubcv; bf16* gates; const float* bgate;
    __device__ __forceinline__ void operator()(const f32x4 (&acc)[2][2][4][2], const Unit& u, int wr, int wc, int fr, int fq) const {
        asm volatile("" : "+v"(fr), "+v"(fq));
        const int row0 = u.pm * BM + wr * 64 + fr;
        if (u.pn < 4) {
            const int col0 = u.pn * BM + wc * 32 + 8 * fq;
#pragma unroll
            for (int ai = 0; ai < 2; ++ai)
#pragma unroll
                for (int m = 0; m < 4; ++m) { const unsigned ro = ((unsigned)(row0 + ai * HALF + m * 16) * 2048u + (unsigned)col0) * 2u;
#pragma unroll
                    for (int bj = 0; bj < 2; ++bj) { const f32x4 v0 = acc[ai][bj][m][0], v1 = acc[ai][bj][m][1];
                        u32x4 w; w.x = cvt_pk_bf16(v0[0], v0[1]); w.y = cvt_pk_bf16(v0[2], v0[3]); w.z = cvt_pk_bf16(v1[0], v1[1]); w.w = cvt_pk_bf16(v1[2], v1[3]);
                        *at<u32x4>(ubcv, ro + bj * HALF * 2) = w; }
                    asm volatile("" ::: "memory"); }
        } else if (u.pn < 8) {
            const int col0 = 1024 + (u.pn - 4) * HALF + wc * 32 + 8 * fq;
#pragma unroll
            for (int ai = 0; ai < 2; ++ai)
#pragma unroll
                for (int m = 0; m < 4; ++m) { const unsigned ro = ((unsigned)(row0 + ai * HALF + m * 16) * 2048u + (unsigned)col0) * 2u;
                    const f32x4 p0 = acc[ai][0][m][0] * acc[ai][1][m][0], p1 = acc[ai][0][m][1] * acc[ai][1][m][1];
                    u32x4 w; w.x = cvt_pk_bf16(p0[0], p0[1]); w.y = cvt_pk_bf16(p0[2], p0[3]); w.z = cvt_pk_bf16(p1[0], p1[1]); w.w = cvt_pk_bf16(p1[2], p1[3]);
                    *at<u32x4>(ubcv, ro) = w;
                    asm volatile("" ::: "memory"); }
        } else {
            const int col0 = (u.pn - 8) * HALF + wc * 32 + 8 * fq;
            f32x4 ba[2], bb[2];
#pragma unroll
            for (int n = 0; n < 2; ++n) { ba[n] = *at<const f32x4>(bgate, (unsigned)(col0 + 4 * n) * 4u); bb[n] = *at<const f32x4>(bgate, (unsigned)(1024 + col0 + 4 * n) * 4u); }
#pragma unroll
            for (int ai = 0; ai < 2; ++ai)
#pragma unroll
                for (int m = 0; m < 4; ++m) { const unsigned ro = ((unsigned)(row0 + ai * HALF + m * 16) * 2048u + (unsigned)col0) * 2u;
                    f32x4 rt[2], gb[2];
#pragma unroll
                    for (int n = 0; n < 2; ++n)
#pragma unroll
                        for (int j = 0; j < 4; ++j) { const float ea = __expf(-(acc[ai][0][m][n][j] + ba[n][j])), eb = __expf(-(acc[ai][1][m][n][j] + bb[n][j]));
                            gb[n][j] = __builtin_amdgcn_rcpf(1.0f + eb); rt[n][j] = (1.0f + eb) * __builtin_amdgcn_rcpf(1.0f + ea); }
                    u32x4 w; w.x = cvt_pk_bf16(rt[0][0], rt[0][1]); w.y = cvt_pk_bf16(rt[0][2], rt[0][3]); w.z = cvt_pk_bf16(rt[1][0], rt[1][1]); w.w = cvt_pk_bf16(rt[1][2], rt[1][3]);
                    *at<u32x4>(gates, ro) = w;
                    w.x = cvt_pk_bf16(gb[0][0], gb[0][1]); w.y = cvt_pk_bf16(gb[0][2], gb[0][3]); w.z = cvt_pk_bf16(gb[1][0], gb[1][1]); w.w = cvt_pk_bf16(gb[1][2], gb[1][3]);
                    *at<u32x4>(gates, ro + 2048u) = w;
                    asm volatile("" ::: "memory"); }
        }
    }
};
struct EpiS2B { static constexpr bool PERM16 = false, PERM = true, MID = true, INIT = false; static constexpr int NVM = 16;
    const bf16* gates; bf16* merged;
    __device__ __forceinline__ void mid(f32x4 (&acc)[2][2][4][2], const Unit& u, int wr, int wc, int fr, int fq) const {
        asm volatile("" : "+v"(fr), "+v"(fq));
        const int row0 = u.pm * BM + wr * 64 + fr, col0 = u.pn * BM + wc * 32 + 8 * fq;
#pragma unroll
        for (int ai = 0; ai < 2; ++ai)
#pragma unroll
            for (int m = 0; m < 4; ++m) { const unsigned go = ((unsigned)(row0 + ai * HALF + m * 16) * 2048u + (unsigned)col0) * 2u;
#pragma unroll
                for (int bj = 0; bj < 2; ++bj) { const u32x4 a = *at<const u32x4>(gates, go + bj * HALF * 2);
                    f32x4& v0 = acc[ai][bj][m][0]; f32x4& v1 = acc[ai][bj][m][1];
                    v0[0] *= bflo(a.x); v0[1] *= bfhi(a.x); v0[2] *= bflo(a.y); v0[3] *= bfhi(a.y); v1[0] *= bflo(a.z); v1[1] *= bfhi(a.z); v1[2] *= bflo(a.w); v1[3] *= bfhi(a.w); }
                asm volatile("" ::: "memory"); }
    }
    __device__ __forceinline__ void operator()(const f32x4 (&acc)[2][2][4][2], const Unit& u, int wr, int wc, int fr, int fq) const {
        asm volatile("" : "+v"(fr), "+v"(fq));
        const int row0 = u.pm * BM + wr * 64 + fr, col0 = u.pn * BM + wc * 32 + 8 * fq;
#pragma unroll
        for (int ai = 0; ai < 2; ++ai)
#pragma unroll
            for (int m = 0; m < 4; ++m) { const unsigned r = (unsigned)(row0 + ai * HALF + m * 16);
#pragma unroll
                for (int bj = 0; bj < 2; ++bj) { const int c = col0 + bj * HALF;
                    const u32x4 g = *at<const u32x4>(gates, (r * 2048u + 1024u + (unsigned)c) * 2u);
                    f32x4 v0 = acc[ai][bj][m][0], v1 = acc[ai][bj][m][1];
                    v0[0] *= bflo(g.x); v0[1] *= bfhi(g.x); v0[2] *= bflo(g.y); v0[3] *= bfhi(g.y); v1[0] *= bflo(g.z); v1[1] *= bfhi(g.z); v1[2] *= bflo(g.w); v1[3] *= bfhi(g.w);
                    u32x4 w; w.x = cvt_pk_bf16(v0[0], v0[1]); w.y = cvt_pk_bf16(v0[2], v0[3]); w.z = cvt_pk_bf16(v1[0], v1[1]); w.w = cvt_pk_bf16(v1[2], v1[3]);
                    *at<u32x4>(merged, (r * 1024u + (unsigned)c) * 2u) = w; }
                asm volatile("" ::: "memory"); }
    }
};
constexpr int XM_PITCH = 2048;
struct EpiS3 { static constexpr bool PERM16 = false, PERM = true, MID = false, INIT = true; static constexpr int NVM = 16;
    const float* x; bf16* xm;
    __device__ __forceinline__ void init(f32x4 (&acc)[2][2][4][2], const Unit& u, int wr, int wc, int fr, int fq) const {
        asm volatile("" : "+v"(fr), "+v"(fq));
        const int row0 = u.pm * BM + wr * 64 + fr, col0 = u.pn * BM + wc * 32 + 8 * fq;
#pragma unroll
        for (int ai = 0; ai < 2; ++ai)
#pragma unroll
            for (int m = 0; m < 4; ++m) { const unsigned o = ((unsigned)(row0 + ai * HALF + m * 16) * (unsigned)D + (unsigned)col0) * 4u;
#pragma unroll
                for (int bj = 0; bj < 2; ++bj)
#pragma unroll
                    for (int n = 0; n < 2; ++n) acc[ai][bj][m][n] = __builtin_nontemporal_load(at<const f32x4>(x, o + (bj * HALF + n * 4) * 4)); }
    }
    __device__ __forceinline__ void operator()(const f32x4 (&acc)[2][2][4][2], const Unit& u, int wr, int wc, int fr, int fq) const {
        asm volatile("" : "+v"(fr), "+v"(fq));
        const int row0 = u.pm * BM + wr * 64 + fr, col0 = u.pn * BM + wc * 32 + 8 * fq;
#pragma unroll
        for (int ai = 0; ai < 2; ++ai)
#pragma unroll
            for (int m = 0; m < 4; ++m) { const unsigned ro = ((unsigned)(row0 + ai * HALF + m * 16) * (unsigned)XM_PITCH + (unsigned)col0) * 2u;
#pragma unroll
                for (int bj = 0; bj < 2; ++bj) { const f32x4 v0 = acc[ai][bj][m][0], v1 = acc[ai][bj][m][1];
                    u32x4 w; w.x = cvt_pk_bf16(v0[0], v0[1]); w.y = cvt_pk_bf16(v0[2], v0[3]); w.z = cvt_pk_bf16(v1[0], v1[1]); w.w = cvt_pk_bf16(v1[2], v1[3]);
                    *at<u32x4>(xm, ro + bj * HALF * 2) = w; }
                asm volatile("" ::: "memory"); }
    }
};
struct EpiS5 { static constexpr bool PERM16 = false, PERM = true, MID = false, INIT = false; static constexpr int NVM = 8;
    bf16* hid; const LAS float* rowrw;
    __device__ __forceinline__ void operator()(const f32x4 (&acc)[2][2][4][2], const Unit& u, int wr, int wc, int fr, int fq) const {
        asm volatile("" : "+v"(fr), "+v"(fq));
        const int row0 = u.pm * BM + wr * 64 + fr, col0 = u.pn * HALF + wc * 32 + 8 * fq;
#pragma unroll
        for (int ai = 0; ai < 2; ++ai)
#pragma unroll
            for (int m = 0; m < 4; ++m) { f32x4 h0, h1; typedef float f32x2_ __attribute__((ext_vector_type(2))); const f32x2_ rw = *(const LAS f32x2_*)(rowrw + 2 * (u.li * BM + wr * 64 + fr + ai * HALF + m * 16));
#pragma unroll
                for (int j = 0; j < 4; ++j) { const float g0 = acc[ai][0][m][0][j] * rw.x, g1 = acc[ai][0][m][1][j] * rw.x;
                    h0[j] = g0 * sigmoid_fast(g0) * acc[ai][1][m][0][j] * rw.y; h1[j] = g1 * sigmoid_fast(g1) * acc[ai][1][m][1][j] * rw.y; }
                u32x4 w; w.x = cvt_pk_bf16(h0[0], h0[1]); w.y = cvt_pk_bf16(h0[2], h0[3]); w.z = cvt_pk_bf16(h1[0], h1[1]); w.w = cvt_pk_bf16(h1[2], h1[3]);
                *at<u32x4>(hid, ((unsigned)(row0 + ai * HALF + m * 16) * (unsigned)EH + (unsigned)col0) * 2u) = w;
                asm volatile("" ::: "memory"); }
    }
};
constexpr float Y_SCALE = 16.0f, Y_UNSCALE = 1.0f / 16.0f;
__device__ __forceinline__ unsigned pack4_fp8(const f32x4 v) { int p = __builtin_amdgcn_cvt_pk_fp8_f32(v[0] * Y_SCALE, v[1] * Y_SCALE, 0, false); p = __builtin_amdgcn_cvt_pk_fp8_f32(v[2] * Y_SCALE, v[3] * Y_SCALE, p, true); return (unsigned)p; }
struct EpiS6 { static constexpr bool PERM16 = true, PERM = false, MID = false, INIT = false; static constexpr int NVM = 8;
    unsigned char* y;
    __device__ __forceinline__ void operator()(const f32x4 (&acc)[2][2][4][2], const Unit& u, int wr, int wc, int fr, int fq) const {
        asm volatile("" : "+v"(fr), "+v"(fq));
        const int row0 = u.pm * BM + wr * 64 + fr, col0 = u.pn * BM + wc * 64 + 16 * fq;
#pragma unroll
        for (int ai = 0; ai < 2; ++ai)
#pragma unroll
            for (int m = 0; m < 4; ++m) { const int r = row0 + ai * HALF + m * 16;
                u32x4 w; w.x = pack4_fp8(acc[ai][0][m][0]); w.y = pack4_fp8(acc[ai][0][m][1]); w.z = pack4_fp8(acc[ai][1][m][0]); w.w = pack4_fp8(acc[ai][1][m][1]);
                *at<u32x4>(y, (unsigned)r * 1024u + (unsigned)col0) = w;
                asm volatile("" ::: "memory"); }
    }
};

template <class Epi, class Sched, bool ALIGN_EPI, bool SP2>
__device__ __forceinline__ void gemm_phase(LAS unsigned char* lds, const Sched& S, const Epi& E, const int nt_in, const int wid, f32x4 (&acc)[2][2][4][2]) {
    int lane = (int)__builtin_amdgcn_mbcnt_hi(~0u, __builtin_amdgcn_mbcnt_lo(~0u, 0u)); asm volatile("" : "+v"(lane));
    const int tid = wid * 64 + lane, wr = wid >> 2, wc = wid & 3, fr = lane & 15, fq = lane >> 4;
    const int lda = S.lda, ldb = S.ldb;
    int nt = nt_in; asm volatile("" : "+s"(nt));
    unsigned voffA[2], voffB[2], colA[2]; int RA[2];
#pragma unroll
    for (int i = 0; i < 2; ++i) { int R, C; stage_rc(tid * 16 + i * 8192, R, C); const int p32 = perm32(R & 31);
        const int Rb = Epi::PERM16 ? (64 * (R >> 5) + ((p32 >> 3) << 4) + (p32 & 7)) : (Epi::PERM ? ((R & ~31) + p32) : R);
        voffA[i] = (unsigned)(R * lda + C) * 2u; voffB[i] = (unsigned)(Rb * ldb + C) * 2u; RA[i] = R; colA[i] = (unsigned)C * 2u; }
    const size_t kstep = (size_t)(BK * 2);
    const size_t hstepA = (size_t)HALF * lda * 2, hstepB = (size_t)(Epi::PERM16 ? 8 : HALF) * ldb * 2;
    const unsigned ldsw = (unsigned)wid * 1024u;
    const int aoff = lds_byte(wr * 64 + fr, fq * 8), boff = lds_byte(wc * 32 + fr, fq * 8);
#define PG8_SA(b, h) (((b) * 2 + (h)) * HTB)
#define PG8_SB(b, h) ((4 + (b) * 2 + (h)) * HTB)
#define PG8_GLDS(gp, lp) __builtin_amdgcn_global_load_lds((const unsigned*)(gp), (LAS unsigned*)(lp), 16, 0, 0)
#define PG8_STAGE_A(bufoff, wn, h, kb) do { _Pragma("unroll") for (int _i = 0; _i < 2; ++_i) { \
        const char* _p = Sched::GATHER ? (((wn) ? nA : cA) + (kb) + ((wn) ? gn[h][_i] : ga[h][_i])) : (((wn) ? nA : cA) + (size_t)(h) * hstepA + (kb) + voffA[_i]); \
        PG8_GLDS(_p, lds + (bufoff) + ldsw + _i * 8192); } } while (0)
#define PG8_STAGE_B(bufoff, gbase) do { _Pragma("unroll") for (int _i = 0; _i < 2; ++_i) PG8_GLDS((const char*)(gbase) + voffB[_i], lds + (bufoff) + ldsw + _i * 8192); } while (0)
#define PG8_LDA(dst, b, h) do { _Pragma("unroll") for (int m = 0; m < 4; ++m) _Pragma("unroll") for (int k = 0; k < 2; ++k) dst[m][k] = *(const LAS bf16x8*)(lds + PG8_SA(b, h) + aoff + m * 2048 + k * 1024); } while (0)
#define PG8_LDB(dst, b, h) do { _Pragma("unroll") for (int n = 0; n < 2; ++n) _Pragma("unroll") for (int k = 0; k < 2; ++k) dst[n][k] = *(const LAS bf16x8*)(lds + PG8_SB(b, h) + boff + n * 2048 + k * 1024); } while (0)
#define PG8_MMA(ai, bj, At, Bt) do { __builtin_amdgcn_s_setprio(1); _Pragma("unroll") for (int m = 0; m < 4; ++m) _Pragma("unroll") for (int n = 0; n < 2; ++n) _Pragma("unroll") for (int k = 0; k < 2; ++k) \
        acc[ai][bj][m][n] = __builtin_amdgcn_mfma_f32_16x16x32_bf16(Bt[n][k], At[m][k], acc[ai][bj][m][n], 0, 0, 0); __builtin_amdgcn_s_setprio(0); } while (0)
#define PG8_WAIT_V(n) asm volatile("s_waitcnt vmcnt(" #n ")" ::: "memory")
#define PG8_WAIT_VN(n) asm volatile("s_waitcnt vmcnt(%0)" :: "n"(n) : "memory")
#define PG8_WAIT_F(f) do { if (f) PG8_WAIT_VN(8 + Epi::NVM); else PG8_WAIT_V(8); } while (0)
#define PG8_WAIT_L(n) asm volatile("s_waitcnt lgkmcnt(" #n ")" ::: "memory")
#define PG8_BAR __builtin_amdgcn_s_barrier()
#define PG8_SCHED __builtin_amdgcn_sched_barrier(0)
    Unit cur, nxt; int ui = 0;
    if (!S.next(0, cur)) return;
    if constexpr (!Epi::INIT) {
#pragma unroll
    for (int a = 0; a < 2; ++a)
#pragma unroll
        for (int b = 0; b < 2; ++b)
#pragma unroll
            for (int m = 0; m < 4; ++m)
#pragma unroll
                for (int n = 0; n < 2; ++n) acc[a][b][m][n] = (f32x4){0.f, 0.f, 0.f, 0.f};
    }
    bf16x8 At[4][2], B0[2][2], B1[2][2];
    unsigned ga[2][2], gn[2][2];
#pragma unroll
    for (int h = 0; h < 2; ++h)
#pragma unroll
        for (int i = 0; i < 2; ++i) { ga[h][i] = Sched::GATHER ? S.a_row_off(cur, h * HALF + RA[i]) + colA[i] : 0u; gn[h][i] = ga[h][i]; }
    const char* cA = S.a_base(cur); const char* cB = S.b_base(cur);
    const char* nA = cA; const char* nB = cB;
    if constexpr (SP2) {
        PG8_STAGE_B(PG8_SB(0, 0), cB); PG8_STAGE_B(PG8_SB(0, 1), cB + hstepB); PG8_STAGE_A(PG8_SA(0, 0), false, 0, 0); PG8_STAGE_A(PG8_SA(0, 1), false, 1, 0);
        if (wr == 1) PG8_BAR;
        PG8_WAIT_V(2); PG8_BAR;
        PG8_STAGE_B(PG8_SB(1, 0), cB + kstep); PG8_STAGE_A(PG8_SA(1, 0), false, 0, kstep); PG8_STAGE_B(PG8_SB(1, 1), cB + hstepB + kstep);
        PG8_WAIT_V(6); PG8_BAR;
    } else {
        PG8_STAGE_B(PG8_SB(0, 0), cB); PG8_STAGE_A(PG8_SA(0, 0), false, 0, 0); PG8_STAGE_B(PG8_SB(0, 1), cB + hstepB); PG8_STAGE_A(PG8_SA(0, 1), false, 1, 0);
        if (wr == 1) PG8_BAR;
        PG8_WAIT_V(4); PG8_BAR;
        PG8_STAGE_B(PG8_SB(1, 0), cB + kstep); PG8_STAGE_A(PG8_SA(1, 0), false, 0, kstep); PG8_STAGE_B(PG8_SB(1, 1), cB + hstepB + kstep);
        PG8_WAIT_V(6); PG8_BAR;
    }
    for (;;) {
        const bool has_next = S.next(ui + 1, nxt);
        if (has_next) { nA = S.a_base(nxt); nB = S.b_base(nxt); } else { nA = cA; nB = cB; }
        if constexpr (Sched::GATHER) {
#pragma unroll
            for (int h = 0; h < 2; ++h)
#pragma unroll
                for (int i = 0; i < 2; ++i) gn[h][i] = has_next ? S.a_row_off(nxt, h * HALF + RA[i]) + colA[i] : ga[h][i];
        }
        for (int t = 0; t < nt; t += 2) {
            const bool last = (t == nt - 2);
            if constexpr (Epi::MID) { if (t == (nt >> 1)) E.mid(acc, cur, wr, wc, fr, fq); }
            const size_t k1 = (size_t)(t + 1) * kstep;
            const size_t k2 = last ? 0 : (size_t)(t + 2) * kstep; const size_t k3 = k2 + kstep;
            const char* b2 = last ? nB : cB + (size_t)(t + 2) * kstep; const char* b3 = b2 + kstep;
            if constexpr (SP2) {
            PG8_LDB(B0, 0, 0); PG8_LDB(B1, 0, 1); PG8_SCHED; PG8_LDA(At, 0, 0); PG8_STAGE_A(PG8_SA(1, 1), false, 1, k1);
            PG8_WAIT_V(8); PG8_WAIT_L(0); PG8_BAR; PG8_MMA(0, 0, At, B0); PG8_MMA(0, 1, At, B1); PG8_BAR; PG8_SCHED;
            PG8_LDA(At, 0, 1); PG8_STAGE_B(PG8_SB(0, 0), b2); PG8_STAGE_B(PG8_SB(0, 1), b2 + hstepB); PG8_STAGE_A(PG8_SA(0, 0), last, 0, k2);
            PG8_WAIT_V(8); PG8_WAIT_L(0); PG8_BAR; PG8_MMA(1, 0, At, B0); PG8_MMA(1, 1, At, B1); PG8_BAR; PG8_SCHED;
            PG8_LDB(B0, 1, 0); PG8_LDB(B1, 1, 1); PG8_SCHED; PG8_LDA(At, 1, 0); PG8_STAGE_A(PG8_SA(0, 1), last, 1, k2);
            PG8_WAIT_V(8); PG8_WAIT_L(0); PG8_BAR; PG8_MMA(0, 0, At, B0); PG8_MMA(0, 1, At, B1); PG8_BAR; PG8_SCHED;
            PG8_LDA(At, 1, 1); PG8_STAGE_B(PG8_SB(1, 0), b3); PG8_STAGE_B(PG8_SB(1, 1), b3 + hstepB); PG8_STAGE_A(PG8_SA(1, 0), last, 0, k3);
            PG8_WAIT_V(8); PG8_WAIT_L(0); PG8_BAR; PG8_MMA(1, 0, At, B0); PG8_MMA(1, 1, At, B1); PG8_BAR; PG8_SCHED;
            } else {
            PG8_LDB(B0, 0, 0); PG8_SCHED; PG8_LDA(At, 0, 0); PG8_STAGE_A(PG8_SA(1, 1), false, 1, k1);
            PG8_WAIT_L(8); PG8_BAR; PG8_WAIT_L(0); PG8_MMA(0, 0, At, B0); PG8_BAR; PG8_SCHED;
            PG8_LDB(B1, 0, 1); PG8_STAGE_B(PG8_SB(0, 0), b2);
            PG8_BAR; PG8_WAIT_L(0); PG8_MMA(0, 1, At, B1); PG8_BAR;
            PG8_LDA(At, 0, 1); PG8_STAGE_A(PG8_SA(0, 0), last, 0, k2);
            PG8_BAR; PG8_WAIT_L(0); PG8_MMA(1, 0, At, B0); PG8_BAR; PG8_SCHED;
            PG8_STAGE_B(PG8_SB(0, 1), b2 + hstepB);
            PG8_WAIT_V(6); PG8_BAR; PG8_MMA(1, 1, At, B1); PG8_BAR;
            PG8_LDB(B0, 1, 0); PG8_SCHED; PG8_LDA(At, 1, 0); PG8_STAGE_A(PG8_SA(0, 1), last, 1, k2);
            PG8_WAIT_L(8); PG8_BAR; PG8_WAIT_L(0); PG8_MMA(0, 0, At, B0); PG8_BAR; PG8_SCHED;
            PG8_LDB(B1, 1, 1); PG8_STAGE_B(PG8_SB(1, 0), b3);
            PG8_BAR; PG8_WAIT_L(0); PG8_MMA(0, 1, At, B1); PG8_BAR;
            PG8_LDA(At, 1, 1); PG8_STAGE_A(PG8_SA(1, 0), last, 0, k3);
            PG8_BAR; PG8_WAIT_L(0); PG8_MMA(1, 0, At, B0); PG8_BAR; PG8_SCHED;
            PG8_STAGE_B(PG8_SB(1, 1), b3 + hstepB);
            PG8_WAIT_V(6); PG8_BAR; PG8_MMA(1, 1, At, B1); PG8_BAR;
            }
        }
        if constexpr (ALIGN_EPI) { if (wr == 0) PG8_BAR; }
        E(acc, cur, wr, wc, fr, fq);
        if (!has_next) break;
#pragma unroll
        for (int a = 0; a < 2; ++a)
#pragma unroll
            for (int b = 0; b < 2; ++b)
#pragma unroll
                for (int m = 0; m < 4; ++m)
#pragma unroll
                    for (int n = 0; n < 2; ++n) acc[a][b][m][n] = (f32x4){0.f, 0.f, 0.f, 0.f};
        cur = nxt; cA = nA; cB = nB; ++ui;
#pragma unroll
        for (int h = 0; h < 2; ++h)
#pragma unroll
            for (int i = 0; i < 2; ++i) ga[h][i] = gn[h][i];
        if constexpr (ALIGN_EPI) { if (wr == 1) PG8_BAR; }
    }
    PG8_WAIT_V(0);
    if constexpr (!ALIGN_EPI) { if (wr == 0) PG8_BAR; }
    PG8_BAR;
#undef PG8_SA
#undef PG8_SB
#undef PG8_GLDS
#undef PG8_STAGE_A
#undef PG8_STAGE_B
#undef PG8_LDA
#undef PG8_LDB
#undef PG8_MMA
#undef PG8_WAIT_V
#undef PG8_WAIT_VN
#undef PG8_WAIT_F
#undef PG8_WAIT_L
#undef PG8_BAR
#undef PG8_SCHED
}
}

#define XB_TMO      128
#define XB_XCNT(j)  (256  + 64 * (j))
#define XB_XSUB(j)  (1280 + 64 * (j))
#define XB_XGEN(j)  (2304 + 64 * (j))
#define XB_TOP      3328
#define XB_TOPGEN   3392
#define XCD_BAR_WORDS 3456
#define XB_SPIN_CAP (1u << 18)
__device__ __forceinline__ unsigned xb_ld(unsigned* p)              { return __hip_atomic_load(p, __ATOMIC_RELAXED, __HIP_MEMORY_SCOPE_AGENT); }
__device__ __forceinline__ unsigned xb_add(unsigned* p, unsigned v) { return __hip_atomic_fetch_add(p, v, __ATOMIC_RELAXED, __HIP_MEMORY_SCOPE_AGENT); }
__device__ __forceinline__ unsigned xb_xcc_id() { return (unsigned)__builtin_amdgcn_s_getreg((3 << 11) | 20) & 0xFu; }
#define XB_SPIN(cond, bar) do { unsigned _sp = 0; while (cond) { __builtin_amdgcn_s_sleep(1); \
    if ((++_sp & 255u) == 0u) { if (xb_ld(&(bar)[XB_TMO])) break; if (_sp > XB_SPIN_CAP) { atomicAdd(&(bar)[XB_TMO], 1u); break; } } } } while (0)
struct XcdBarrier { unsigned* bar; unsigned x; volatile LAS unsigned* st; };
__device__ __forceinline__ XcdBarrier xcd_barrier_post(unsigned* bar, volatile LAS unsigned* st) {
    XcdBarrier b; b.bar = bar; b.x = xb_xcc_id(); b.st = st;
    if (threadIdx.x == 0) (void)xb_add(&bar[XB_XCNT(b.x)], 1u);
    return b;
}
__device__ __forceinline__ void xcd_barrier_complete(unsigned* bar, unsigned x, unsigned& nloc, unsigned& nx) {
    const unsigned G = gridDim.x * gridDim.y * gridDim.z;
    unsigned sum, cnt, mine, sp = 0u;
    for (;;) {
        sum = 0u; cnt = 0u; mine = 0u;
#pragma unroll 1
        for (unsigned j = 0; j < 16; ++j) { const unsigned c = xb_ld(&bar[XB_XCNT(j)]); sum += c; cnt += (c > 0u) ? 1u : 0u; mine = (j == x) ? c : mine; }
        if (sum == G) break;
        __builtin_amdgcn_s_sleep(1);
        if ((++sp & 255u) == 0u) { if (xb_ld(&bar[XB_TMO])) break; if (sp > XB_SPIN_CAP) { atomicAdd(&bar[XB_TMO], 1u); break; } }
    }
    nloc = mine > 0u ? mine : 1u; nx = cnt > 0u ? cnt : 1u;
}
__device__ __forceinline__ void xcd_barrier_setup(const XcdBarrier& b) {
    if (threadIdx.x == 0) { unsigned nloc, nx; xcd_barrier_complete(b.bar, b.x, nloc, nx); b.st[0] = nloc; b.st[1] = nx; }
}
__device__ __forceinline__ void xcd_barrier(const XcdBarrier& b, const int wave) {
    asm volatile("s_waitcnt vmcnt(0)" ::: "memory");
    __syncthreads();
    if (wave == 0 && __builtin_amdgcn_mbcnt_hi(~0u, __builtin_amdgcn_mbcnt_lo(~0u, 0u)) == 0u) {
        unsigned* bar = b.bar; unsigned bx = b.x; asm volatile("" : "+s"(bx));
        __builtin_amdgcn_s_waitcnt(0);
        const unsigned nloc = b.st[0], nx = b.st[1];
        const unsigned old = xb_add(&bar[XB_XSUB(bx)], 1u);
        const unsigned gen = old / nloc;
        if (old + 1u == (gen + 1u) * nloc) {
            __builtin_amdgcn_fence(__ATOMIC_RELEASE, "agent");
            asm volatile("s_waitcnt vmcnt(0)" ::: "memory");
            const unsigned og = xb_add(&bar[XB_TOP], 1u);
            const unsigned tg = og / nx;
            if (og + 1u == (tg + 1u) * nx) xb_add(&bar[XB_TOPGEN], 1u);
            else XB_SPIN(xb_ld(&bar[XB_TOPGEN]) == tg, bar);
            __builtin_amdgcn_fence(__ATOMIC_ACQUIRE, "agent");
            xb_add(&bar[XB_XGEN(bx)], 1u);
            asm volatile("s_waitcnt vmcnt(0)" ::: "memory");
        } else {
            XB_SPIN(xb_ld(&bar[XB_XGEN(bx)]) == gen, bar);
            __builtin_amdgcn_fence(__ATOMIC_ACQUIRE, "agent");
            asm volatile("s_waitcnt vmcnt(0)" ::: "memory");
        }
    }
    __syncthreads();
}

struct Args { const float* in[20]; float* out; unsigned char* ws; int ph_lo, ph_hi, rep, stag, exb, pad; };
struct Frame {
    LAS unsigned char* lds; volatile LAS unsigned* MISC; u32* ctl;
    int tid, lane, wave, vcu, G;
};

__device__ __forceinline__ void p0_item64(const float* W, int N, bf16* WT, int ldo, int mode, LAS unsigned char* scr, int item, int lane, const float* ksc) {
    const int nblk = N >> 6, kb = item / nblk, nb = item - kb * nblk, k0 = kb * 64, n0 = nb * 64;
    const float* src = W + (size_t)k0 * N + n0 + lane;
    float v[64];
#pragma unroll
    for (int i = 0; i < 64; ++i) v[i] = __builtin_nontemporal_load(src + (size_t)i * N);
    if (ksc) {
#pragma unroll
        for (int i = 0; i < 64; ++i) v[i] *= ksc[k0 + i]; }
    LAS unsigned char* row = scr + lane * 144;
#pragma unroll
    for (int c = 0; c < 8; ++c) { u32x4 o; o.x = pg8::cvt_pk_bf16(v[8 * c], v[8 * c + 1]); o.y = pg8::cvt_pk_bf16(v[8 * c + 2], v[8 * c + 3]); o.z = pg8::cvt_pk_bf16(v[8 * c + 4], v[8 * c + 5]); o.w = pg8::cvt_pk_bf16(v[8 * c + 6], v[8 * c + 7]);
        *(LAS u32x4*)(row + c * 16) = o; }
    LDS_WAIT(); asm volatile("" ::: "memory");
    const int ch = lane & 7;
#pragma unroll
    for (int j = 0; j < 8; ++j) { const int n = (lane >> 3) + 8 * j; const u32x4 o = *(const LAS u32x4*)(scr + n * 144 + ch * 16);
        const int nn = n0 + n; int r;
        if (mode == 0) r = nn;
        else if (mode == 3) {
            if (nn < 1024) r = nn;
            else if (nn < 2048) { const int w2 = nn - 1024, c = w2 & 511; r = 1024 + (c >> 7) * 256 + (w2 >> 9) * 128 + (c & 127); }
            else { const int w2 = nn - 2048, c = w2 & 1023; r = 2048 + (c >> 7) * 256 + (w2 >> 10) * 128 + (c & 127); } }
        else r = (nn >> 7) * 256 + (mode == 2 ? 128 : 0) + (nn & 127);
        *(u32x4*)(WT + (size_t)r * ldo + k0 + ch * 8) = o; }
    LDS_WAIT(); asm volatile("" ::: "memory");
}

__global__ void __launch_bounds__(NTHR, 2) mega_fwd(Args args) {
    extern __shared__ __attribute__((aligned(16))) unsigned char lds_raw[];
    LAS unsigned char* const lds = (LAS unsigned char*)lds_raw;
    const int wv0_ = __builtin_amdgcn_readfirstlane((int)(threadIdx.x >> 6));
#define CTL ((u32*)(KWS + WS_CTL))
#define CTL0 ((u32*)(args.ws + WS_CTL))
#define CAS __attribute__((address_space(4)))
#define KIN(k) (*(const float* const CAS*)(ka_ + 8 * (k)))
#define KOUT (*(float* const CAS*)(ka_ + 160))
#define KWS (*(unsigned char* const CAS*)(ka_ + 168))
#define PHV() const CAS char* ka_ = (const CAS char*)__builtin_amdgcn_kernarg_segment_ptr(); asm volatile("" : "+s"(ka_)); int wave_ = wv0_; asm volatile("" : "+s"(wave_)); int lane_ = (int)__builtin_amdgcn_mbcnt_hi(~0u, __builtin_amdgcn_mbcnt_lo(~0u, 0u)); asm volatile("" : "+v"(lane_)); const int tid_ = wave_ * 64 + lane_; \
    const int G_ = gridDim.x; const int vcu_ = (G_ % 8 == 0) ? ((int)blockIdx.x % 8) * (G_ / 8) + (int)blockIdx.x / 8 : (int)blockIdx.x; \
    const int gw = vcu_ * NWAVES + wave_, NGW = G_ * NWAVES, gt = vcu_ * NTHR + tid_, NGT = G_ * NTHR; (void)lane_; (void)gw; (void)NGW; (void)gt; (void)NGT;
#define p_x KIN(0)
#define p_g_mix KIN(1)
#define p_w_in KIN(2)
#define p_b_gate KIN(3)
#define p_w_pool_group KIN(4)
#define p_pool_scale KIN(5)
#define p_w_pool_out KIN(6)
#define p_conv_w KIN(7)
#define p_w_conv_out KIN(8)
#define p_w_o KIN(9)
#define p_g_ffn KIN(10)
#define p_w_router KIN(11)
#define p_router_bias KIN(12)
#define p_e_gate KIN(13)
#define p_e_up KIN(14)
#define p_e_down KIN(15)
#define p_s_gate KIN(16)
#define p_s_up KIN(17)
#define p_s_down KIN(18)
#define p_g_final KIN(19)
#define p_out KOUT
#define p_tope ((int*)(KWS + WS_TOPE))
#define p_topw ((float*)(KWS + WS_TOPW))
#define p_inv ((int*)(KWS + WS_INV))
#define p_rowtok ((int*)(KWS + WS_ROWTOK))
#define p_roww ((float*)(KWS + WS_ROWW))
#define p_rt ((float*)(KWS + WS_RT))
#define p_rte ((int*)(KWS + WS_H))
#define p_rwe ((float*)(KWS + WS_H + (size_t)64 * ECAP * 4))
#define p_xm ((bf16*)KOUT)
#define p_off ((int*)(KWS + WS_OFF))
#define p_tilee ((int*)(KWS + WS_TILEE))
#define p_edt ((bf16*)(KWS + WS_EDT))
#define p_wtin ((bf16*)(KWS + WS_WTIN))
#define p_wtab ((bf16*)(KWS + WS_WTAB))
#define p_wto ((bf16*)(KWS + WS_WTO))
#define p_egut ((bf16*)(KWS + WS_EGUT))
#define p_H ((bf16*)(KWS + WS_H))
#define p_AB p_H
#define p_H2 p_H
#define p_ubcv ((bf16*)(KWS + WS_UBCV))
#define p_merged p_ubcv
#define p_gates ((bf16*)(KWS + WS_GATES))
#define p_hid ((bf16*)(KWS + WS_HID))
#define p_y ((unsigned char*)(KWS + WS_Y))

    constexpr int I_IN = 16 * 64, I_CO = 8 * 16, I_O = 16 * 16, I_EG = 64 * 64, I_SG = 64, I_ED = 64 * 64, I_SD = 64;
    constexpr int N_ITEMS_EARLY = I_IN + I_CO + I_O, NITEMS = N_ITEMS_EARLY + 2 * I_EG + 2 * I_SG + I_ED + I_SD;
#define CONV_RANGE(lo_, hi_, scr_) do { for (int it = (lo_) + gw; it < (hi_); it += NGW) { \
            int r = it; const float* W; bf16* WT; int N, ldo, mode = 0; const float* ksc = nullptr; \
            if (r < I_IN) { W = p_w_in; N = NIN; WT = p_wtin; ldo = D; mode = 3; } \
            else if ((r -= I_IN) < I_CO) { W = p_w_conv_out; N = D; WT = p_wtab + 512; ldo = 1024; } \
            else if ((r -= I_CO) < I_O) { W = p_w_o; N = D; WT = p_wto; ldo = D; } \
            else if ((r -= I_O) < I_EG) { const int e = r >> 6; r &= 63; W = p_e_gate + (size_t)e * D * EH; N = EH; WT = p_egut + (size_t)e * 512 * D; ldo = D; mode = 1; ksc = p_g_ffn; } \
            else if ((r -= I_EG) < I_EG) { const int e = r >> 6; r &= 63; W = p_e_up + (size_t)e * D * EH; N = EH; WT = p_egut + (size_t)e * 512 * D; ldo = D; mode = 2; ksc = p_g_ffn; } \
            else if ((r -= I_EG) < I_SG) { W = p_s_gate; N = EH; WT = p_egut + (size_t)64 * 512 * D; ldo = D; mode = 1; ksc = p_g_ffn; } \
            else if ((r -= I_SG) < I_SG) { W = p_s_up; N = EH; WT = p_egut + (size_t)64 * 512 * D; ldo = D; mode = 2; ksc = p_g_ffn; } \
            else if ((r -= I_SG) < I_ED) { const int e = r >> 6; r &= 63; W = p_e_down + (size_t)e * EH * D; N = D; WT = p_edt + (size_t)e * D * EH; ldo = EH; } \
            else { r -= I_ED; W = p_s_down; N = D; WT = p_edt + (size_t)64 * D * EH; ldo = EH; } \
            p0_item64(W, N, WT, ldo, mode, (scr_), r, lane_, ksc); } } while (0)
    for (int u = threadIdx.x; u < (LDS_BYTES - LDSCTL_OFF) / 4; u += NTHR) ((LAS unsigned*)(lds + LDSCTL_OFF))[u] = 0u;
    __syncthreads();
    XcdBarrier bar; bar.bar = (unsigned*)(CTL0 + CW_BAR); bar.x = 0; bar.st = nullptr;
    if (!MK_PER_PHASE) { bar = xcd_barrier_post((unsigned*)(CTL0 + CW_BAR), (volatile LAS unsigned*)(lds + MISC_OFF) + 8); xcd_barrier_setup(bar); }
    const int lo = args.ph_lo, hi = args.ph_hi; (void)lo; (void)hi;
#if MK_PER_PHASE
#define IN(k) (lo <= (k) && (k) < hi)
#else
#define IN(k) true
#endif
#define SEAM(k) do { if (IN(k) && IN((k) + 1)) xcd_barrier(bar, wv0_); } while (0)
#if REP_PHASE >= 0
#define REPS(k) for (int rep_ = 0; rep_ < ((k) == args.rep ? 2 : 1); ++rep_)
#define REPBAR() do { if (rep_) xcd_barrier(bar, wv0_); } while (0)
#else
    constexpr int rep_ = 0;
#define REPS(k)
#define REPBAR() do { } while (0)
#endif

    REPS(0) if (IN(0)) { REPBAR(); PHV();
        LAS unsigned char* scr = lds + wave_ * 9216;
        for (int rr_ = 0; rr_ < (args.rep == 100 ? 2 : 1); ++rr_) CONV_RANGE(0, N_ITEMS_EARLY, scr);
        if (wave_ < 2) {
        for (int rr_ = 0; rr_ < (args.rep == 101 ? 2 : 1); ++rr_)
        for (int idx = (vcu_ * 2 + wave_) * 64 + lane_; idx < 512 * (D / 4); idx += G_ * 128) { const int k = idx >> 8, d4 = (idx & 255) * 4, gi = k >> 7; f32x4 s = (f32x4){0.f, 0.f, 0.f, 0.f};
            const float* wgp = p_w_pool_group + (size_t)k * 128; const float* scp = p_pool_scale + gi * 128; const float* wpo = p_w_pool_out + (size_t)(gi * 128) * D + d4;
#pragma unroll 8
            for (int j4 = 0; j4 < 32; ++j4) { const f32x4 a4 = *(const f32x4*)(wgp + 4 * j4) * *(const f32x4*)(scp + 4 * j4);
#pragma unroll
                for (int jj = 0; jj < 4; ++jj) s += *(const f32x4*)(wpo + (size_t)(4 * j4 + jj) * D) * a4[jj]; }
            bf16* o = p_wtab + (size_t)d4 * 1024 + k;
            o[0] = (bf16)f2bf(s.x); o[1024] = (bf16)f2bf(s.y); o[2048] = (bf16)f2bf(s.z); o[3072] = (bf16)f2bf(s.w); }
        } else {
        const int gw6 = vcu_ * 6 + wave_ - 2, NG6 = G_ * 6;
        for (int rr_ = 0; rr_ < (args.rep == 102 ? 2 : 1); ++rr_)
        for (int m = gw6; m < T; m += 4 * NG6) {
            f32x4 v[4][4]; const f32x4* gr = (const f32x4*)p_g_mix + lane_;
#pragma unroll
            for (int u = 0; u < 4; ++u) { const int mu = (m + u * NG6 < T) ? m + u * NG6 : m; const f32x4* xr = (const f32x4*)(p_x + (size_t)mu * D) + lane_;
#pragma unroll
                for (int j = 0; j < 4; ++j) v[u][j] = __builtin_nontemporal_load(xr + 64 * j); }
#pragma unroll
            for (int u = 0; u < 4; ++u) { const int mu = (m + u * NG6 < T) ? m + u * NG6 : m; float s = 0.f;
#pragma unroll
                for (int j = 0; j < 4; ++j) s += (v[u][j].x * v[u][j].x + v[u][j].y * v[u][j].y) + (v[u][j].z * v[u][j].z + v[u][j].w * v[u][j].w);
                const float r = rsqrtf(wave_sum(s) * (1.0f / D) + EPS);
                u32x2* o = (u32x2*)(p_H + (size_t)mu * D) + lane_;
#pragma unroll
                for (int j = 0; j < 4; ++j) { const f32x4 gg = gr[64 * j]; u32x2 w; w.x = pk2(v[u][j].x * r * gg.x, v[u][j].y * r * gg.y); w.y = pk2(v[u][j].z * r * gg.z, v[u][j].w * r * gg.w); o[64 * j] = w; } }
        }
        }
    }
    SEAM(0);
    REPS(1) if (IN(1)) { REPBAR(); PHV();
        pg8::RegOrder S; S.init(p_H, p_wtin, D, D, T, NIN, G_, (int)blockIdx.x, 1, 0);
        pg8::EpiS1 E{p_ubcv, p_gates, p_b_gate};
        { f32x4 acc_[2][2][4][2]; pg8::gemm_phase<pg8::EpiS1, pg8::RegOrder, true, true>(lds, S, E, D / 64, wave_, acc_); }
    }
    SEAM(1);
    REPS(2) if (IN(2)) { REPBAR(); PHV();
        for (int base = vcu_ * 64; base < T; base += G_ * 64) {
            const int c8 = (tid_ & 127) * 8, tb = base + (tid_ >> 7) * 16, s0 = tb & (SEQ - 1);
#define UNPK(v, e) do { e[0] = bflo(v.x); e[1] = bfhi(v.x); e[2] = bflo(v.y); e[3] = bfhi(v.y); e[4] = bflo(v.z); e[5] = bfhi(v.z); e[6] = bflo(v.w); e[7] = bfhi(v.w); } while (0)
            if (c8 < 512) {
                const int w = 2 << (c8 >> 7); float S[8];
#pragma unroll
                for (int i = 0; i < 8; ++i) S[i] = 0.f;
                const bf16* up = p_ubcv + (size_t)tb * 2048 + c8;
#pragma unroll
                for (int j = 1; j <= 16; ++j) { u32x4 v = (u32x4){0u, 0u, 0u, 0u}; if (j < w && s0 - j >= 0) v = *(const u32x4*)(up - (long)j * 2048); float e[8]; UNPK(v, e);
#pragma unroll
                    for (int i = 0; i < 8; ++i) S[i] += e[i]; }
#pragma unroll
                for (int i2 = 0; i2 < 16; ++i2) { const int sq = s0 + i2;
                    const u32x4 vc = *(const u32x4*)(up + (size_t)i2 * 2048); u32x4 vo = (u32x4){0u, 0u, 0u, 0u}; if (sq - w + 1 >= 0) vo = *(const u32x4*)(up + (long)(i2 - w + 1) * 2048);
                    float cur[8], old[8], o[8]; UNPK(vc, cur); UNPK(vo, old);
                    const int cnt = (sq + 1) < w ? (sq + 1) : w; const float rc = 1.0f / (float)cnt;
#pragma unroll
                    for (int i = 0; i < 8; ++i) { S[i] += cur[i]; o[i] = S[i] * rc - cur[i]; S[i] -= old[i]; }
                    u32x4 wv; wv.x = pk2(o[0], o[1]); wv.y = pk2(o[2], o[3]); wv.z = pk2(o[4], o[5]); wv.w = pk2(o[6], o[7]);
                    *(u32x4*)(p_AB + (size_t)(tb + i2) * 1024 + c8) = wv; }
            } else {
                const int c = c8 - 512; const bf16* bp = p_ubcv + (size_t)tb * 2048 + 512 + c;
                float w0[8], w1[8], w2[8], p1[8], p2[8];
                { const f32x4 a0 = *(const f32x4*)(p_conv_w + c), a1 = *(const f32x4*)(p_conv_w + c + 4), b0 = *(const f32x4*)(p_conv_w + 512 + c), b1 = *(const f32x4*)(p_conv_w + 512 + c + 4), c0 = *(const f32x4*)(p_conv_w + 1024 + c), c1 = *(const f32x4*)(p_conv_w + 1024 + c + 4);
                  w0[0] = a0.x; w0[1] = a0.y; w0[2] = a0.z; w0[3] = a0.w; w0[4] = a1.x; w0[5] = a1.y; w0[6] = a1.z; w0[7] = a1.w;
                  w1[0] = b0.x; w1[1] = b0.y; w1[2] = b0.z; w1[3] = b0.w; w1[4] = b1.x; w1[5] = b1.y; w1[6] = b1.z; w1[7] = b1.w;
                  w2[0] = c0.x; w2[1] = c0.y; w2[2] = c0.z; w2[3] = c0.w; w2[4] = c1.x; w2[5] = c1.y; w2[6] = c1.z; w2[7] = c1.w; }
#pragma unroll
                for (int j = 1; j <= 2; ++j) { u32x4 a = (u32x4){0u, 0u, 0u, 0u}; if (s0 - j >= 0) a = *(const u32x4*)(bp + 512 - (long)j * 2048);
                    float ea[8]; UNPK(a, ea);
#pragma unroll
                    for (int i = 0; i < 8; ++i) { if (j == 1) p1[i] = ea[i]; else p2[i] = ea[i]; } }
#pragma unroll
                for (int i2 = 0; i2 < 16; ++i2) {
                    const u32x4 g = *(const u32x4*)(bp + (size_t)i2 * 2048), a = *(const u32x4*)(bp + 512 + (size_t)i2 * 2048);
                    float eg[8], ea[8], o[8]; UNPK(g, eg); UNPK(a, ea);
#pragma unroll
                    for (int i = 0; i < 8; ++i) { const float p0 = ea[i]; o[i] = eg[i] * (w0[i] * p2[i] + w1[i] * p1[i] + w2[i] * p0); p2[i] = p1[i]; p1[i] = p0; }
                    u32x4 wv; wv.x = pk2(o[0], o[1]); wv.y = pk2(o[2], o[3]); wv.z = pk2(o[4], o[5]); wv.w = pk2(o[6], o[7]);
                    *(u32x4*)(p_AB + (size_t)(tb + i2) * 1024 + c8) = wv; }
            }
#undef UNPK
        }
    }
    SEAM(2);
    f32x4 accx[2][2][4][2];
    u32x4 wh[4][4], wl[4][4];
#define ROUTER_W_LOAD() do { const int q_ = lane_ >> 4, r_ = lane_ & 15;\
_Pragma("unroll")\
        for (int s2 = 0; s2 < 4; ++s2)\
_Pragma("unroll")\
            for (int j = 0; j < 8; ++j) { const int k = wave_ * 128 + 32 * s2 + 8 * q_ + j; const float gk = p_g_ffn[k];\
_Pragma("unroll")\
                for (int nt2 = 0; nt2 < 4; ++nt2) { const float wv = gk * p_w_router[(size_t)k * NE + 16 * nt2 + r_]; const u32 hb = f2bf(wv); const u32 lb = f2bf(wv - __uint_as_float(hb << 16));\
                    if (j & 1) { wh[nt2][s2][j >> 1] |= hb << 16; wl[nt2][s2][j >> 1] |= lb << 16; } else { wh[nt2][s2][j >> 1] = hb; wl[nt2][s2][j >> 1] = lb; } } } } while (0)
    REPS(3) if (IN(3)) { REPBAR(); PHV();
        pg8::RegOrder S; S.init(p_AB, p_wtab, 1024, 1024, T, D, G_, (int)blockIdx.x, 1, 0);
        pg8::EpiS2B E{p_gates, p_merged};
        { f32x4 acc_[2][2][4][2]; pg8::gemm_phase<pg8::EpiS2B, pg8::RegOrder, true, true>(lds, S, E, 1024 / 64, wave_, acc_); }
#if REP_PHASE < 0 && !MK_PER_PHASE
        { pg8::RegOrder S4; S4.init(p_merged, p_wto, D, D, T, D, G_, (int)blockIdx.x, 1, 0); pg8::Unit u4; S4.next(0, u4); pg8::EpiS3 E4{p_x, p_xm};
          E4.init(accx, u4, wave_ >> 2, wave_ & 3, lane_ & 15, lane_ >> 4); }
#endif
    }
    SEAM(3);
    REPS(4) if (IN(4)) { REPBAR(); PHV();
        pg8::RegOrder S; S.init(p_merged, p_wto, D, D, T, D, G_, (int)blockIdx.x, 1, 0);
        pg8::EpiS3 E{p_x, p_xm};
#if !(REP_PHASE < 0 && !MK_PER_PHASE)
        { pg8::Unit u4; S.next(0, u4); E.init(accx, u4, wave_ >> 2, wave_ & 3, lane_ & 15, lane_ >> 4); }
#endif
        pg8::gemm_phase<pg8::EpiS3, pg8::RegOrder, true, true>(lds, S, E, D / 64, wave_, accx);
#if REP_PHASE < 0 && !MK_PER_PHASE
        if (!(((int)blockIdx.x >> 3) & 1)) ROUTER_W_LOAD();
#endif
    }
    SEAM(4);
    REPS(5) if (IN(5)) { REPBAR(); PHV();
        LAS float* part = (LAS float*)lds;
        LAS float* ssqp = (LAS float*)(lds + 65536);
        LAS float* rt = (LAS float*)(lds + 65536 + 4096);
        LAS float* sc = (LAS float*)(lds + 65536 + 8192);
        LAS float* sel = (LAS float*)(lds + 65536 + 16384);
        LAS int* hist = (LAS int*)(lds + 65536 + 24576);
        LAS int* bs = hist + 64;
        const int q_ = lane_ >> 4, r_ = lane_ & 15;
        if (tid_ < 64) hist[tid_] = 0;
        const int par_ = ((int)blockIdx.x >> 3) & 1;
        if (par_) { CONV_RANGE(N_ITEMS_EARLY, NITEMS, lds + wave_ * 9216); __syncthreads(); ROUTER_W_LOAD(); }
#if !(REP_PHASE < 0 && !MK_PER_PHASE)
        else ROUTER_W_LOAD();
#endif
        for (int it = vcu_; it < T / 32; it += G_) {
            const int t0 = it * 32;
#pragma unroll
            for (int rb = 0; rb < 2; ++rb) {
                u32x4 xa[4];
#pragma unroll
                for (int j = 0; j < 4; ++j) xa[j] = *(const u32x4*)(p_xm + (size_t)(t0 + 16 * rb + r_) * pg8::XM_PITCH + wave_ * 128 + 32 * j + 8 * q_);
                f32x4 acc[4]; float ss = 0.f;
#pragma unroll
                for (int nt2 = 0; nt2 < 4; ++nt2) acc[nt2] = (f32x4){0.f, 0.f, 0.f, 0.f};
#pragma unroll
                for (int s2 = 0; s2 < 4; ++s2) {
#pragma unroll
                    for (int j2 = 0; j2 < 4; ++j2) { const float x0 = bflo(xa[s2][j2]), x1 = bfhi(xa[s2][j2]); ss += x0 * x0 + x1 * x1; }
                    const bf16x8 ah = __builtin_bit_cast(bf16x8, xa[s2]);
#pragma unroll
                    for (int nt2 = 0; nt2 < 4; ++nt2) { const bf16x8 bh = __builtin_bit_cast(bf16x8, wh[nt2][s2]), bl = __builtin_bit_cast(bf16x8, wl[nt2][s2]);
                        acc[nt2] = __builtin_amdgcn_mfma_f32_16x16x32_bf16(ah, bl, acc[nt2], 0, 0, 0);
                        acc[nt2] = __builtin_amdgcn_mfma_f32_16x16x32_bf16(ah, bh, acc[nt2], 0, 0, 0); } }
#pragma unroll
                for (int nt2 = 0; nt2 < 4; ++nt2)
#pragma unroll
                    for (int g = 0; g < 4; ++g) part[(wave_ * 32 + 16 * rb + 4 * q_ + g) * 64 + 16 * nt2 + r_] = acc[nt2][g];
                ssqp[(wave_ * 4 + q_) * 32 + 16 * rb + r_] = ss;
            }
            __syncthreads();
            if (tid_ < 32) { float s2 = 0.f;
#pragma unroll
                for (int i = 0; i < 32; ++i) s2 += ssqp[i * 32 + tid_];
                const float rv = rsqrtf(s2 * (1.0f / D) + EPS); rt[tid_] = rv; p_rt[t0 + tid_] = rv; }
            __syncthreads();
#pragma unroll
            for (int j = 0; j < 4; ++j) { const int o = tid_ + NTHR * j, t = o >> 6, e = o & 63; float lg = 0.f;
#pragma unroll
                for (int k2 = 0; k2 < 8; ++k2) lg += part[(k2 * 32 + t) * 64 + e];
                const float sg = sigmoid_acc(lg * rt[t]); sc[t * 64 + e] = sg; sel[t * 64 + e] = sg + p_router_bias[e]; }
            __syncthreads();
            int lrk[4], slk[4]; float wk[4];
#pragma unroll
            for (int tt = 0; tt < 4; ++tt) {
                const int t = wave_ * 4 + tt, tok = t0 + t; const float v = sel[t * 64 + lane_]; const float sv = sc[t * 64 + lane_];
                const unsigned vb = __float_as_uint(v); const unsigned key = (vb & 0x80000000u) ? ~vb : (vb | 0x80000000u);
                unsigned thr = 0u;
#pragma unroll
                for (int bit = 31; bit >= 0; --bit) { const unsigned cand = thr | (1u << bit); if (__popcll(__ballot(key >= cand)) >= TOPK) thr = cand; }
                const unsigned long long gtm = __ballot(key > thr), eqm = __ballot(key == thr);
                const int need = TOPK - (int)__popcll(gtm);
                const int eqbelow = (int)__builtin_amdgcn_mbcnt_hi((unsigned)(eqm >> 32), __builtin_amdgcn_mbcnt_lo((unsigned)eqm, 0u));
                const bool pick = (key > thr) || (key == thr && eqbelow < need);
                const unsigned long long pm = __ballot(pick);
                const int slot = (int)__builtin_amdgcn_mbcnt_hi((unsigned)(pm >> 32), __builtin_amdgcn_mbcnt_lo((unsigned)pm, 0u));
                const float wsum = wave_sum(pick ? sv : 0.f);
                slk[tt] = pick ? slot : -1; wk[tt] = sv / wsum * ROUTED_SCALE; lrk[tt] = 0; (void)tok;
                if (pick) lrk[tt] = __hip_atomic_fetch_add(&hist[lane_], 1, __ATOMIC_RELAXED, __HIP_MEMORY_SCOPE_WORKGROUP);
            }
            __syncthreads();
            if (tid_ < 64) { const int hv = hist[tid_]; bs[tid_] = (hv && rep_ == 0) ? (int)atomicAdd(&CTL[CW_CNT + tid_], (u32)hv) : 0; hist[tid_] = 0; }
            __syncthreads();
#pragma unroll
            for (int tt = 0; tt < 4; ++tt) if (slk[tt] >= 0) { const int t = wave_ * 4 + tt, tok = t0 + t, pe = bs[lane_] + lrk[tt]; const float rv = rt[t];
                p_rte[lane_ * ECAP + pe] = tok; typedef float f32x2_ __attribute__((ext_vector_type(2))); *(f32x2_*)(p_rwe + 2 * ((size_t)lane_ * ECAP + pe)) = (f32x2_){rv, rv * wk[tt]};
                p_inv[tok * 8 + slk[tt]] = (lane_ << 16) | pe; }
            __syncthreads();
        }
        if (!par_) CONV_RANGE(N_ITEMS_EARLY, NITEMS, lds + wave_ * 9216);
    }
    SEAM(5);
    REPS(7) if (IN(7)) { REPBAR(); PHV();
        LAS int* tl_ = (LAS int*)(lds + LDSCTL_OFF + 1024);
        LAS unsigned* ro_ = (LAS unsigned*)(lds + LDSCTL_OFF + 4096);
        LAS int* so_ = (LAS int*)(lds + LDSCTL_OFF + 12288);
        LAS int* cn_ = so_ + 128;
        LAS float* rw_ = (LAS float*)(lds + LDSCTL_OFF + 13312);
        if (wave_ == 0) {
            const int cnt = (int)__hip_atomic_load(&CTL[CW_CNT + lane_], RLX_AGENT), pc = (cnt + 255) & ~255; int inc = pc;
#pragma unroll
            for (int o = 1; o < 64; o <<= 1) { const int nb = __builtin_amdgcn_ds_bpermute(((lane_ - o) & 63) << 2, inc); if (lane_ >= o) inc += nb; }
            so_[lane_] = inc - pc; cn_[lane_] = cnt; if (lane_ == 63) so_[64] = inc; }
        __syncthreads();
        const int total = __builtin_amdgcn_readfirstlane(so_[64]);
        if (tid_ < 64) { for (int rt = so_[tid_] >> 8; rt < (so_[tid_ + 1] >> 8); ++rt) tl_[rt] = tid_; tl_[(total >> 8) + tid_] = 64; }
        __syncthreads();
        pg8::MoeOrder<true> S; S.A = (const char*)p_xm; S.Bt = (const char*)p_egut; S.lda = pg8::XM_PITCH; S.ldb = D; S.rowoff = ro_; S.tilee = tl_;
        S.npn = 2; S.nunits = ((total >> 8) + 64) * 2; S.G = G_; S.c = (int)blockIdx.x; S.estride = (size_t)512 * D * 2; S.bextra = 0;
        { pg8::Unit u_; for (int i = 0; i < 8 && S.next(i, u_); ++i) if (tid_ < 256) { const int e = u_.aux, pe = u_.pm * 256 + tid_ - (e < 64 ? so_[e] : total);
                int tok = 0; float rr = 0.f, ww = 0.f;
                if (e == 64) { tok = pe; rr = p_rt[pe]; ww = rr; }
                else if (pe < cn_[e]) { typedef float f32x2_ __attribute__((ext_vector_type(2))); tok = p_rte[e * ECAP + pe]; const f32x2_ v2 = *(const f32x2_*)(p_rwe + 2 * ((size_t)e * ECAP + pe)); rr = v2.x; ww = v2.y; }
                ro_[i * 256 + tid_] = (unsigned)tok * (unsigned)(pg8::XM_PITCH * 2); rw_[2 * (i * 256 + tid_)] = rr; rw_[2 * (i * 256 + tid_) + 1] = ww; } }
        __syncthreads();
        pg8::EpiS5 E{p_hid, rw_};
        { f32x4 acc_[2][2][4][2]; pg8::gemm_phase<pg8::EpiS5, pg8::MoeOrder<true>, true, true>(lds, S, E, D / 64, wave_, acc_); }
    }
    SEAM(7);
    REPS(8) if (IN(8)) { REPBAR(); PHV();
        LAS int* tl_ = (LAS int*)(lds + LDSCTL_OFF + 1024);
        const int total = __builtin_amdgcn_readfirstlane(((LAS int*)(lds + LDSCTL_OFF + 12288))[64]);
        pg8::MoeOrder<false> S; S.A = (const char*)p_hid; S.Bt = (const char*)p_edt; S.lda = EH; S.ldb = EH; S.rowoff = nullptr; S.tilee = tl_;
        S.npn = 4; S.nunits = ((total >> 8) + 64) * 4; S.G = G_; S.c = (int)blockIdx.x; S.estride = (size_t)D * EH * 2; S.bextra = 0;
        pg8::EpiS6 E{p_y};
        { f32x4 acc_[2][2][4][2]; pg8::gemm_phase<pg8::EpiS6, pg8::MoeOrder<false>, true, true>(lds, S, E, EH / 64, wave_, acc_); }
    }
    SEAM(8);
    REPS(9) if (IN(9)) { REPBAR(); PHV();
        LAS int* so_ = (LAS int*)(lds + LDSCTL_OFF + 12288);
        const int total = __builtin_amdgcn_readfirstlane(so_[64]);
        const bool dry = (REP_PHASE >= 0) && (args.rep == 9) && rep_ == 0;
        typedef float f32x2_ __attribute__((ext_vector_type(2)));
        for (int tb = gw; tb < T; tb += 2 * NGW) {
            float a[2][16]; int pos[2]; float* o[2]; const u32x4* xr[2];
#pragma unroll
            for (int u = 0; u < 2; ++u) { const int t = (tb + u * NGW < T) ? tb + u * NGW : tb; o[u] = p_out + (size_t)t * D + lane_ * 16; xr[u] = (const u32x4*)(p_xm + (size_t)t * pg8::XM_PITCH + lane_ * 16); const int pk = (lane_ < 8) ? p_inv[t * 8 + lane_] : 0; pos[u] = (lane_ < 8) ? so_[pk >> 16] + (pk & 0xffff) : total + t; }
#pragma unroll
            for (int u = 0; u < 2; ++u)
#pragma unroll
                for (int i = 0; i < 2; ++i) { const u32x4 p = xr[u][i];
#pragma unroll
                    for (int j = 0; j < 4; ++j) { a[u][8 * i + 2 * j] = bflo(p[j]); a[u][8 * i + 2 * j + 1] = bfhi(p[j]); } }
#pragma unroll
            for (int k = 0; k < 9; ++k)
#pragma unroll
                for (int u = 0; u < 2; ++u) { const int p = __builtin_amdgcn_readlane(pos[u], k); const u32x4 v = *(const u32x4*)(p_y + (size_t)p * 1024 + lane_ * 16);
#pragma unroll
                    for (int i = 0; i < 4; ++i) { const f32x2_ d0 = __builtin_amdgcn_cvt_pk_f32_fp8((int)v[i], false), d1 = __builtin_amdgcn_cvt_pk_f32_fp8((int)v[i], true);
                        a[u][4 * i] += d0.x * pg8::Y_UNSCALE; a[u][4 * i + 1] += d0.y * pg8::Y_UNSCALE; a[u][4 * i + 2] += d1.x * pg8::Y_UNSCALE; a[u][4 * i + 3] += d1.y * pg8::Y_UNSCALE; } }
#pragma unroll
            for (int u = 0; u < 2; ++u) {
                if (u == 1 && tb + NGW >= T) break;
                float ssq = 0.f;
#pragma unroll
                for (int i = 0; i < 16; ++i) ssq += a[u][i] * a[u][i];
                const float r = rsqrtf(wave_sum(ssq) * (1.0f / D) + EPS);
                if (dry && a[u][0] != 123456.789f) continue;
#pragma unroll
                for (int i = 0; i < 4; ++i) { const f32x4 g = *(const f32x4*)(p_g_final + lane_ * 16 + 4 * i);
                    *(f32x4*)(o[u] + 4 * i) = (f32x4){a[u][4 * i] * r * g.x, a[u][4 * i + 1] * r * g.y, a[u][4 * i + 2] * r * g.z, a[u][4 * i + 3] * r * g.w}; }
            }
        }
    }
#undef IN
#undef SEAM
}


#undef p_x
constexpr int N_PHASES = 10;
extern "C" void kernel_launch(void* const* d_in, const int* in_sizes, int n_in, void* d_out, int out_size, void* d_ws, size_t ws_size, hipStream_t stream) {
    static int grid = 0;
    if (grid == 0) {
        if (n_in != 20 || ws_size < WS_END || out_size != T * D) { fprintf(stderr, "kernel_launch: unexpected shapes / workspace (%zu)\n", ws_size); grid = -1; return; }
        int dev = 0, cus = 0;
        if (hipGetDevice(&dev) != hipSuccess || hipDeviceGetAttribute(&cus, hipDeviceAttributeMultiprocessorCount, dev) != hipSuccess) { grid = -1; return; }
        if (hipFuncSetAttribute((const void*)mega_fwd, hipFuncAttributeMaxDynamicSharedMemorySize, LDS_BYTES) != hipSuccess) { fprintf(stderr, "kernel_launch: hipFuncSetAttribute failed\n"); grid = -1; return; }
        int per_cu = 0;
        if (hipOccupancyMaxActiveBlocksPerMultiprocessor(&per_cu, (const void*)mega_fwd, NTHR, LDS_BYTES) != hipSuccess || per_cu < 1) { fprintf(stderr, "kernel_launch: occupancy query says %d\n", per_cu); }
        (void)hipGetLastError();
        grid = cus;
    }
    if (grid < 0) return;
    if (hipMemsetAsync((char*)d_ws + WS_CTL, 0, CTL_BYTES, stream) != hipSuccess) return;
    Args a{};
    for (int i = 0; i < 20; ++i) a.in[i] = (const float*)d_in[i];
    a.out = (float*)d_out; a.ws = (unsigned char*)d_ws; a.rep = REP_PHASE; a.stag = STAG_G2; a.exb = PROBE_DRY;
#if MK_PER_PHASE
    for (int p = 0; p < N_PHASES; ++p) { a.ph_lo = p; a.ph_hi = p + 1; hipLaunchKernelGGL(mega_fwd, dim3(grid), dim3(NTHR), LDS_BYTES, stream, a); }
#else
    a.ph_lo = 0; a.ph_hi = N_PHASES;
    hipLaunchKernelGGL(mega_fwd, dim3(grid), dim3(NTHR), LDS_BYTES, stream, a);
#endif
}
```

```cpp
#include <hip/hip_runtime.h>
#include <stdint.h>
#include <cstdio>

#ifndef STAG_G2
#define STAG_G2 0
#endif
#ifndef PROBE_DRY
#define PROBE_DRY 0
#endif
#ifndef REP_PHASE
#define REP_PHASE -1
#endif
#ifndef MK_PER_PHASE
#define MK_PER_PHASE 0
#endif

typedef unsigned short bf16;
typedef unsigned int u32;
#define GAS __attribute__((address_space(1)))
#define LAS __attribute__((address_space(3)))
typedef float f32x4 __attribute__((ext_vector_type(4)));
typedef short bf16x8 __attribute__((ext_vector_type(8)));
typedef unsigned u32x4 __attribute__((ext_vector_type(4)));
typedef unsigned u32x2 __attribute__((ext_vector_type(2)));
#define RLX_AGENT __ATOMIC_RELAXED, __HIP_MEMORY_SCOPE_AGENT

constexpr int T = 16384, D = 1024, SEQ = 2048, NIN = 4096;
constexpr int NE = 64, TOPK = 8, EH = 256;
constexpr float EPS = 1e-6f, ROUTED_SCALE = 2.5f;
constexpr int MAXROWS = T * TOPK + NE * 256 + T;
constexpr int NWAVES = 8, NTHR = 512;

constexpr size_t MiB = 1u << 20;
constexpr size_t WS_CTL = 0, CTL_BYTES = 32768;
constexpr size_t WS_TOPE = 1 * MiB;
constexpr size_t WS_TOPW = WS_TOPE + 512 * 1024;
constexpr size_t WS_INV = WS_TOPW + 512 * 1024;
constexpr size_t WS_ROWTOK = WS_INV + 512 * 1024;
constexpr size_t WS_ROWW = WS_ROWTOK + 640 * 1024;
constexpr size_t WS_OFF = WS_ROWW + 1280 * 1024;
constexpr size_t WS_TILEE = WS_OFF + 1024;
constexpr size_t WS_RT = WS_TILEE + 4096;
constexpr int ECAP = T;
constexpr size_t WS_EDT = 5 * MiB;
constexpr size_t WS_WTIN = 38 * MiB;
constexpr size_t WS_WTAB = 46 * MiB;
constexpr size_t WS_WTO = 48 * MiB;
constexpr size_t WS_EGUT = 51 * MiB;
constexpr size_t WS_H = 116 * MiB;
constexpr size_t WS_UBCV = 148 * MiB;
constexpr size_t WS_GATES = 212 * MiB;
constexpr size_t WS_H8 = 84 * MiB;
constexpr size_t WS_X8 = 100 * MiB;
constexpr size_t WS_HID = 203 * MiB;
constexpr size_t WS_Y = 38 * MiB;
constexpr size_t WS_END = 283 * MiB;
static_assert(WS_RT + (size_t)T * 8 <= WS_EDT, "tables");
static_assert(WS_EDT + (size_t)65 * 1024 * 256 <= WS_WTIN, "edt");
static_assert(WS_EGUT + (size_t)65 * 512 * 1024 <= WS_H, "egut");
static_assert(WS_HID + (size_t)MAXROWS * 256 <= WS_END, "hid");
static_assert(WS_Y + (size_t)MAXROWS * 1024 <= WS_HID, "y");
static_assert(WS_GATES + (size_t)T * 2048 * 2 <= WS_END, "gates");
constexpr int CW_CNT = 0, CW_CUR = 64;
constexpr int CW_BAR = 4096;
constexpr int CW_SB = 3072;
constexpr int CW_GRP = 1024;

constexpr int RING_BYTES = 131072;
constexpr int LDSCTL_OFF = RING_BYTES, MISC_OFF = LDSCTL_OFF + 320;
constexpr int LDS_BYTES = 163840;

__device__ __forceinline__ float bf2f(bf16 b) { return __uint_as_float(((u32)b) << 16); }
__device__ __forceinline__ float bflo(u32 w) { return __uint_as_float(w << 16); }
__device__ __forceinline__ float bfhi(u32 w) { return __uint_as_float(w & 0xffff0000u); }
__device__ __forceinline__ u32 f2bf(float f) { u32 u = __float_as_uint(f); return (u + 0x7fffu + ((u >> 16) & 1u)) >> 16; }
__device__ __forceinline__ u32 pk2(float lo, float hi) { return f2bf(lo) | (f2bf(hi) << 16); }
__device__ __forceinline__ float sigmoid_fast(float x) { return __builtin_amdgcn_rcpf(1.0f + __expf(-x)); }
__device__ __forceinline__ float sigmoid_acc(float x) { return 1.0f / (1.0f + expf(-x)); }
__device__ __forceinline__ float wave_sum(float v) {
    v += __int_as_float(__builtin_amdgcn_ds_swizzle(__float_as_int(v), (1 << 10) | 0x1f));
    v += __int_as_float(__builtin_amdgcn_ds_swizzle(__float_as_int(v), (2 << 10) | 0x1f));
    v += __int_as_float(__builtin_amdgcn_ds_swizzle(__float_as_int(v), (4 << 10) | 0x1f));
    v += __int_as_float(__builtin_amdgcn_ds_swizzle(__float_as_int(v), (8 << 10) | 0x1f));
    v += __int_as_float(__builtin_amdgcn_ds_swizzle(__float_as_int(v), (16 << 10) | 0x1f));
    return __int_as_float(__builtin_amdgcn_readlane(__float_as_int(v), 0)) + __int_as_float(__builtin_amdgcn_readlane(__float_as_int(v), 32));
}
#define LDS_WAIT() asm volatile("s_waitcnt lgkmcnt(0)" ::: "memory")
#define VM_WAIT() asm volatile("s_waitcnt vmcnt(0)" ::: "memory")
__device__ __forceinline__ int ld_agent(const int* p) { return (int)__hip_atomic_load((const u32*)p, RLX_AGENT); }

namespace pg8 {
constexpr int BM = 256, BK = 64, HALF = 128, HTB = HALF * BK * 2, STAGE_BYTES = 8 * HTB, NXCD = 8, WGM = 8;
__host__ __device__ __forceinline__ int lds_byte(int r, int c) { const int st = (r >> 4) * 2 + (c >> 5), rr = r & 15, cc = c & 31, ob = rr * 64 + cc * 2; return st * 1024 + (ob ^ (((ob >> 9) & 1) << 5)); }
__host__ __device__ __forceinline__ void stage_rc(int b, int& R, int& C) { const int st = b / 1024, sb = b % 1024, swz = sb ^ (((sb >> 9) & 1) << 5); R = (st >> 1) * 16 + swz / 64; C = (st & 1) * 32 + (swz % 64) / 2; }
__host__ __device__ __forceinline__ int perm32(int rho) { const int n = rho >> 4, i = rho & 15; return 8 * (i >> 2) + 4 * n + (i & 3); }

struct Unit { int pm, pn, aux, li; };

__device__ __forceinline__ int xcd_remap(int L, int nwg) { const int q = nwg / NXCD, r = nwg % NXCD, xcd = L % NXCD, o = L / NXCD; return (xcd < r ? xcd * (q + 1) : r * (q + 1) + (xcd - r) * q) + o; }

struct RegOrder {
    static constexpr bool GATHER = false;
    const char* A; const char* Bt; int lda, ldb;
    int nM, nN, nwg, G, c, halves, khalf;
    __device__ __forceinline__ void init(const void* A_, const void* Bt_, int lda_, int ldb_, int M, int N, int G_, int c_, int halves_, int khalf_) {
        A = (const char*)A_; Bt = (const char*)Bt_; lda = lda_; ldb = ldb_; nM = M / BM; nN = N / BM; nwg = nM * nN; G = G_; c = c_; halves = halves_; khalf = khalf_; }
    __device__ __forceinline__ bool next(int i, Unit& u) const {
        const int round = (halves == 2) ? (i >> 1) : i; u.aux = (halves == 2) ? (i & 1) : 0;
        const long L = (long)round * G + c; if (L >= nwg) return false;
        const int wgid = xcd_remap((int)L, nwg);
        const int nig = WGM * nN, gid = wgid / nig, fm = gid * WGM, gsz = (nM - fm) < WGM ? (nM - fm) : WGM;
        u.pm = fm + ((wgid % nig) % gsz); u.pn = (wgid % nig) / gsz; u.li = i; return true;
    }
    __device__ __forceinline__ const char* a_base(const Unit& u) const { return A + (size_t)u.pm * BM * lda * 2 + (size_t)u.aux * khalf; }
    __device__ __forceinline__ const char* b_base(const Unit& u) const { return Bt + (size_t)u.pn * BM * ldb * 2 + (size_t)u.aux * khalf; }
    __device__ __forceinline__ unsigned a_row_off(const Unit&, int) const { return 0u; }
};
template <bool GATHER_> struct MoeOrder {
    static constexpr bool GATHER = GATHER_;
    const char* A; const char* Bt; int lda, ldb; const LAS unsigned* rowoff; const LAS int* tilee; int nunits, npn, G, c; size_t estride, bextra;
    __device__ __forceinline__ bool next(int i, Unit& u) const {
        const long L = (long)i * G + c; if (L >= nunits) return false;
        const int wgid = xcd_remap((int)L, nunits);
        u.pm = wgid / npn; u.pn = wgid - u.pm * npn; u.aux = __builtin_amdgcn_readfirstlane(tilee[u.pm]); u.li = i; return true;
    }
    __device__ __forceinline__ const char* a_base(const Unit& u) const { return GATHER ? A : A + (size_t)u.pm * BM * lda * 2; }
    __device__ __forceinline__ const char* b_base(const Unit& u) const { return Bt + (size_t)u.aux * estride + bextra + (size_t)u.pn * BM * ldb * 2; }
    __device__ __forceinline__ unsigned a_row_off(const Unit& u, int r) const { return rowoff[u.li * BM + r]; }
};

template <class TT> __device__ __forceinline__ TT* at(const void* base, unsigned byteoff) { return (TT*)((const char*)base + byteoff); }
__device__ __forceinline__ unsigned pk4_fp8(float a, float b, float c, float d, float s) {
    a = __builtin_amdgcn_fmed3f(a * s, -448.f, 448.f); b = __builtin_amdgcn_fmed3f(b * s, -448.f, 448.f); c = __builtin_amdgcn_fmed3f(c * s, -448.f, 448.f); d = __builtin_amdgcn_fmed3f(d * s, -448.f, 448.f);
    int p = __builtin_amdgcn_cvt_pk_fp8_f32(a, b, 0, false); p = __builtin_amdgcn_cvt_pk_fp8_f32(c, d, p, true); return (unsigned)p; }
__device__ __forceinline__ unsigned cvt_pk_bf16(float lo, float hi) { unsigned r; asm volatile("v_cvt_pk_bf16_f32 %0, %1, %2" : "=v"(r) : "v"(lo), "v"(hi)); return r; }

struct EpiS1 { static constexpr bool PERM16 = false, PERM = true, MID = false, INIT = false; static constexpr int NVM = 8;
    bf16* ubcv; const float* rt0;
    __device__ __forceinline__ void operator()(const f32x4 (&acc)[2][2][4][2], const Unit& u, int wr, int wc, int fr, int fq) const {
        asm volatile("" : "+v"(fr), "+v"(fq));
        const int row0 = u.pm * BM + wr * 64 + fr;
        if (u.pn < 4) {
            const int col0 = u.pn * BM + wc * 32 + 8 * fq;
#pragma unroll
            for (int ai = 0; ai < 2; ++ai)
#pragma unroll
                for (int m = 0; m < 4; ++m) { const unsigned ro = ((unsigned)(row0 + ai * HALF + m * 16) * 2048u + (unsigned)col0) * 2u; const float rs = *at<const float>(rt0, (unsigned)(row0 + ai * HALF + m * 16) * 4u);
#pragma unroll
                    for (int bj = 0; bj < 2; ++bj) { const f32x4 v0 = acc[ai][bj][m][0] * rs, v1 = acc[ai][bj][m][1] * rs;
                        u32x4 w; w.x = cvt_pk_bf16(v0[0], v0[1]); w.y = cvt_pk_bf16(v0[2], v0[3]); w.z = cvt_pk_bf16(v1[0], v1[1]); w.w = cvt_pk_bf16(v1[2], v1[3]);
                        *at<u32x4>(ubcv, ro + bj * HALF * 2) = w; }
                    asm volatile("" ::: "memory"); }
        } else {
            const int col0 = 1024 + (u.pn - 4) * HALF + wc * 32 + 8 * fq;
#pragma unroll
            for (int ai = 0; ai < 2; ++ai)
#pragma unroll
                for (int m = 0; m < 4; ++m) { const unsigned ro = ((unsigned)(row0 + ai * HALF + m * 16) * 2048u + (unsigned)col0) * 2u; const float rs = *at<const float>(rt0, (unsigned)(row0 + ai * HALF + m * 16) * 4u), rs2 = rs * rs;
                    const f32x4 p0 = acc[ai][0][m][0] * acc[ai][1][m][0] * rs2, p1 = acc[ai][0][m][1] * acc[ai][1][m][1] * rs2;
                    u32x4 w; w.x = cvt_pk_bf16(p0[0], p0[1]); w.y = cvt_pk_bf16(p0[2], p0[3]); w.z = cvt_pk_bf16(p1[0], p1[1]); w.w = cvt_pk_bf16(p1[2], p1[3]);
                    *at<u32x4>(ubcv, ro) = w;
                    asm volatile("" ::: "memory"); }
        }
    }
};
struct EpiS1G { static constexpr bool PERM16 = false, PERM = true, MID = false, INIT = false; static constexpr int NVM = 16;
    bf16* gates; const float* bgate; float as;
    __device__ __forceinline__ void operator()(const f32x4 (&acc)[2][2][4][2], const Unit& u, int wr, int wc, int fr, int fq) const {
        asm volatile("" : "+v"(fr), "+v"(fq));
        const int row0 = u.pm * BM + wr * 64 + fr;
        {
            const int col0 = u.pn * HALF + wc * 32 + 8 * fq;
            f32x4 ba[2], bb[2];
#pragma unroll
            for (int n = 0; n < 2; ++n) { ba[n] = *at<const f32x4>(bgate, (unsigned)(col0 + 4 * n) * 4u); bb[n] = *at<const f32x4>(bgate, (unsigned)(1024 + col0 + 4 * n) * 4u); }
#pragma unroll
            for (int ai = 0; ai < 2; ++ai)
#pragma unroll
                for (int m = 0; m < 4; ++m) { const unsigned ro = ((unsigned)(row0 + ai * HALF + m * 16) * 2048u + (unsigned)col0) * 2u;
                    f32x4 rt[2], gb[2];
#pragma unroll
                    for (int n = 0; n < 2; ++n)
#pragma unroll
                        for (int j = 0; j < 4; ++j) { const float ea = __expf(-(acc[ai][0][m][n][j] * as + ba[n][j])), eb = __expf(-(acc[ai][1][m][n][j] * as + bb[n][j]));
                            gb[n][j] = __builtin_amdgcn_rcpf(1.0f + eb); rt[n][j] = (1.0f + eb) * __builtin_amdgcn_rcpf(1.0f + ea); }
                    u32x4 w; w.x = cvt_pk_bf16(rt[0][0], rt[0][1]); w.y = cvt_pk_bf16(rt[0][2], rt[0][3]); w.z = cvt_pk_bf16(rt[1][0], rt[1][1]); w.w = cvt_pk_bf16(rt[1][2], rt[1][3]);
                    *at<u32x4>(gates, ro) = w;
                    w.x = cvt_pk_bf16(gb[0][0], gb[0][1]); w.y = cvt_pk_bf16(gb[0][2], gb[0][3]); w.z = cvt_pk_bf16(gb[1][0], gb[1][1]); w.w = cvt_pk_bf16(gb[1][2], gb[1][3]);
                    *at<u32x4>(gates, ro + 2048u) = w;
                    asm volatile("" ::: "memory"); }
        }
    }
};
struct EpiS2B { static constexpr bool PERM16 = false, PERM = true, MID = true, INIT = false; static constexpr int NVM = 16;
    const bf16* gates; bf16* merged;
    __device__ __forceinline__ void mid(f32x4 (&acc)[2][2][4][2], const Unit& u, int wr, int wc, int fr, int fq) const {
        asm volatile("" : "+v"(fr), "+v"(fq));
        const int row0 = u.pm * BM + wr * 64 + fr, col0 = u.pn * BM + wc * 32 + 8 * fq;
#pragma unroll
        for (int ai = 0; ai < 2; ++ai)
#pragma unroll
            for (int m = 0; m < 4; ++m) { const unsigned go = ((unsigned)(row0 + ai * HALF + m * 16) * 2048u + (unsigned)col0) * 2u;
#pragma unroll
                for (int bj = 0; bj < 2; ++bj) { const u32x4 a = *at<const u32x4>(gates, go + bj * HALF * 2);
                    f32x4& v0 = acc[ai][bj][m][0]; f32x4& v1 = acc[ai][bj][m][1];
                    v0[0] *= bflo(a.x); v0[1] *= bfhi(a.x); v0[2] *= bflo(a.y); v0[3] *= bfhi(a.y); v1[0] *= bflo(a.z); v1[1] *= bfhi(a.z); v1[2] *= bflo(a.w); v1[3] *= bfhi(a.w); }
                asm volatile("" ::: "memory"); }
    }
    __device__ __forceinline__ void operator()(const f32x4 (&acc)[2][2][4][2], const Unit& u, int wr, int wc, int fr, int fq) const {
        asm volatile("" : "+v"(fr), "+v"(fq));
        const int row0 = u.pm * BM + wr * 64 + fr, col0 = u.pn * BM + wc * 32 + 8 * fq;
#pragma unroll
        for (int ai = 0; ai < 2; ++ai)
#pragma unroll
            for (int m = 0; m < 4; ++m) { const unsigned r = (unsigned)(row0 + ai * HALF + m * 16);
#pragma unroll
                for (int bj = 0; bj < 2; ++bj) { const int c = col0 + bj * HALF;
                    const u32x4 g = *at<const u32x4>(gates, (r * 2048u + 1024u + (unsigned)c) * 2u);
                    f32x4 v0 = acc[ai][bj][m][0], v1 = acc[ai][bj][m][1];
                    v0[0] *= bflo(g.x); v0[1] *= bfhi(g.x); v0[2] *= bflo(g.y); v0[3] *= bfhi(g.y); v1[0] *= bflo(g.z); v1[1] *= bfhi(g.z); v1[2] *= bflo(g.w); v1[3] *= bfhi(g.w);
                    u32x4 w; w.x = cvt_pk_bf16(v0[0], v0[1]); w.y = cvt_pk_bf16(v0[2], v0[3]); w.z = cvt_pk_bf16(v1[0], v1[1]); w.w = cvt_pk_bf16(v1[2], v1[3]);
                    *at<u32x4>(merged, (r * 2048u + (unsigned)c) * 2u) = w; }
                asm volatile("" ::: "memory"); }
    }
};
constexpr int XM_PITCH = 2048;
struct EpiS3 { static constexpr bool PERM16 = false, PERM = true, MID = false, INIT = true; static constexpr int NVM = 16;
    const bf16* x; bf16* xm;
    __device__ __forceinline__ void init(f32x4 (&acc)[2][2][4][2], const Unit& u, int wr, int wc, int fr, int fq) const {
        asm volatile("" : "+v"(fr), "+v"(fq));
        const int row0 = u.pm * BM + wr * 64 + fr, col0 = u.pn * BM + wc * 32 + 8 * fq;
#pragma unroll
        for (int ai = 0; ai < 2; ++ai)
#pragma unroll
            for (int m = 0; m < 4; ++m) { const unsigned o = ((unsigned)(row0 + ai * HALF + m * 16) * (unsigned)D + (unsigned)col0) * 2u;
#pragma unroll
                for (int bj = 0; bj < 2; ++bj) { const u32x4 p = *at<const u32x4>(x, o + bj * HALF * 2);
                    acc[ai][bj][m][0] = (f32x4){bflo(p.x), bfhi(p.x), bflo(p.y), bfhi(p.y)}; acc[ai][bj][m][1] = (f32x4){bflo(p.z), bfhi(p.z), bflo(p.w), bfhi(p.w)}; } }
    }
    __device__ __forceinline__ void operator()(const f32x4 (&acc)[2][2][4][2], const Unit& u, int wr, int wc, int fr, int fq) const {
        asm volatile("" : "+v"(fr), "+v"(fq));
        const int row0 = u.pm * BM + wr * 64 + fr, col0 = u.pn * BM + wc * 32 + 8 * fq;
#pragma unroll
        for (int ai = 0; ai < 2; ++ai)
#pragma unroll
            for (int m = 0; m < 4; ++m) { const unsigned ro = ((unsigned)(row0 + ai * HALF + m * 16) * (unsigned)XM_PITCH + (unsigned)col0) * 2u;
#pragma unroll
                for (int bj = 0; bj < 2; ++bj) { const f32x4 v0 = acc[ai][bj][m][0], v1 = acc[ai][bj][m][1];
                    u32x4 w; w.x = cvt_pk_bf16(v0[0], v0[1]); w.y = cvt_pk_bf16(v0[2], v0[3]); w.z = cvt_pk_bf16(v1[0], v1[1]); w.w = cvt_pk_bf16(v1[2], v1[3]);
                    *at<u32x4>(xm, ro + bj * HALF * 2) = w; }
                asm volatile("" ::: "memory"); }
    }
};
constexpr float H_SCALE = 16.0f, WD_SCALE = 64.0f, X8_SCALE = 16.0f, WG_SCALE = 128.0f, H8_SCALE = 16.0f, WI_SCALE = 128.0f;
constexpr float dummy_scale_doc = 0.f;
struct EpiS5 { static constexpr bool PERM16 = false, PERM = true, MID = false, INIT = false; static constexpr int NVM = 8;
    unsigned char* hid; const LAS float* rowrw;
    __device__ __forceinline__ void operator()(const f32x4 (&acc)[2][2][4][2], const Unit& u, int wr, int wc, int fr, int fq) const {
        asm volatile("" : "+v"(fr), "+v"(fq));
        const int row0 = u.pm * BM + wr * 64 + fr, col0 = u.pn * HALF + wc * 32 + 8 * fq;
#pragma unroll
        for (int ai = 0; ai < 2; ++ai)
#pragma unroll
            for (int m = 0; m < 4; ++m) { f32x4 h0, h1; typedef float f32x2_ __attribute__((ext_vector_type(2))); const f32x2_ rw = *(const LAS f32x2_*)(rowrw + 2 * (u.li * BM + wr * 64 + fr + ai * HALF + m * 16));
#pragma unroll
                for (int j = 0; j < 4; ++j) { const float g0 = acc[ai][0][m][0][j] * rw.x, g1 = acc[ai][0][m][1][j] * rw.x;
                    h0[j] = g0 * sigmoid_fast(g0) * acc[ai][1][m][0][j] * rw.y; h1[j] = g1 * sigmoid_fast(g1) * acc[ai][1][m][1][j] * rw.y; }
                u32x2 w;
                w.x = pk4_fp8(h0[0], h0[1], h0[2], h0[3], H_SCALE); w.y = pk4_fp8(h1[0], h1[1], h1[2], h1[3], H_SCALE);
                *at<u32x2>(hid, (unsigned)(row0 + ai * HALF + m * 16) * (unsigned)EH + (unsigned)col0) = w;
                asm volatile("" ::: "memory"); }
    }
};
constexpr float Y_SCALE = 16.0f, Y_UNSCALE = 1.0f / 16.0f, Y_ACC_SCALE = 16.0f / (16.0f * 64.0f);
__device__ __forceinline__ unsigned pack4_fp8(const f32x4 v) { return pk4_fp8(v[0], v[1], v[2], v[3], Y_ACC_SCALE); }
struct EpiS6 { static constexpr bool PERM16 = true, PERM = false, MID = false, INIT = false; static constexpr int NVM = 8;
    unsigned char* y; const LAS int* yd;
    __device__ __forceinline__ void operator()(const f32x4 (&acc)[2][2][4][2], const Unit& u, int wr, int wc, int fr, int fq) const {
        asm volatile("" : "+v"(fr), "+v"(fq));
        const int col0 = u.pn * BM + wc * 64 + 16 * fq;
#pragma unroll
        for (int ai = 0; ai < 2; ++ai)
#pragma unroll
            for (int m = 0; m < 4; ++m) { const int d = yd[u.li * BM + wr * 64 + fr + ai * HALF + m * 16];
                u32x4 w; w.x = pack4_fp8(acc[ai][0][m][0]); w.y = pack4_fp8(acc[ai][0][m][1]); w.z = pack4_fp8(acc[ai][1][m][0]); w.w = pack4_fp8(acc[ai][1][m][1]);
                if (d >= 0) *at<u32x4>(y, (unsigned)d + (unsigned)col0) = w;
                asm volatile("" ::: "memory"); }
    }
};

template <bool F8> struct FragSel { struct type { bf16x8 k[2]; }; };
template <> struct FragSel<true> { struct type { int v __attribute__((ext_vector_type(8))); }; };
template <class Epi, class Sched, bool ALIGN_EPI, bool SP2, bool F8 = false>
__device__ __forceinline__ void gemm_phase(LAS unsigned char* lds, const Sched& S, const Epi& E, const int nt_in, const int wid, f32x4 (&acc)[2][2][4][2]) {
    int lane = (int)__builtin_amdgcn_mbcnt_hi(~0u, __builtin_amdgcn_mbcnt_lo(~0u, 0u)); asm volatile("" : "+v"(lane));
    const int tid = wid * 64 + lane, wr = wid >> 2, wc = wid & 3, fr = lane & 15, fq = lane >> 4;
    const int lda = S.lda, ldb = S.ldb;
    int nt = nt_in; asm volatile("" : "+s"(nt));
    unsigned voffA[2], voffB[2], colA[2]; int RA[2];
#pragma unroll
    for (int i = 0; i < 2; ++i) { int R, C; stage_rc(tid * 16 + i * 8192, R, C); const int p32 = perm32(R & 31);
        const int Rb = Epi::PERM16 ? (64 * (R >> 5) + ((p32 >> 3) << 4) + (p32 & 7)) : (Epi::PERM ? ((R & ~31) + p32) : R);
        voffA[i] = (unsigned)(R * lda + C) * 2u; voffB[i] = (unsigned)(Rb * ldb + C) * 2u; RA[i] = R; colA[i] = (unsigned)C * 2u; }
    const size_t kstep = (size_t)(BK * 2);
    const size_t hstepA = (size_t)HALF * lda * 2, hstepB = (size_t)(Epi::PERM16 ? 8 : HALF) * ldb * 2;
    const unsigned ldsw = (unsigned)wid * 1024u;
    const int aoff = lds_byte(wr * 64 + fr, fq * 8), boff = lds_byte(wc * 32 + fr, fq * 8);
#define PG8_SA(b, h) (((b) * 2 + (h)) * HTB)
#define PG8_SB(b, h) ((4 + (b) * 2 + (h)) * HTB)
#define PG8_GLDS(gp, lp) __builtin_amdgcn_global_load_lds((const unsigned*)(gp), (LAS unsigned*)(lp), 16, 0, 0)
#define PG8_STAGE_A(bufoff, wn, h, kb) do { _Pragma("unroll") for (int _i = 0; _i < 2; ++_i) { \
        const char* _p = Sched::GATHER ? (((wn) ? nA : cA) + (kb) + ((wn) ? gn[h][_i] : ga[h][_i])) : (((wn) ? nA : cA) + (size_t)(h) * hstepA + (kb) + voffA[_i]); \
        PG8_GLDS(_p, lds + (bufoff) + ldsw + _i * 8192); } } while (0)
#define PG8_STAGE_B(bufoff, gbase) do { _Pragma("unroll") for (int _i = 0; _i < 2; ++_i) PG8_GLDS((const char*)(gbase) + voffB[_i], lds + (bufoff) + ldsw + _i * 8192); } while (0)
#define PG8_LD1(dst, addr) do { if constexpr (F8) { const i32x4_ lo_ = *(const LAS i32x4_*)(addr), hi_ = *(const LAS i32x4_*)((addr) + 1024); dst.v = __builtin_shufflevector(lo_, hi_, 0, 1, 2, 3, 4, 5, 6, 7); } \
        else { dst.k[0] = *(const LAS bf16x8*)(addr); dst.k[1] = *(const LAS bf16x8*)((addr) + 1024); } } while (0)
#define PG8_LDA(dst, b, h) do { _Pragma("unroll") for (int m = 0; m < 4; ++m) PG8_LD1(dst[m], lds + PG8_SA(b, h) + aoff + m * 2048); } while (0)
#define PG8_LDB(dst, b, h) do { _Pragma("unroll") for (int n = 0; n < 2; ++n) PG8_LD1(dst[n], lds + PG8_SB(b, h) + boff + n * 2048); } while (0)
#define PG8_MMA(ai, bj, At, Bt) do { __builtin_amdgcn_s_setprio(1); _Pragma("unroll") for (int m = 0; m < 4; ++m) _Pragma("unroll") for (int n = 0; n < 2; ++n) { \
        if constexpr (F8) asm volatile("v_mfma_f32_16x16x128_f8f6f4 %0, %1, %2, %0" : "+v"(acc[ai][bj][m][n]) : "v"(Bt[n].v), "v"(At[m].v));     \
        else { _Pragma("unroll") for (int k = 0; k < 2; ++k) acc[ai][bj][m][n] = __builtin_amdgcn_mfma_f32_16x16x32_bf16(Bt[n].k[k], At[m].k[k], acc[ai][bj][m][n], 0, 0, 0); } } \
        __builtin_amdgcn_s_setprio(0); } while (0)
#define PG8_WAIT_V(n) asm volatile("s_waitcnt vmcnt(" #n ")" ::: "memory")
#define PG8_WAIT_VN(n) asm volatile("s_waitcnt vmcnt(%0)" :: "n"(n) : "memory")
#define PG8_WAIT_F(f) do { if (f) PG8_WAIT_VN(8 + Epi::NVM); else PG8_WAIT_V(8); } while (0)
#define PG8_WAIT_L(n) asm volatile("s_waitcnt lgkmcnt(" #n ")" ::: "memory")
#define PG8_BAR __builtin_amdgcn_s_barrier()
#define PG8_SCHED __builtin_amdgcn_sched_barrier(0)
    Unit cur, nxt; int ui = 0;
    if (!S.next(0, cur)) return;
    if constexpr (!Epi::INIT) {
#pragma unroll
    for (int a = 0; a < 2; ++a)
#pragma unroll
        for (int b = 0; b < 2; ++b)
#pragma unroll
            for (int m = 0; m < 4; ++m)
#pragma unroll
                for (int n = 0; n < 2; ++n) acc[a][b][m][n] = (f32x4){0.f, 0.f, 0.f, 0.f};
    }
    typedef int i32x8_ __attribute__((ext_vector_type(8))); typedef int i32x4_ __attribute__((ext_vector_type(4)));
    using frag_t = typename FragSel<F8>::type;
    frag_t At[4], B0[2], B1[2];
    unsigned ga[2][2], gn[2][2];
#pragma unroll
    for (int h = 0; h < 2; ++h)
#pragma unroll
        for (int i = 0; i < 2; ++i) { ga[h][i] = Sched::GATHER ? S.a_row_off(cur, h * HALF + RA[i]) + colA[i] : 0u; gn[h][i] = ga[h][i]; }
    const char* cA = S.a_base(cur); const char* cB = S.b_base(cur);
    const char* nA = cA; const char* nB = cB;
    if constexpr (SP2) {
        PG8_STAGE_B(PG8_SB(0, 0), cB); PG8_STAGE_B(PG8_SB(0, 1), cB + hstepB); PG8_STAGE_A(PG8_SA(0, 0), false, 0, 0); PG8_STAGE_A(PG8_SA(0, 1), false, 1, 0);
        if (wr == 1) PG8_BAR;
        PG8_WAIT_V(2); PG8_BAR;
        PG8_STAGE_B(PG8_SB(1, 0), cB + kstep); PG8_STAGE_A(PG8_SA(1, 0), false, 0, kstep); PG8_STAGE_B(PG8_SB(1, 1), cB + hstepB + kstep);
        PG8_WAIT_V(6); PG8_BAR;
    } else {
        PG8_STAGE_B(PG8_SB(0, 0), cB); PG8_STAGE_A(PG8_SA(0, 0), false, 0, 0); PG8_STAGE_B(PG8_SB(0, 1), cB + hstepB); PG8_STAGE_A(PG8_SA(0, 1), false, 1, 0);
        if (wr == 1) PG8_BAR;
        PG8_WAIT_V(4); PG8_BAR;
        PG8_STAGE_B(PG8_SB(1, 0), cB + kstep); PG8_STAGE_A(PG8_SA(1, 0), false, 0, kstep); PG8_STAGE_B(PG8_SB(1, 1), cB + hstepB + kstep);
        PG8_WAIT_V(6); PG8_BAR;
    }
    for (;;) {
        const bool has_next = S.next(ui + 1, nxt);
        if (has_next) { nA = S.a_base(nxt); nB = S.b_base(nxt); } else { nA = cA; nB = cB; }
        if constexpr (Sched::GATHER) {
#pragma unroll
            for (int h = 0; h < 2; ++h)
#pragma unroll
                for (int i = 0; i < 2; ++i) gn[h][i] = has_next ? S.a_row_off(nxt, h * HALF + RA[i]) + colA[i] : ga[h][i];
        }
        for (int t = 0; t < nt; t += 2) {
            const bool last = (t == nt - 2);
            if constexpr (Epi::MID) { if (t == (nt >> 1)) E.mid(acc, cur, wr, wc, fr, fq); }
            const size_t k1 = (size_t)(t + 1) * kstep;
            const size_t k2 = last ? 0 : (size_t)(t + 2) * kstep; const size_t k3 = k2 + kstep;
            const char* b2 = last ? nB : cB + (size_t)(t + 2) * kstep; const char* b3 = b2 + kstep;
            if constexpr (SP2) {
            PG8_LDB(B0, 0, 0); PG8_LDB(B1, 0, 1); PG8_SCHED; PG8_LDA(At, 0, 0); PG8_STAGE_A(PG8_SA(1, 1), false, 1, k1);
            PG8_WAIT_V(8); PG8_WAIT_L(0); PG8_BAR; PG8_MMA(0, 0, At, B0); PG8_MMA(0, 1, At, B1); PG8_BAR; PG8_SCHED;
            PG8_LDA(At, 0, 1); PG8_STAGE_B(PG8_SB(0, 0), b2); PG8_STAGE_B(PG8_SB(0, 1), b2 + hstepB); PG8_STAGE_A(PG8_SA(0, 0), last, 0, k2);
            PG8_WAIT_V(8); PG8_WAIT_L(0); PG8_BAR; PG8_MMA(1, 0, At, B0); PG8_MMA(1, 1, At, B1); PG8_BAR; PG8_SCHED;
            PG8_LDB(B0, 1, 0); PG8_LDB(B1, 1, 1); PG8_SCHED; PG8_LDA(At, 1, 0); PG8_STAGE_A(PG8_SA(0, 1), last, 1, k2);
            PG8_WAIT_V(8); PG8_WAIT_L(0); PG8_BAR; PG8_MMA(0, 0, At, B0); PG8_MMA(0, 1, At, B1); PG8_BAR; PG8_SCHED;
            PG8_LDA(At, 1, 1); PG8_STAGE_B(PG8_SB(1, 0), b3); PG8_STAGE_B(PG8_SB(1, 1), b3 + hstepB); PG8_STAGE_A(PG8_SA(1, 0), last, 0, k3);
            PG8_WAIT_V(8); PG8_WAIT_L(0); PG8_BAR; PG8_MMA(1, 0, At, B0); PG8_MMA(1, 1, At, B1); PG8_BAR; PG8_SCHED;
            } else {
            PG8_LDB(B0, 0, 0); PG8_SCHED; PG8_LDA(At, 0, 0); PG8_STAGE_A(PG8_SA(1, 1), false, 1, k1);
            PG8_WAIT_L(8); PG8_BAR; PG8_WAIT_L(0); PG8_MMA(0, 0, At, B0); PG8_BAR; PG8_SCHED;
            PG8_LDB(B1, 0, 1); PG8_STAGE_B(PG8_SB(0, 0), b2);
            PG8_BAR; PG8_WAIT_L(0); PG8_MMA(0, 1, At, B1); PG8_BAR;
            PG8_LDA(At, 0, 1); PG8_STAGE_A(PG8_SA(0, 0), last, 0, k2);
            PG8_BAR; PG8_WAIT_L(0); PG8_MMA(1, 0, At, B0); PG8_BAR; PG8_SCHED;
            PG8_STAGE_B(PG8_SB(0, 1), b2 + hstepB);
            PG8_WAIT_V(6); PG8_BAR; PG8_MMA(1, 1, At, B1); PG8_BAR;
            PG8_LDB(B0, 1, 0); PG8_SCHED; PG8_LDA(At, 1, 0); PG8_STAGE_A(PG8_SA(0, 1), last, 1, k2);
            PG8_WAIT_L(8); PG8_BAR; PG8_WAIT_L(0); PG8_MMA(0, 0, At, B0); PG8_BAR; PG8_SCHED;
            PG8_LDB(B1, 1, 1); PG8_STAGE_B(PG8_SB(1, 0), b3);
            PG8_BAR; PG8_WAIT_L(0); PG8_MMA(0, 1, At, B1); PG8_BAR;
            PG8_LDA(At, 1, 1); PG8_STAGE_A(PG8_SA(1, 0), last, 0, k3);
            PG8_BAR; PG8_WAIT_L(0); PG8_MMA(1, 0, At, B0); PG8_BAR; PG8_SCHED;
            PG8_STAGE_B(PG8_SB(1, 1), b3 + hstepB);
            PG8_WAIT_V(6); PG8_BAR; PG8_MMA(1, 1, At, B1); PG8_BAR;
            }
        }
        if constexpr (ALIGN_EPI) { if (wr == 0) PG8_BAR; }
        if constexpr (F8) asm volatile("s_nop 15\n\ts_nop 15" ::: "memory");
        E(acc, cur, wr, wc, fr, fq);
        if (!has_next) break;
#pragma unroll
        for (int a = 0; a < 2; ++a)
#pragma unroll
            for (int b = 0; b < 2; ++b)
#pragma unroll
                for (int m = 0; m < 4; ++m)
#pragma unroll
                    for (int n = 0; n < 2; ++n) acc[a][b][m][n] = (f32x4){0.f, 0.f, 0.f, 0.f};
        cur = nxt; cA = nA; cB = nB; ++ui;
#pragma unroll
        for (int h = 0; h < 2; ++h)
#pragma unroll
            for (int i = 0; i < 2; ++i) ga[h][i] = gn[h][i];
        if constexpr (ALIGN_EPI) { if (wr == 1) PG8_BAR; }
    }
    PG8_WAIT_V(0);
    if constexpr (!ALIGN_EPI) { if (wr == 0) PG8_BAR; }
    PG8_BAR;
#undef PG8_SA
#undef PG8_SB
#undef PG8_GLDS
#undef PG8_STAGE_A
#undef PG8_STAGE_B
#undef PG8_LDA
#undef PG8_LD1
#undef PG8_LDB
#undef PG8_MMA
#undef PG8_WAIT_V
#undef PG8_WAIT_VN
#undef PG8_WAIT_F
#undef PG8_WAIT_L
#undef PG8_BAR
#undef PG8_SCHED
}
}

#define XB_TMO      128
#define XB_XCNT(j)  (256  + 64 * (j))
#define XB_XSUB(j)  (1280 + 64 * (j))
#define XB_XGEN(j)  (2304 + 64 * (j))
#define XB_TOP      3328
#define XB_TOPGEN   3392
#define XCD_BAR_WORDS 3456
#define XB_SPIN_CAP (1u << 18)
__device__ __forceinline__ unsigned xb_ld(unsigned* p)              { return __hip_atomic_load(p, __ATOMIC_RELAXED, __HIP_MEMORY_SCOPE_AGENT); }
__device__ __forceinline__ unsigned xb_add(unsigned* p, unsigned v) { return __hip_atomic_fetch_add(p, v, __ATOMIC_RELAXED, __HIP_MEMORY_SCOPE_AGENT); }
__device__ __forceinline__ unsigned xb_xcc_id() { return (unsigned)__builtin_amdgcn_s_getreg((3 << 11) | 20) & 0xFu; }
#define XB_SPIN(cond, bar) do { unsigned _sp = 0; while (cond) { __builtin_amdgcn_s_sleep(1); \
    if ((++_sp & 255u) == 0u) { if (xb_ld(&(bar)[XB_TMO])) break; if (_sp > XB_SPIN_CAP) { atomicAdd(&(bar)[XB_TMO], 1u); break; } } } } while (0)
struct XcdBarrier { unsigned* bar; unsigned x; volatile LAS unsigned* st; };
__device__ __forceinline__ XcdBarrier xcd_barrier_post(unsigned* bar, volatile LAS unsigned* st) {
    XcdBarrier b; b.bar = bar; b.x = xb_xcc_id(); b.st = st;
    if (threadIdx.x == 0) (void)xb_add(&bar[XB_XCNT(b.x)], 1u);
    return b;
}
__device__ __forceinline__ void xcd_barrier_complete(unsigned* bar, unsigned x, unsigned& nloc, unsigned& nx) {
    const unsigned G = gridDim.x * gridDim.y * gridDim.z;
    unsigned sum, cnt, mine, sp = 0u;
    for (;;) {
        sum = 0u; cnt = 0u; mine = 0u;
#pragma unroll 1
        for (unsigned j = 0; j < 16; ++j) { const unsigned c = xb_ld(&bar[XB_XCNT(j)]); sum += c; cnt += (c > 0u) ? 1u : 0u; mine = (j == x) ? c : mine; }
        if (sum == G) break;
        __builtin_amdgcn_s_sleep(1);
        if ((++sp & 255u) == 0u) { if (xb_ld(&bar[XB_TMO])) break; if (sp > XB_SPIN_CAP) { atomicAdd(&bar[XB_TMO], 1u); break; } }
    }
    nloc = mine > 0u ? mine : 1u; nx = cnt > 0u ? cnt : 1u;
}
__device__ __forceinline__ void xcd_barrier_setup(const XcdBarrier& b) {
    if (threadIdx.x == 0) { unsigned nloc, nx; xcd_barrier_complete(b.bar, b.x, nloc, nx); b.st[0] = nloc; b.st[1] = nx; }
}
__device__ __forceinline__ void xcd_barrier_w0(const XcdBarrier& b) {
    if (__builtin_amdgcn_mbcnt_hi(~0u, __builtin_amdgcn_mbcnt_lo(~0u, 0u)) == 0u) {
        unsigned* bar = b.bar; unsigned bx = b.x; asm volatile("" : "+s"(bx));
        __builtin_amdgcn_s_waitcnt(0);
        const unsigned nloc = b.st[0], nx = b.st[1];
        const unsigned old = xb_add(&bar[XB_XSUB(bx)], 1u);
        const unsigned gen = old / nloc;
        if (old + 1u == (gen + 1u) * nloc) {
            __builtin_amdgcn_fence(__ATOMIC_RELEASE, "agent");
            asm volatile("s_waitcnt vmcnt(0)" ::: "memory");
            const unsigned og = xb_add(&bar[XB_TOP], 1u);
            const unsigned tg = og / nx;
            if (og + 1u == (tg + 1u) * nx) xb_add(&bar[XB_TOPGEN], 1u);
            else XB_SPIN(xb_ld(&bar[XB_TOPGEN]) == tg, bar);
            __builtin_amdgcn_fence(__ATOMIC_ACQUIRE, "agent");
            xb_add(&bar[XB_XGEN(bx)], 1u);
            asm volatile("s_waitcnt vmcnt(0)" ::: "memory");
        } else {
            XB_SPIN(xb_ld(&bar[XB_XGEN(bx)]) == gen, bar);
            __builtin_amdgcn_fence(__ATOMIC_ACQUIRE, "agent");
            asm volatile("s_waitcnt vmcnt(0)" ::: "memory");
        }
    }
}
__device__ __forceinline__ void grp_barrier_w0(unsigned* ctl, int grp, unsigned target, int nb, unsigned same_xcd, bool force_release) {
    if (__builtin_amdgcn_mbcnt_hi(~0u, __builtin_amdgcn_mbcnt_lo(~0u, 0u)) == 0u) {
        if (!same_xcd || force_release) __builtin_amdgcn_fence(__ATOMIC_RELEASE, "agent");
        asm volatile("s_waitcnt vmcnt(0)" ::: "memory");
        (void)xb_add(&ctl[CW_GRP + grp * 32], 1u);
        for (unsigned sp = 0; xb_ld(&ctl[CW_GRP + grp * 32]) < target && sp < (1u << 24); ++sp) __builtin_amdgcn_s_sleep(1);
        if (nb >= 0) for (unsigned sp = 0; xb_ld(&ctl[CW_GRP + nb * 32]) < 8u && sp < (1u << 24); ++sp) __builtin_amdgcn_s_sleep(1);
        __builtin_amdgcn_fence(__ATOMIC_ACQUIRE, "agent");
        asm volatile("s_waitcnt vmcnt(0)" ::: "memory");
    }
}
__device__ __forceinline__ void sb_arrive(unsigned* ctl, const XcdBarrier& b) {
    if (__builtin_amdgcn_mbcnt_hi(~0u, __builtin_amdgcn_mbcnt_lo(~0u, 0u)) == 0u) {
        unsigned bx = b.x; asm volatile("" : "+s"(bx));
        const unsigned nloc = b.st[0], nx = b.st[1];
        const unsigned old = xb_add(&ctl[CW_SB + 32 * bx], 1u);
        if (old + 1u == nloc) { __builtin_amdgcn_fence(__ATOMIC_RELEASE, "agent"); asm volatile("s_waitcnt vmcnt(0)" ::: "memory");
            const unsigned og = xb_add(&ctl[CW_SB + 32 * 16], 1u); if (og + 1u == nx) (void)xb_add(&ctl[CW_SB + 32 * 17], 1u); }
    }
}
__device__ __forceinline__ void sb_wait(unsigned* ctl) {
    if (__builtin_amdgcn_mbcnt_hi(~0u, __builtin_amdgcn_mbcnt_lo(~0u, 0u)) == 0u) {
        for (unsigned sp = 0; xb_ld(&ctl[CW_SB + 32 * 17]) == 0u && sp < (1u << 24); ++sp) __builtin_amdgcn_s_sleep(1);
        __builtin_amdgcn_fence(__ATOMIC_ACQUIRE, "agent"); asm volatile("s_waitcnt vmcnt(0)" ::: "memory");
    }
}
__device__ __forceinline__ void xcd_barrier(const XcdBarrier& b, const int wave) {
    asm volatile("s_waitcnt vmcnt(0)" ::: "memory");
    __syncthreads();
    if (wave == 0) xcd_barrier_w0(b);
    __syncthreads();
}

struct Args { const float* in[20]; float* out; unsigned char* ws; int ph_lo, ph_hi, rep, stag, exb, pad; };
struct Frame {
    LAS unsigned char* lds; volatile LAS unsigned* MISC; u32* ctl;
    int tid, lane, wave, vcu, G;
};

__device__ __forceinline__ void p0_item64(const float* W, int N, bf16* WT, int ldo, int mode, LAS unsigned char* scr, int item, int lane, const float* ksc) {
    const int nblk = N >> 6, kb = item / nblk, nb = item - kb * nblk, k0 = kb * 64, n0 = nb * 64;
    if (mode == 1 || mode == 2 || mode == 4 || (mode == 3 && n0 >= 2048)) {
        const float sc8 = (mode == 4) ? pg8::WD_SCALE : (mode == 3 ? pg8::WI_SCALE : pg8::WG_SCALE);
        unsigned char* WT8 = (mode == 3) ? (unsigned char*)WT + (size_t)2048 * 1024 * 2 : (unsigned char*)WT;
        const int r = lane >> 4, c4 = lane & 15;
        const f32x4* src4 = (const f32x4*)(W + (size_t)(k0 + 16 * r) * N + n0) + c4;
        f32x4 v4[16];
#pragma unroll
        for (int i = 0; i < 16; ++i) v4[i] = __builtin_nontemporal_load(src4 + (size_t)i * (N >> 2));
        if (ksc) { const f32x4* kp = (const f32x4*)(ksc + k0 + 16 * r);
#pragma unroll
            for (int q = 0; q < 4; ++q) { const f32x4 k4 = kp[q];
#pragma unroll
                for (int t = 0; t < 4; ++t) v4[4 * q + t] *= k4[t]; } }
#pragma unroll
        for (int j = 0; j < 4; ++j) { u32x4 o;
#pragma unroll
            for (int g = 0; g < 4; ++g) o[g] = pg8::pk4_fp8(v4[4 * g][j], v4[4 * g + 1][j], v4[4 * g + 2][j], v4[4 * g + 3][j], sc8);
            const int nn = n0 + 4 * c4 + j; int r8;
            if (mode == 4) r8 = nn; else if (mode == 3) { const int w2 = nn - 2048, cc = w2 & 1023; r8 = (cc >> 7) * 256 + (w2 >> 10) * 128 + (cc & 127); } else r8 = (nn >> 7) * 256 + (mode == 2 ? 128 : 0) + (nn & 127);
            *(u32x4*)(WT8 + (size_t)r8 * ldo + k0 + 16 * r) = o; }
        return;
    }
    const float* src = W + (size_t)k0 * N + n0 + lane;
    float v[64];
#pragma unroll
    for (int i = 0; i < 64; ++i) v[i] = __builtin_nontemporal_load(src + (size_t)i * N);
    if (ksc) {
#pragma unroll
        for (int i = 0; i < 64; ++i) v[i] *= ksc[k0 + i]; }
    if (mode == 1 || mode == 2 || mode == 4 || (mode == 3 && n0 >= 2048)) {
        const float sc8 = (mode == 4) ? pg8::WD_SCALE : (mode == 3 ? pg8::WI_SCALE : pg8::WG_SCALE);
        unsigned char* WT8 = (mode == 3) ? (unsigned char*)WT + (size_t)2048 * 1024 * 2 : (unsigned char*)WT;
        LAS unsigned char* row8 = scr + lane * 80;
#pragma unroll
        for (int q = 0; q < 4; ++q) { u32x4 o;
#pragma unroll
            for (int g = 0; g < 4; ++g) o[g] = pg8::pk4_fp8(v[16 * q + 4 * g], v[16 * q + 4 * g + 1], v[16 * q + 4 * g + 2], v[16 * q + 4 * g + 3], sc8);
            *(LAS u32x4*)(row8 + q * 16) = o; }
        LDS_WAIT(); asm volatile("" ::: "memory");
        const int ch8 = lane & 3;
#pragma unroll
        for (int j = 0; j < 4; ++j) { const int n = (lane >> 2) + 16 * j; const u32x4 o = *(const LAS u32x4*)(scr + n * 80 + ch8 * 16);
            const int nn = n0 + n; int r8;
            if (mode == 4) r8 = nn; else if (mode == 3) { const int w2 = nn - 2048, cc = w2 & 1023; r8 = (cc >> 7) * 256 + (w2 >> 10) * 128 + (cc & 127); } else r8 = (nn >> 7) * 256 + (mode == 2 ? 128 : 0) + (nn & 127);
            *(u32x4*)(WT8 + (size_t)r8 * ldo + k0 + ch8 * 16) = o; }
        LDS_WAIT(); asm volatile("" ::: "memory");
        return;
    }
    LAS unsigned char* row = scr + lane * 144;
#pragma unroll
    for (int c = 0; c < 8; ++c) { u32x4 o; o.x = pg8::cvt_pk_bf16(v[8 * c], v[8 * c + 1]); o.y = pg8::cvt_pk_bf16(v[8 * c + 2], v[8 * c + 3]); o.z = pg8::cvt_pk_bf16(v[8 * c + 4], v[8 * c + 5]); o.w = pg8::cvt_pk_bf16(v[8 * c + 6], v[8 * c + 7]);
        *(LAS u32x4*)(row + c * 16) = o; }
    LDS_WAIT(); asm volatile("" ::: "memory");
    const int ch = lane & 7;
#pragma unroll
    for (int j = 0; j < 8; ++j) { const int n = (lane >> 3) + 8 * j; const u32x4 o = *(const LAS u32x4*)(scr + n * 144 + ch * 16);
        const int nn = n0 + n; int r;
        if (mode == 0) r = nn;
        else if (mode == 3) {
            if (nn < 1024) r = nn;
            else if (nn < 2048) { const int w2 = nn - 1024, c = w2 & 511; r = 1024 + (c >> 7) * 256 + (w2 >> 9) * 128 + (c & 127); }
            else { const int w2 = nn - 2048, c = w2 & 1023; r = 2048 + (c >> 7) * 256 + (w2 >> 10) * 128 + (c & 127); } }
        else r = (nn >> 7) * 256 + (mode == 2 ? 128 : 0) + (nn & 127);
        *(u32x4*)(WT + (size_t)r * ldo + k0 + ch * 8) = o; }
    LDS_WAIT(); asm volatile("" ::: "memory");
}

struct CopyItem { const float* W; unsigned char* WT8; const float* ksc; int N, ldo, mode, r; float sc8; };
__device__ __forceinline__ void p0x_load(const CopyItem& c, int lane, f32x4 (&v4)[16]) {
    const int nblk = c.N >> 6, kb = c.r / nblk, nb = c.r - kb * nblk, k0 = kb * 64, n0 = nb * 64, r = lane >> 4, c4 = lane & 15;
    const f32x4* src4 = (const f32x4*)(c.W + (size_t)(k0 + 16 * r) * c.N + n0) + c4;
#pragma unroll
    for (int i = 0; i < 16; ++i) v4[i] = __builtin_nontemporal_load(src4 + (size_t)i * (c.N >> 2));
}
__device__ __forceinline__ void p0x_finish(const CopyItem& c, int lane, f32x4 (&v4)[16]) {
    const int nblk = c.N >> 6, kb = c.r / nblk, nb = c.r - kb * nblk, k0 = kb * 64, n0 = nb * 64, r = lane >> 4, c4 = lane & 15;
    if (c.ksc) { const f32x4* kp = (const f32x4*)(c.ksc + k0 + 16 * r);
#pragma unroll
        for (int q = 0; q < 4; ++q) { const f32x4 k4 = kp[q];
#pragma unroll
            for (int t = 0; t < 4; ++t) v4[4 * q + t] *= k4[t]; } }
#pragma unroll
    for (int j = 0; j < 4; ++j) { u32x4 o;
#pragma unroll
        for (int g = 0; g < 4; ++g) o[g] = pg8::pk4_fp8(v4[4 * g][j], v4[4 * g + 1][j], v4[4 * g + 2][j], v4[4 * g + 3][j], c.sc8);
        const int nn = n0 + 4 * c4 + j; const int r8 = (c.mode == 4) ? nn : ((nn >> 7) * 256 + (c.mode == 2 ? 128 : 0) + (nn & 127));
        *(u32x4*)(c.WT8 + (size_t)r8 * c.ldo + k0 + 16 * r) = o; }
}

template <int W> __device__ __forceinline__ void p2_pool_run(const bf16* up, bf16* ab, const int s0) {
#define UNPK_(v, e) do { e[0] = bflo(v.x); e[1] = bfhi(v.x); e[2] = bflo(v.y); e[3] = bfhi(v.y); e[4] = bflo(v.z); e[5] = bfhi(v.z); e[6] = bflo(v.w); e[7] = bfhi(v.w); } while (0)
    u32x4 pre[W - 1], vcs[16]; float S[8];
#pragma unroll
    for (int j = 1; j < W; ++j) { pre[j - 1] = (u32x4){0u, 0u, 0u, 0u}; if (s0 - j >= 0) pre[j - 1] = *(const u32x4*)(up - (long)j * 2048); }
#pragma unroll
    for (int i2 = 0; i2 < 16; ++i2) vcs[i2] = *(const u32x4*)(up + (size_t)i2 * 2048);
#pragma unroll
    for (int i = 0; i < 8; ++i) S[i] = 0.f;
#pragma unroll
    for (int j = 1; j < W; ++j) { float e[8]; UNPK_(pre[j - 1], e);
#pragma unroll
        for (int i = 0; i < 8; ++i) S[i] += e[i]; }
#pragma unroll
    for (int i2 = 0; i2 < 16; ++i2) { const int sq = s0 + i2;
        const u32x4 vo = (i2 - W + 1 < 0) ? pre[(W - 2 - i2) < 0 ? 0 : (W - 2 - i2)] : vcs[(i2 - W + 1) < 0 ? 0 : (i2 - W + 1)];
        float cur[8], old[8], o[8]; UNPK_(vcs[i2], cur); UNPK_(vo, old);
        const int cnt = (sq + 1) < W ? (sq + 1) : W; const float rc = 1.0f / (float)cnt;
#pragma unroll
        for (int i = 0; i < 8; ++i) { S[i] += cur[i]; o[i] = S[i] * rc - cur[i]; S[i] -= old[i]; }
        u32x4 wv; wv.x = pk2(o[0], o[1]); wv.y = pk2(o[2], o[3]); wv.z = pk2(o[4], o[5]); wv.w = pk2(o[6], o[7]);
        *(u32x4*)(ab + (size_t)i2 * 2048) = wv; }
#undef UNPK_
}
__global__ void __launch_bounds__(NTHR, 2) mega_fwd(Args args) {
    extern __shared__ __attribute__((aligned(16))) unsigned char lds_raw[];
    LAS unsigned char* const lds = (LAS unsigned char*)lds_raw;
    const int wv0_ = __builtin_amdgcn_readfirstlane((int)(threadIdx.x >> 6));
#define CTL ((u32*)(KWS + WS_CTL))
#define CTL0 ((u32*)(args.ws + WS_CTL))
#define GRP_PM ((int)(blockIdx.x % 8) * 8 + (int)(blockIdx.x / 8) % 8)
#define GRP_Q ((int)(blockIdx.x / 8) / 8)
#define CAS __attribute__((address_space(4)))
#define KIN(k) (*(const float* const CAS*)(ka_ + 8 * (k)))
#define KOUT (*(float* const CAS*)(ka_ + 160))
#define KWS (*(unsigned char* const CAS*)(ka_ + 168))
#define PHV() const CAS char* ka_ = (const CAS char*)__builtin_amdgcn_kernarg_segment_ptr(); asm volatile("" : "+s"(ka_)); int wave_ = wv0_; asm volatile("" : "+s"(wave_)); int lane_ = (int)__builtin_amdgcn_mbcnt_hi(~0u, __builtin_amdgcn_mbcnt_lo(~0u, 0u)); asm volatile("" : "+v"(lane_)); const int tid_ = wave_ * 64 + lane_; \
    const int G_ = gridDim.x; const int vcu_ = (G_ % 8 == 0) ? ((int)blockIdx.x % 8) * (G_ / 8) + (int)blockIdx.x / 8 : (int)blockIdx.x; \
    const int gw = vcu_ * NWAVES + wave_, NGW = G_ * NWAVES, gt = vcu_ * NTHR + tid_, NGT = G_ * NTHR; (void)lane_; (void)gw; (void)NGW; (void)gt; (void)NGT;
#define p_x KIN(0)
#define p_g_mix KIN(1)
#define p_w_in KIN(2)
#define p_b_gate KIN(3)
#define p_w_pool_group KIN(4)
#define p_pool_scale KIN(5)
#define p_w_pool_out KIN(6)
#define p_conv_w KIN(7)
#define p_w_conv_out KIN(8)
#define p_w_o KIN(9)
#define p_g_ffn KIN(10)
#define p_w_router KIN(11)
#define p_router_bias KIN(12)
#define p_e_gate KIN(13)
#define p_e_up KIN(14)
#define p_e_down KIN(15)
#define p_s_gate KIN(16)
#define p_s_up KIN(17)
#define p_s_down KIN(18)
#define p_g_final KIN(19)
#define p_out KOUT
#define p_tope ((int*)(KWS + WS_TOPE))
#define p_topw ((float*)(KWS + WS_TOPW))
#define p_inv ((int*)(KWS + WS_INV))
#define p_rowtok ((int*)(KWS + WS_ROWTOK))
#define p_roww ((float*)(KWS + WS_ROWW))
#define p_rt ((float*)(KWS + WS_RT))
#define p_rt0 ((float*)(KWS + WS_RT + (size_t)T * 4))
#define p_rte ((int*)(KWS + 22 * MiB))
#define p_rwe ((float*)(KWS + 22 * MiB + (size_t)64 * ECAP * 4))
#define p_xm ((bf16*)KOUT)
#define p_off ((int*)(KWS + WS_OFF))
#define p_tilee ((int*)(KWS + WS_TILEE))
#define p_edt8 ((unsigned char*)(KWS + WS_EDT))
#define p_wtin ((bf16*)(KWS + WS_WTIN))
#define p_wtab ((bf16*)(KWS + WS_WTAB))
#define p_wto ((bf16*)(KWS + WS_WTO))
#define p_egut8 ((unsigned char*)(KWS + WS_EGUT))
#define p_h8 ((unsigned char*)(KWS + WS_H8))
#define p_x8 ((unsigned char*)(KWS + WS_X8))
#define p_H ((bf16*)(KWS + WS_H))
#define p_AB ((bf16*)KOUT)
#define p_H2 p_H
#define p_ubcv ((bf16*)(KWS + WS_UBCV))
#define p_merged ((bf16*)KOUT + 1024)
#define p_gates ((bf16*)(KWS + WS_GATES))
#define p_hid ((unsigned char*)(KWS + WS_HID))
#define p_y ((unsigned char*)(KWS + WS_Y))

    constexpr int I_IN = 16 * 64, I_CO = 8 * 16, I_O = 16 * 16, I_EG = 64 * 64, I_SG = 64, I_ED = 64 * 64, I_SD = 64;
    constexpr int N_ITEMS_EARLY = I_IN + I_CO + I_O, NITEMS = N_ITEMS_EARLY + 2 * I_EG + 2 * I_SG + I_ED + I_SD;
#define CONV_ONE(it_, scr_) do { \
            int r = (it_); const float* W; bf16* WT; int N, ldo, mode = 0; const float* ksc = nullptr; \
            if (r < I_IN) { W = p_w_in; N = NIN; WT = p_wtin; ldo = D; mode = 3; if ((r & 63) < 32) ksc = p_g_mix; } \
            else if ((r -= I_IN) < I_CO) { W = p_w_conv_out; N = D; WT = p_wtab + 512; ldo = 1024; } \
            else if ((r -= I_CO) < I_O) { W = p_w_o; N = D; WT = p_wto; ldo = D; } \
            else if ((r -= I_O) < I_EG) { const int e = r >> 6; r &= 63; W = p_e_gate + (size_t)e * D * EH; N = EH; WT = (bf16*)(p_egut8 + (size_t)e * 512 * D); ldo = D; mode = 1; ksc = p_g_ffn; } \
            else if ((r -= I_EG) < I_EG) { const int e = r >> 6; r &= 63; W = p_e_up + (size_t)e * D * EH; N = EH; WT = (bf16*)(p_egut8 + (size_t)e * 512 * D); ldo = D; mode = 2; ksc = p_g_ffn; } \
            else if ((r -= I_EG) < I_SG) { W = p_s_gate; N = EH; WT = (bf16*)(p_egut8 + (size_t)64 * 512 * D); ldo = D; mode = 1; ksc = p_g_ffn; } \
            else if ((r -= I_SG) < I_SG) { W = p_s_up; N = EH; WT = (bf16*)(p_egut8 + (size_t)64 * 512 * D); ldo = D; mode = 2; ksc = p_g_ffn; } \
            else if ((r -= I_SG) < I_ED) { const int e = r >> 6; r &= 63; W = p_e_down + (size_t)e * EH * D; N = D; WT = (bf16*)(p_edt8 + (size_t)e * D * EH); ldo = EH; mode = 4; } \
            else { r -= I_ED; W = p_s_down; N = D; WT = (bf16*)(p_edt8 + (size_t)64 * D * EH); ldo = EH; mode = 4; } \
            p0_item64(W, N, WT, ldo, mode, (scr_), r, lane_, ksc); } while (0)
#define CONV_DEC_X(it_, c_) do { int r = (it_) - N_ITEMS_EARLY; (c_).ksc = p_g_ffn; (c_).sc8 = pg8::WG_SCALE; (c_).ldo = D; (c_).N = EH; \
            if (r < I_EG) { const int e = r >> 6; r &= 63; (c_).W = p_e_gate + (size_t)e * D * EH; (c_).WT8 = p_egut8 + (size_t)e * 512 * D; (c_).mode = 1; } \
            else if ((r -= I_EG) < I_EG) { const int e = r >> 6; r &= 63; (c_).W = p_e_up + (size_t)e * D * EH; (c_).WT8 = p_egut8 + (size_t)e * 512 * D; (c_).mode = 2; } \
            else if ((r -= I_EG) < I_SG) { (c_).W = p_s_gate; (c_).WT8 = p_egut8 + (size_t)64 * 512 * D; (c_).mode = 1; } \
            else if ((r -= I_SG) < I_SG) { (c_).W = p_s_up; (c_).WT8 = p_egut8 + (size_t)64 * 512 * D; (c_).mode = 2; } \
            else { (c_).ksc = nullptr; (c_).sc8 = pg8::WD_SCALE; (c_).ldo = EH; (c_).N = D; (c_).mode = 4; \
                if ((r -= I_SG) < I_ED) { const int e = r >> 6; r &= 63; (c_).W = p_e_down + (size_t)e * EH * D; (c_).WT8 = p_edt8 + (size_t)e * D * EH; } \
                else { r -= I_ED; (c_).W = p_s_down; (c_).WT8 = p_edt8 + (size_t)64 * D * EH; } } \
            (c_).r = r; } while (0)
#define CONV_TWO(ita_, itb_) do { const int ia_ = (ita_), ib_ = (itb_); if (ia_ < NITEMS) { CopyItem ca_; CONV_DEC_X(ia_, ca_); f32x4 va_[16]; p0x_load(ca_, lane_, va_); \
            if (ib_ < NITEMS) { CopyItem cb_; CONV_DEC_X(ib_, cb_); f32x4 vb_[16]; p0x_load(cb_, lane_, vb_); p0x_finish(ca_, lane_, va_); p0x_finish(cb_, lane_, vb_); } \
            else p0x_finish(ca_, lane_, va_); } } while (0)
#define CONV_RANGE(lo_, hi_, scr_) do { for (int it = (lo_) + gw; it < (hi_); it += NGW) CONV_ONE(it, (scr_)); } while (0)
    constexpr int FILL_PER_BAR = 256 * 7, FILL_TOTAL = 7 * FILL_PER_BAR;
    for (int u = threadIdx.x; u < (LDS_BYTES - LDSCTL_OFF) / 4; u += NTHR) ((LAS unsigned*)(lds + LDSCTL_OFF))[u] = 0u;
    __syncthreads();
    XcdBarrier bar; bar.bar = (unsigned*)(CTL0 + CW_BAR); bar.x = 0; bar.st = nullptr;
    if (!MK_PER_PHASE) { bar = xcd_barrier_post((unsigned*)(CTL0 + CW_BAR), (volatile LAS unsigned*)(lds + MISC_OFF) + 8);
        if (threadIdx.x == 0 && gridDim.x == 256) __hip_atomic_store(&CTL0[CW_GRP + GRP_PM * 32 + 8 + GRP_Q], bar.x + 1u, __ATOMIC_RELAXED, __HIP_MEMORY_SCOPE_AGENT);
        }
    const int lo = args.ph_lo, hi = args.ph_hi; (void)lo; (void)hi;
#if MK_PER_PHASE
#define IN(k) (lo <= (k) && (k) < hi)
#else
#define IN(k) true
#endif
#define SEAM(k) do { if (IN(k) && IN((k) + 1)) xcd_barrier(bar, wv0_); } while (0)
#define SEAM_G(bi_, inst_, halo_) do { asm volatile("s_waitcnt vmcnt(0)" ::: "memory"); __syncthreads(); \
        if (wv0_ == 0) { if (gridDim.x == 256) grp_barrier_w0(CTL0, GRP_PM, 4u * (inst_), ((halo_) && (GRP_PM % 8) != 0) ? GRP_PM - 1 : -1, ((volatile LAS unsigned*)(lds + MISC_OFF))[12], false); else xcd_barrier_w0(bar); } \
        else { PHV(); if (G_ == 256 && (bi_) >= 0) { const int s_ = N_ITEMS_EARLY + (bi_) * FILL_PER_BAR + vcu_ * 7 + (wave_ - 1); CONV_TWO(s_, NITEMS); } } \
        __syncthreads(); } while (0)
#define SEAM_F(k, bi_) do { asm volatile("s_waitcnt vmcnt(0)" ::: "memory"); __syncthreads(); \
        if (wv0_ == 0) xcd_barrier_w0(bar); \
        else { PHV(); if (G_ == 256) { const int it_ = N_ITEMS_EARLY + (bi_) * FILL_PER_BAR + vcu_ * 7 + (wave_ - 1); CONV_ONE(it_, lds + wave_ * 9216); } } \
        __syncthreads(); } while (0)
#if REP_PHASE >= 0
#define REPS(k) for (int rep_ = 0; rep_ < ((k) == REP_PHASE ? 2 : 1); ++rep_)
#define REPBAR() do { if (rep_) xcd_barrier(bar, wv0_); } while (0)
#else
    constexpr int rep_ = 0;
#define REPS(k)
#define REPBAR() do { } while (0)
#endif

    REPS(0) if (IN(0)) { REPBAR(); PHV();
        LAS unsigned char* scr = lds + wave_ * 9216;
        for (int item = gw, cit = gw; item < 32 * 64 || cit < N_ITEMS_EARLY; item += NGW, cit += NGW) { const bool hf_ = item < 32 * 64; const int itm = hf_ ? item : 0;
            const int k0 = (itm >> 6) * 16, d0 = (itm & 63) * 16, gi = k0 >> 7, r_ = lane_ & 15, q_ = lane_ >> 4;
            const f32x4* ap = (const f32x4*)(p_w_pool_group + (size_t)(k0 + r_) * 128 + 32 * q_); const f32x4* scp = (const f32x4*)(p_pool_scale + gi * 128 + 32 * q_);
            const float* wp = p_w_pool_out + (size_t)(gi * 128 + 32 * q_) * D + d0 + r_;
            f32x4 av[8]; float wv[32];
#pragma unroll
            for (int i = 0; i < 8; ++i) av[i] = ap[i] * scp[i];
#pragma unroll
            for (int s2 = 0; s2 < 32; ++s2) wv[s2] = wp[(size_t)s2 * D];
            if (cit < N_ITEMS_EARLY) CONV_ONE(cit, scr);
            f32x4 acc4 = (f32x4){0.f, 0.f, 0.f, 0.f};
#pragma unroll
            for (int s2 = 0; s2 < 32; ++s2) acc4 = __builtin_amdgcn_mfma_f32_16x16x4f32(av[s2 >> 2][s2 & 3], wv[s2], acc4, 0, 0, 0);
            u32x2 o; o.x = pk2(acc4[0], acc4[1]); o.y = pk2(acc4[2], acc4[3]);
            if (hf_) *(u32x2*)(p_wtab + (size_t)(d0 + r_) * 1024 + k0 + 4 * q_) = o; }
        if (wave_ == 0) xcd_barrier_setup(bar);
        if (G_ == 256) { asm volatile("s_waitcnt vmcnt(0)" ::: "memory"); __syncthreads(); if (wave_ == 0) sb_arrive(CTL0, bar); }
        const int rbase_ = (GRP_PM * 4 + GRP_Q) * 64 + wave_;
        f32x4 gq0_[4];
#pragma unroll
        for (int j = 0; j < 4; ++j) gq0_[j] = ((const f32x4*)p_g_mix)[lane_ + 64 * j];
        LAS unsigned char* nsl_ = lds + wave_ * 9216;
        for (int rr_ = 0; rr_ < (REP_PHASE == 102 ? 2 : 1); ++rr_)
        for (int m = (G_ == 256 ? 0 : gw); m < (G_ == 256 ? 8 : T); m += (G_ == 256 ? 4 : 4 * NGW)) {
            f32x4 v[4][4];
#pragma unroll
            for (int u = 0; u < 4; ++u) { const int mu = (G_ == 256) ? rbase_ + 8 * (m + u) : ((m + u * NGW < T) ? m + u * NGW : m); const f32x4* xr = (const f32x4*)(p_x + (size_t)mu * D) + lane_;
#pragma unroll
                for (int j = 0; j < 4; ++j) v[u][j] = __builtin_nontemporal_load(xr + 64 * j); }
#pragma unroll
            for (int u = 0; u < 4; ++u) { const int mu = (G_ == 256) ? rbase_ + 8 * (m + u) : ((m + u * NGW < T) ? m + u * NGW : m); float s = 0.f;
#pragma unroll
                for (int j = 0; j < 4; ++j) s += (v[u][j].x * v[u][j].x + v[u][j].y * v[u][j].y) + (v[u][j].z * v[u][j].z + v[u][j].w * v[u][j].w);
                const float r = rsqrtf(wave_sum(s) * (1.0f / D) + EPS);
                if (lane_ == 0) p_rt0[mu] = r;
#pragma unroll
                for (int j = 0; j < 4; ++j) { const f32x4 gg = gq0_[j]; const float h0 = v[u][j].x * r * gg.x, h1 = v[u][j].y * r * gg.y, h2 = v[u][j].z * r * gg.z, h3 = v[u][j].w * r * gg.w;
                    u32x2 w; w.x = pk2(v[u][j].x, v[u][j].y); w.y = pk2(v[u][j].z, v[u][j].w); *(LAS u32x2*)(nsl_ + (lane_ + 64 * j) * 8) = w;
                    *(LAS u32*)(nsl_ + 2048 + (lane_ + 64 * j) * 4) = pg8::pk4_fp8(h0, h1, h2, h3, pg8::H8_SCALE); }
                asm volatile("" ::: "memory");
                { const u32x4 b0 = *(const LAS u32x4*)(nsl_ + lane_ * 16), b1 = *(const LAS u32x4*)(nsl_ + 1024 + lane_ * 16), b2 = *(const LAS u32x4*)(nsl_ + 2048 + lane_ * 16);
                  u32x4* o = (u32x4*)(p_H + (size_t)mu * D) + lane_; o[0] = b0; o[64] = b1; ((u32x4*)(p_h8 + (size_t)mu * D))[lane_] = b2; }
                asm volatile("" ::: "memory"); }
        }
    }
    do { asm volatile("s_waitcnt vmcnt(0)" ::: "memory"); __syncthreads();
        if (wv0_ == 0) { if (gridDim.x == 256) { sb_wait(CTL0);
                {
                    const int l_ = (int)__builtin_amdgcn_mbcnt_hi(~0u, __builtin_amdgcn_mbcnt_lo(~0u, 0u)); const int g0 = GRP_PM & ~7;
                    const unsigned id_ = xb_ld(&CTL0[CW_GRP + (g0 + ((l_ & 31) >> 2)) * 32 + 8 + (l_ & 3)]);
                    const unsigned same = (__ballot(id_ == bar.x + 1u) == ~0ull) ? 1u : 0u;
                    if (l_ == 0) ((volatile LAS unsigned*)(lds + MISC_OFF))[12] = same; }
                grp_barrier_w0(CTL0, GRP_PM, 4u, -1, ((volatile LAS unsigned*)(lds + MISC_OFF))[12], false); }
            else xcd_barrier_w0(bar); }
        else { PHV(); if (G_ == 256) { const int s_ = N_ITEMS_EARLY + vcu_ * 7 + (wave_ - 1); CONV_TWO(s_, NITEMS); } }
        __syncthreads(); } while (0);
    REPS(1) if (IN(1)) { REPBAR(); PHV();
        {
            pg8::RegOrder S; S.init(p_H, p_wtin, D, D, T, 2048, G_, (int)blockIdx.x, 1, 0);
            pg8::EpiS1 E{p_ubcv, p_rt0};
            f32x4 acc_[2][2][4][2]; pg8::gemm_phase<pg8::EpiS1, pg8::RegOrder, true, true>(lds, S, E, D / 64, wave_, acc_); }
        {
            pg8::RegOrder S; S.init(p_h8, (unsigned char*)p_wtin + (size_t)2048 * 1024 * 2, D / 2, D / 2, T, 2048, G_, (int)blockIdx.x, 1, 0);
            pg8::EpiS1G E{p_gates, p_b_gate, 1.0f / (pg8::H8_SCALE * pg8::WI_SCALE)};
            f32x4 acc_[2][2][4][2]; pg8::gemm_phase<pg8::EpiS1G, pg8::RegOrder, true, true, true>(lds, S, E, D / 128, wave_, acc_); }
    }
    SEAM_G(1, 2, true);
    REPS(2) if (IN(2)) { REPBAR(); PHV();
        for (int base = (G_ == 256 ? GRP_PM * 4 + GRP_Q : vcu_) * 64; base < T; base += G_ * 64) {
            const bool poolw_ = (wave_ & 1) == 0; const int wgrp_ = __builtin_amdgcn_readfirstlane(wave_ >> 1);
            const int c8 = poolw_ ? wgrp_ * 128 + (lane_ & 15) * 8 : 512 + lane_ * 8, tb = base + (poolw_ ? (lane_ >> 4) : (wave_ >> 1)) * 16, s0 = tb & (SEQ - 1);
#define UNPK(v, e) do { e[0] = bflo(v.x); e[1] = bfhi(v.x); e[2] = bflo(v.y); e[3] = bfhi(v.y); e[4] = bflo(v.z); e[5] = bfhi(v.z); e[6] = bflo(v.w); e[7] = bfhi(v.w); } while (0)
            if (poolw_) {
                const bf16* up = p_ubcv + (size_t)tb * 2048 + c8; bf16* ab = p_AB + (size_t)tb * 2048 + c8;
                if (wgrp_ == 0) p2_pool_run<2>(up, ab, s0); else if (wgrp_ == 1) p2_pool_run<4>(up, ab, s0); else if (wgrp_ == 2) p2_pool_run<8>(up, ab, s0); else p2_pool_run<16>(up, ab, s0);
            } else {
                const int c = c8 - 512; const bf16* bp = p_ubcv + (size_t)tb * 2048 + 512 + c;
                float w0[8], w1[8], w2[8], p1[8], p2[8];
                { const f32x4 a0 = *(const f32x4*)(p_conv_w + c), a1 = *(const f32x4*)(p_conv_w + c + 4), b0 = *(const f32x4*)(p_conv_w + 512 + c), b1 = *(const f32x4*)(p_conv_w + 512 + c + 4), c0 = *(const f32x4*)(p_conv_w + 1024 + c), c1 = *(const f32x4*)(p_conv_w + 1024 + c + 4);
                  w0[0] = a0.x; w0[1] = a0.y; w0[2] = a0.z; w0[3] = a0.w; w0[4] = a1.x; w0[5] = a1.y; w0[6] = a1.z; w0[7] = a1.w;
                  w1[0] = b0.x; w1[1] = b0.y; w1[2] = b0.z; w1[3] = b0.w; w1[4] = b1.x; w1[5] = b1.y; w1[6] = b1.z; w1[7] = b1.w;
                  w2[0] = c0.x; w2[1] = c0.y; w2[2] = c0.z; w2[3] = c0.w; w2[4] = c1.x; w2[5] = c1.y; w2[6] = c1.z; w2[7] = c1.w; }
#pragma unroll
                for (int j = 1; j <= 2; ++j) { u32x4 a = (u32x4){0u, 0u, 0u, 0u}; if (s0 - j >= 0) a = *(const u32x4*)(bp + 512 - (long)j * 2048);
                    float ea[8]; UNPK(a, ea);
#pragma unroll
                    for (int i = 0; i < 8; ++i) { if (j == 1) p1[i] = ea[i]; else p2[i] = ea[i]; } }
#pragma unroll
                for (int i2 = 0; i2 < 16; ++i2) {
                    const u32x4 g = *(const u32x4*)(bp + (size_t)i2 * 2048), a = *(const u32x4*)(bp + 512 + (size_t)i2 * 2048);
                    float eg[8], ea[8], o[8]; UNPK(g, eg); UNPK(a, ea);
#pragma unroll
                    for (int i = 0; i < 8; ++i) { const float p0 = ea[i]; o[i] = eg[i] * (w0[i] * p2[i] + w1[i] * p1[i] + w2[i] * p0); p2[i] = p1[i]; p1[i] = p0; }
                    u32x4 wv; wv.x = pk2(o[0], o[1]); wv.y = pk2(o[2], o[3]); wv.z = pk2(o[4], o[5]); wv.w = pk2(o[6], o[7]);
                    *(u32x4*)(p_AB + (size_t)(tb + i2) * 2048 + c8) = wv; }
            }
#undef UNPK
        }
    }
    SEAM_G(2, 3, false);
    f32x4 accx[2][2][4][2];
    u32x4 wh[4][4], wl[4][4];
#define ROUTER_W_LOAD() do { const int q_ = lane_ >> 4, r_ = lane_ & 15;\
_Pragma("unroll")\
        for (int s2 = 0; s2 < 4; ++s2)\
_Pragma("unroll")\
            for (int j = 0; j < 8; ++j) { const int k = wave_ * 128 + 32 * s2 + 8 * q_ + j; const float gk = p_g_ffn[k];\
_Pragma("unroll")\
                for (int nt2 = 0; nt2 < 4; ++nt2) { const float wv = gk * p_w_router[(size_t)k * NE + 16 * nt2 + r_]; const u32 hb = f2bf(wv); const u32 lb = f2bf(wv - __uint_as_float(hb << 16));\
                    if (j & 1) { wh[nt2][s2][j >> 1] |= hb << 16; wl[nt2][s2][j >> 1] |= lb << 16; } else { wh[nt2][s2][j >> 1] = hb; wl[nt2][s2][j >> 1] = lb; } } } } while (0)
    REPS(3) if (IN(3)) { REPBAR(); PHV();
        pg8::RegOrder S; S.init(p_AB, p_wtab, 2048, 1024, T, D, G_, (int)blockIdx.x, 1, 0);
        pg8::EpiS2B E{p_gates, p_merged};
        { f32x4 acc_[2][2][4][2]; pg8::gemm_phase<pg8::EpiS2B, pg8::RegOrder, true, true>(lds, S, E, 1024 / 64, wave_, acc_); }
#if REP_PHASE < 0 && !MK_PER_PHASE
        { pg8::RegOrder S4; S4.init(p_merged, p_wto, 2048, D, T, D, G_, (int)blockIdx.x, 1, 0); pg8::Unit u4; S4.next(0, u4); pg8::EpiS3 E4{p_H, p_xm};
          E4.init(accx, u4, wave_ >> 2, wave_ & 3, lane_ & 15, lane_ >> 4); }
#endif
    }
    SEAM_G(3, 4, false);
    REPS(4) if (IN(4)) { REPBAR(); PHV();
        pg8::RegOrder S; S.init(p_merged, p_wto, 2048, D, T, D, G_, (int)blockIdx.x, 1, 0);
        pg8::EpiS3 E{p_H, p_xm};
#if !(REP_PHASE < 0 && !MK_PER_PHASE)
        { pg8::Unit u4; S.next(0, u4); E.init(accx, u4, wave_ >> 2, wave_ & 3, lane_ & 15, lane_ >> 4); }
#endif
        pg8::gemm_phase<pg8::EpiS3, pg8::RegOrder, true, true>(lds, S, E, D / 64, wave_, accx);
#if REP_PHASE < 0 && !MK_PER_PHASE
        if (!(((int)blockIdx.x >> 3) & 1)) ROUTER_W_LOAD();
#endif
    }
    SEAM_G(4, 5, false);
    REPS(5) if (IN(5)) { REPBAR(); PHV();
        constexpr int TB = 64;
        LAS float* part = (LAS float*)lds;
        LAS float* ssqp = (LAS float*)(lds + LDSCTL_OFF + 4096);
        LAS float* rt = (LAS float*)(lds + LDSCTL_OFF + 13312);
        LAS int* hist = (LAS int*)(lds + LDSCTL_OFF + 13312 + 256);
        LAS int* bs = hist + 64;
        const int q_ = lane_ >> 4, r_ = lane_ & 15;
        if (tid_ < 64) hist[tid_] = 0;
        const int par_ = ((int)blockIdx.x >> 3) & 1;
        const int conv_lo_ = N_ITEMS_EARLY + (G_ == 256 ? FILL_TOTAL : 0);
        if (par_) { CONV_RANGE(conv_lo_, NITEMS, lds + wave_ * 9216); __syncthreads(); ROUTER_W_LOAD(); }
#if !(REP_PHASE < 0 && !MK_PER_PHASE)
        else ROUTER_W_LOAD();
#endif
        const float rbias_ = p_router_bias[lane_];
        for (int it = (G_ == 256 ? GRP_PM * 4 + GRP_Q : vcu_); it < T / TB; it += G_) {
            const int t0 = it * TB;
#pragma unroll
            for (int rb = 0; rb < 4; ++rb) {
                u32x4 xa_[4];
#pragma unroll
                for (int j = 0; j < 4; ++j) xa_[j] = *(const u32x4*)(p_xm + (size_t)(t0 + 16 * rb + r_) * pg8::XM_PITCH + wave_ * 128 + 32 * j + 8 * q_);
#pragma unroll
                for (int j = 0; j < 4; ++j) { u32x2 w8;
                    w8.x = pg8::pk4_fp8(bflo(xa_[j].x), bfhi(xa_[j].x), bflo(xa_[j].y), bfhi(xa_[j].y), pg8::X8_SCALE); w8.y = pg8::pk4_fp8(bflo(xa_[j].z), bfhi(xa_[j].z), bflo(xa_[j].w), bfhi(xa_[j].w), pg8::X8_SCALE);
                    if (rep_ == 0) *(u32x2*)(p_x8 + (size_t)(t0 + 16 * rb + r_) * D + wave_ * 128 + 32 * j + 8 * q_) = w8; }
                f32x4 acc[4]; float ss = 0.f;
#pragma unroll
                for (int nt2 = 0; nt2 < 4; ++nt2) acc[nt2] = (f32x4){0.f, 0.f, 0.f, 0.f};
#pragma unroll
                for (int s2 = 0; s2 < 4; ++s2) {
#pragma unroll
                    for (int j2 = 0; j2 < 4; ++j2) { const float x0 = bflo(xa_[s2][j2]), x1 = bfhi(xa_[s2][j2]); ss += x0 * x0 + x1 * x1; }
                    const bf16x8 ah = __builtin_bit_cast(bf16x8, xa_[s2]);
#pragma unroll
                    for (int nt2 = 0; nt2 < 4; ++nt2) { const bf16x8 bh = __builtin_bit_cast(bf16x8, wh[nt2][s2]), bl = __builtin_bit_cast(bf16x8, wl[nt2][s2]);
                        acc[nt2] = __builtin_amdgcn_mfma_f32_16x16x32_bf16(ah, bl, acc[nt2], 0, 0, 0);
                        acc[nt2] = __builtin_amdgcn_mfma_f32_16x16x32_bf16(ah, bh, acc[nt2], 0, 0, 0); } }
#pragma unroll
                for (int nt2 = 0; nt2 < 4; ++nt2)
#pragma unroll
                    for (int g = 0; g < 4; ++g) part[(wave_ * TB + 16 * rb + 4 * q_ + g) * 64 + 16 * nt2 + r_] = acc[nt2][g];
                ssqp[(wave_ * 4 + q_) * TB + 16 * rb + r_] = ss;
            }
            __syncthreads();
            if (tid_ < TB) { float s2 = 0.f;
#pragma unroll
                for (int i = 0; i < 32; ++i) s2 += ssqp[i * TB + tid_];
                const float rv = rsqrtf(s2 * (1.0f / D) + EPS); rt[tid_] = rv; p_rt[t0 + tid_] = rv; }
            __syncthreads();
            int lrk[8], slk[8]; float wk[8];
            unsigned key8[8], thr8[8]; float sv8[8];
#pragma unroll
            for (int tt = 0; tt < 8; ++tt) { const int t = wave_ + 8 * tt; float lg = 0.f;
#pragma unroll
                for (int k2 = 0; k2 < 8; ++k2) lg += part[(k2 * TB + t) * 64 + lane_];
                sv8[tt] = sigmoid_acc(lg * rt[t]); const float v = sv8[tt] + rbias_;
                const unsigned vb = __float_as_uint(v); key8[tt] = (vb & 0x80000000u) ? ~vb : (vb | 0x80000000u); thr8[tt] = 0u; }
#pragma unroll 2
            for (int bit = 31; bit >= 0; --bit) {
#pragma unroll
                for (int tt = 0; tt < 8; ++tt) { const unsigned cand = thr8[tt] | (1u << bit); if (__popcll(__ballot(key8[tt] >= cand)) >= TOPK) thr8[tt] = cand; } }
#pragma unroll
            for (int tt = 0; tt < 8; ++tt) { const unsigned key = key8[tt], thr = thr8[tt]; const float sv = sv8[tt];
                const unsigned long long gtm = __ballot(key > thr), eqm = __ballot(key == thr);
                const int need = TOPK - (int)__popcll(gtm);
                const int eqbelow = (int)__builtin_amdgcn_mbcnt_hi((unsigned)(eqm >> 32), __builtin_amdgcn_mbcnt_lo((unsigned)eqm, 0u));
                const bool pick = (key > thr) || (key == thr && eqbelow < need);
                const unsigned long long pm = __ballot(pick);
                const int slot = (int)__builtin_amdgcn_mbcnt_hi((unsigned)(pm >> 32), __builtin_amdgcn_mbcnt_lo((unsigned)pm, 0u));
                const float wsum = wave_sum(pick ? sv : 0.f);
                slk[tt] = pick ? slot : -1; wk[tt] = sv / wsum * ROUTED_SCALE; lrk[tt] = 0;
                if (pick) lrk[tt] = __hip_atomic_fetch_add(&hist[lane_], 1, __ATOMIC_RELAXED, __HIP_MEMORY_SCOPE_WORKGROUP);
            }
            __syncthreads();
            if (tid_ < 64) { const int hv = hist[tid_]; bs[tid_] = (hv && rep_ == 0) ? (int)atomicAdd(&CTL[CW_CNT + tid_], (u32)hv) : 0; hist[tid_] = 0; }
            __syncthreads();
#pragma unroll
            for (int tt = 0; tt < 8; ++tt) if (slk[tt] >= 0) { const int t = wave_ + 8 * tt, tok = t0 + t, pe = bs[lane_] + lrk[tt]; const float rv = rt[t];
                p_rte[lane_ * ECAP + pe] = (tok << 4) | slk[tt]; typedef float f32x2_ __attribute__((ext_vector_type(2))); *(f32x2_*)(p_rwe + 2 * ((size_t)lane_ * ECAP + pe)) = (f32x2_){rv, rv * wk[tt]};
                }
            __syncthreads();
        }
        if (!par_) CONV_RANGE(conv_lo_, NITEMS, lds + wave_ * 9216);
    }
    do { asm volatile("s_waitcnt vmcnt(0)" ::: "memory"); __syncthreads();
        if (wv0_ == 0) xcd_barrier_w0(bar);
        else { PHV(); if (G_ == 256) { const int s_ = N_ITEMS_EARLY + 5 * FILL_PER_BAR + vcu_ * 7 + (wave_ - 1); CONV_TWO(s_, s_ + FILL_PER_BAR); } }
        __syncthreads(); } while (0);
    REPS(7) if (IN(7)) { REPBAR(); PHV();
        LAS int* tl_ = (LAS int*)(lds + LDSCTL_OFF + 1024);
        LAS unsigned* ro_ = (LAS unsigned*)(lds + LDSCTL_OFF + 4096);
        LAS int* so_ = (LAS int*)(lds + LDSCTL_OFF + 12288);
        LAS int* cn_ = so_ + 128;
        LAS float* rw_ = (LAS float*)(lds + LDSCTL_OFF + 13312);
        if (wave_ == 0) {
            const int cnt = (int)__hip_atomic_load(&CTL[CW_CNT + lane_], RLX_AGENT), pc = (cnt + 255) & ~255; int inc = pc;
#pragma unroll
            for (int o = 1; o < 64; o <<= 1) { const int nb = __builtin_amdgcn_ds_bpermute(((lane_ - o) & 63) << 2, inc); if (lane_ >= o) inc += nb; }
            so_[lane_] = inc - pc; cn_[lane_] = cnt; if (lane_ == 63) so_[64] = inc; }
        __syncthreads();
        const int total = __builtin_amdgcn_readfirstlane(so_[64]);
        if (tid_ < 64) { for (int rt = so_[tid_] >> 8; rt < (so_[tid_ + 1] >> 8); ++rt) tl_[rt] = tid_; tl_[(total >> 8) + tid_] = 64; }
        __syncthreads();
        pg8::MoeOrder<true> S; S.A = (const char*)p_x8; S.Bt = (const char*)p_egut8; S.lda = D / 2; S.ldb = D / 2; S.rowoff = ro_; S.tilee = tl_;
        S.npn = 2; S.nunits = ((total >> 8) + 64) * 2; S.G = G_; S.c = (int)blockIdx.x; S.estride = (size_t)512 * D; S.bextra = 0;
        if (tid_ < 256) {
            typedef float f32x2_ __attribute__((ext_vector_type(2)));
            int tk_[8]; f32x2_ rw2_[8]; bool val_[8];
#pragma unroll
            for (int i = 0; i < 8; ++i) { pg8::Unit u_; val_[i] = S.next(i, u_); tk_[i] = 0; rw2_[i] = (f32x2_){0.f, 0.f};
                if (val_[i]) { const int e = u_.aux, pe = u_.pm * 256 + tid_ - (e < 64 ? so_[e] : total);
                    if (e == 64) { tk_[i] = pe << 4; const float rr = p_rt[pe]; rw2_[i] = (f32x2_){rr, rr}; }
                    else if (pe < cn_[e]) { tk_[i] = p_rte[e * ECAP + pe]; rw2_[i] = *(const f32x2_*)(p_rwe + 2 * ((size_t)e * ECAP + pe)); } } }
            const float us = 1.0f / (pg8::X8_SCALE * pg8::WG_SCALE);
#pragma unroll
            for (int i = 0; i < 8; ++i) if (val_[i]) { ro_[i * 256 + tid_] = (unsigned)(tk_[i] >> 4) * (unsigned)D; rw_[2 * (i * 256 + tid_)] = rw2_[i].x * us; rw_[2 * (i * 256 + tid_) + 1] = rw2_[i].y * us; } }
        __syncthreads();
        pg8::EpiS5 E{p_hid, rw_};
        { f32x4 acc_[2][2][4][2]; pg8::gemm_phase<pg8::EpiS5, pg8::MoeOrder<true>, true, true, true>(lds, S, E, D / 128, wave_, acc_); }
    }
    do { asm volatile("s_waitcnt vmcnt(0)" ::: "memory"); __syncthreads();
        if (wv0_ == 0) xcd_barrier_w0(bar);
        else if (wv0_ <= 4) { PHV(); const int r256 = tid_ - 64;
            LAS int* tl_ = (LAS int*)(lds + LDSCTL_OFF + 1024); LAS int* so_ = (LAS int*)(lds + LDSCTL_OFF + 12288); LAS int* cn_ = so_ + 128; LAS int* yd_ = (LAS int*)(lds + LDSCTL_OFF + 13312);
            const int total = so_[64];
            pg8::MoeOrder<false> S; S.A = nullptr; S.Bt = nullptr; S.lda = 0; S.ldb = 0; S.rowoff = nullptr; S.tilee = tl_; S.npn = 4; S.nunits = ((total >> 8) + 64) * 4; S.G = G_; S.c = (int)blockIdx.x; S.estride = 0; S.bextra = 0;
            int dv_[12]; bool val_[12];
#pragma unroll
            for (int i = 0; i < 12; ++i) { pg8::Unit u_; val_[i] = S.next(i, u_); dv_[i] = -1;
                if (val_[i]) { const int e = u_.aux, pe = u_.pm * 256 + r256 - (e < 64 ? so_[e] : total);
                    if (e == 64) dv_[i] = (pe << 4) | 8; else if (pe < cn_[e]) dv_[i] = p_rte[e * ECAP + pe]; } }
#pragma unroll
            for (int i = 0; i < 12; ++i) if (val_[i]) yd_[i * 256 + r256] = (dv_[i] < 0) ? -1 : ((dv_[i] >> 4) * 9 + (dv_[i] & 15)) * 1024;
            { pg8::Unit u_; for (int i = 12; i < 16 && S.next(i, u_); ++i) { const int e = u_.aux, pe = u_.pm * 256 + r256 - (e < 64 ? so_[e] : total); int d = -1;
                if (e == 64) d = (pe * 9 + 8) * 1024; else if (pe < cn_[e]) { const int v = p_rte[e * ECAP + pe]; d = ((v >> 4) * 9 + (v & 15)) * 1024; }
                yd_[i * 256 + r256] = d; } } }
        __syncthreads(); } while (0);
    REPS(8) if (IN(8)) { REPBAR(); PHV();
        LAS int* tl_ = (LAS int*)(lds + LDSCTL_OFF + 1024);
        const int total = __builtin_amdgcn_readfirstlane(((LAS int*)(lds + LDSCTL_OFF + 12288))[64]);
        pg8::MoeOrder<false> S; S.A = (const char*)p_hid; S.Bt = (const char*)p_edt8; S.lda = EH / 2; S.ldb = EH / 2; S.rowoff = nullptr; S.tilee = tl_;
        S.npn = 4; S.nunits = ((total >> 8) + 64) * 4; S.G = G_; S.c = (int)blockIdx.x; S.estride = (size_t)D * EH; S.bextra = 0;
        LAS int* yd_ = (LAS int*)(lds + LDSCTL_OFF + 13312);
        pg8::EpiS6 E{p_y, yd_};
        { f32x4 acc_[2][2][4][2]; pg8::gemm_phase<pg8::EpiS6, pg8::MoeOrder<false>, true, true, true>(lds, S, E, EH / 128, wave_, acc_); }
    }
    SEAM(8);
    REPS(9) if (IN(9)) { REPBAR(); PHV();
        const bool dry = (REP_PHASE >= 0) && (args.rep == 9) && rep_ == 0;
        typedef float f32x2_ __attribute__((ext_vector_type(2)));
        f32x4 gq_[4];
#pragma unroll
        for (int i = 0; i < 4; ++i) gq_[i] = *(const f32x4*)(p_g_final + i * 256 + lane_ * 4);
        for (int tb = gw; tb < T; tb += 2 * NGW) {
            float a[2][16]; float* o[2]; const u32x4* xr[2]; const unsigned char* yr[2];
#pragma unroll
            for (int u = 0; u < 2; ++u) { const int t = (tb + u * NGW < T) ? tb + u * NGW : tb; o[u] = p_out + (size_t)t * D + lane_ * 16; xr[u] = (const u32x4*)(p_xm + (size_t)t * pg8::XM_PITCH + lane_ * 16); yr[u] = p_y + (size_t)t * 9 * 1024 + lane_ * 16; }
#pragma unroll
            for (int u = 0; u < 2; ++u)
#pragma unroll
                for (int i = 0; i < 2; ++i) { const u32x4 p = xr[u][i];
#pragma unroll
                    for (int j = 0; j < 4; ++j) { a[u][8 * i + 2 * j] = bflo(p[j]) * pg8::Y_SCALE; a[u][8 * i + 2 * j + 1] = bfhi(p[j]) * pg8::Y_SCALE; } }
#pragma unroll
            for (int k = 0; k < 9; ++k)
#pragma unroll
                for (int u = 0; u < 2; ++u) { const u32x4 v = *(const u32x4*)(yr[u] + k * 1024);
#pragma unroll
                    for (int i = 0; i < 4; ++i) { const f32x2_ d0 = __builtin_amdgcn_cvt_pk_f32_fp8((int)v[i], false), d1 = __builtin_amdgcn_cvt_pk_f32_fp8((int)v[i], true);
                        f32x2_ s0 = (f32x2_){a[u][4 * i], a[u][4 * i + 1]}, s1 = (f32x2_){a[u][4 * i + 2], a[u][4 * i + 3]}; s0 += d0; s1 += d1;
                        a[u][4 * i] = s0.x; a[u][4 * i + 1] = s0.y; a[u][4 * i + 2] = s1.x; a[u][4 * i + 3] = s1.y; } }
#pragma unroll
            for (int u = 0; u < 2; ++u) {
                if (u == 1 && tb + NGW >= T) break;
                float ssq = 0.f;
#pragma unroll
                for (int i = 0; i < 16; ++i) ssq += a[u][i] * a[u][i];
                const float r = rsqrtf(wave_sum(ssq) * (pg8::Y_UNSCALE * pg8::Y_UNSCALE / D) + EPS) * pg8::Y_UNSCALE;
                if (dry && a[u][0] != 123456.789f) continue;
                LAS float* tq_ = (LAS float*)(lds + wave_ * 8192 + u * 4096);
#pragma unroll
                for (int i = 0; i < 4; ++i) *(LAS f32x4*)(tq_ + lane_ * 16 + 4 * i) = (f32x4){a[u][4 * i] * r, a[u][4 * i + 1] * r, a[u][4 * i + 2] * r, a[u][4 * i + 3] * r};
                asm volatile("" ::: "memory");
#pragma unroll
                for (int i = 0; i < 4; ++i) { const f32x4 g = gq_[i]; const f32x4 v = *(const LAS f32x4*)(tq_ + i * 256 + lane_ * 4);
                    float* op_ = o[u] - lane_ * 16 + i * 256 + lane_ * 4; const f32x4 w_ = (f32x4){v.x * g.x, v.y * g.y, v.z * g.z, v.w * g.w};
                    asm volatile("global_store_dwordx4 %0, %1, off sc1\n\ts_nop 0" :: "v"(op_), "v"(w_) : "memory"); }
                asm volatile("" ::: "memory");
            }
        }
    }
#undef IN
#undef SEAM
}


#undef p_x
constexpr int N_PHASES = 10;
extern "C" void kernel_launch(void* const* d_in, const int* in_sizes, int n_in, void* d_out, int out_size, void* d_ws, size_t ws_size, hipStream_t stream) {
    static int grid = 0;
    if (grid == 0) {
        if (n_in != 20 || ws_size < WS_END || out_size != T * D) { fprintf(stderr, "kernel_launch: unexpected shapes / workspace (%zu)\n", ws_size); grid = -1; return; }
        int dev = 0, cus = 0;
        if (hipGetDevice(&dev) != hipSuccess || hipDeviceGetAttribute(&cus, hipDeviceAttributeMultiprocessorCount, dev) != hipSuccess) { grid = -1; return; }
        if (hipFuncSetAttribute((const void*)mega_fwd, hipFuncAttributeMaxDynamicSharedMemorySize, LDS_BYTES) != hipSuccess) { fprintf(stderr, "kernel_launch: hipFuncSetAttribute failed\n"); grid = -1; return; }
        int per_cu = 0;
        if (hipOccupancyMaxActiveBlocksPerMultiprocessor(&per_cu, (const void*)mega_fwd, NTHR, LDS_BYTES) != hipSuccess || per_cu < 1) { fprintf(stderr, "kernel_launch: occupancy query says %d\n", per_cu); }
        (void)hipGetLastError();
        grid = cus;
    }
    if (grid < 0) return;
    if (hipMemsetAsync((char*)d_ws + WS_CTL, 0, CTL_BYTES, stream) != hipSuccess) return;
    Args a{};
    for (int i = 0; i < 20; ++i) a.in[i] = (const float*)d_in[i];
    a.out = (float*)d_out; a.ws = (unsigned char*)d_ws; a.rep = REP_PHASE; a.stag = STAG_G2; a.exb = PROBE_DRY;
#if MK_PER_PHASE
    for (int p = 0; p < N_PHASES; ++p) { a.ph_lo = p; a.ph_hi = p + 1; hipLaunchKernelGGL(mega_fwd, dim3(grid), dim3(NTHR), LDS_BYTES, stream, a); }
#else
    a.ph_lo = 0; a.ph_hi = N_PHASES;
    hipLaunchKernelGGL(mega_fwd, dim3(grid), dim3(NTHR), LDS_BYTES, stream, a);
#endif
}
```
